# Optimizing an MI355X kernel written in HIP

```python
import jax, jax.numpy as jnp
from jax import lax
import numpy as np

D_MODEL = 1024
BATCH = 16
SEQ = 2048
DEPTH = 4

CHUNK = 64
Q_BLOCK = 128
MLA_HEADS = 8
QK_NOPE_DIM = 64
QK_ROPE_DIM = 32
QK_DIM = QK_NOPE_DIM + QK_ROPE_DIM
V_HEAD_DIM = 64
Q_RANK = 256
KV_RANK = 128
ROPE_THETA = 10000.0
MLA_WIDTH = MLA_HEADS * V_HEAD_DIM
GM_GROUPS = 8
GM_GROUP_DIM = 64
GM_WIDTH = GM_GROUPS * GM_GROUP_DIM
GM_BLOCK = 128
MIX_WIDTH = MLA_WIDTH + GM_WIDTH
IN_WIDTH = Q_RANK + KV_RANK + QK_ROPE_DIM + 2 * GM_WIDTH
N_EXPERT_GROUPS = 4
EXPERTS_PER_GROUP = 8
N_EXPERTS = N_EXPERT_GROUPS * EXPERTS_PER_GROUP
TOP_K_IN_GROUP = 2
D_EXPERT = 512
MOE_BLOCK = 128
PLE_DIM = 256
RMS_EPS = 1e-6

kernel_name = 'hybrid_mla_gmlp_hiermoe_ple'


def rms_norm(x, g):
    xf = x.astype(jnp.float32)
    y = xf * lax.rsqrt(jnp.mean(xf * xf, axis=-1, keepdims=True) + RMS_EPS)
    return (y * g.astype(jnp.float32)).astype(x.dtype)


def rope_tables(seq, dtype):
    inv = ROPE_THETA ** (-jnp.arange(0, QK_ROPE_DIM, 2, dtype=jnp.float32) / QK_ROPE_DIM)
    ang = jnp.arange(seq, dtype=jnp.float32)[:, None] * inv[None, :]
    return jnp.cos(ang).astype(dtype), jnp.sin(ang).astype(dtype)


def apply_rope(x, cos, sin):
    half = x.shape[-1] // 2
    x1, x2 = x[..., :half], x[..., half:]
    c = cos[None, :, None, :]
    s = sin[None, :, None, :]
    return jnp.concatenate([x1 * c - x2 * s, x2 * c + x1 * s], axis=-1)


def block_causal_attention(q, k, v):
    S = q.shape[1]
    scale = QK_DIM ** -0.5
    chunk_id = jnp.arange(S) // CHUNK
    neg = jnp.finfo(jnp.float32).min
    outs = []
    for blk in range(S // Q_BLOCK):
        q0 = blk * Q_BLOCK
        kend = q0 + Q_BLOCK
        qb = q[:, q0:kend]
        kb = k[:, :kend]
        vb = v[:, :kend]
        s = jnp.einsum('bqhd,bkhd->bhqk', qb, kb, preferred_element_type=jnp.float32) * scale
        mask = chunk_id[None, :kend] <= chunk_id[q0:kend, None]
        s = jnp.where(mask[None, None], s, neg)
        pr = jax.nn.softmax(s, axis=-1).astype(vb.dtype)
        outs.append(jnp.einsum('bhqk,bkhd->bqhd', pr, vb))
    return jnp.concatenate(outs, axis=1)


def mla_branch(c_q, c_kv, k_r, g_cq, g_ckv, w_uq, w_ukv, g_qn, g_kn, cos, sin):
    B, S, _ = c_q.shape
    q = (rms_norm(c_q, g_cq) @ w_uq).reshape(B, S, MLA_HEADS, QK_DIM)
    kv = (rms_norm(c_kv, g_ckv) @ w_ukv).reshape(B, S, MLA_HEADS, QK_NOPE_DIM + V_HEAD_DIM)
    k_nope, v = kv[..., :QK_NOPE_DIM], kv[..., QK_NOPE_DIM:]
    k_rope = jnp.broadcast_to(k_r[:, :, None, :], (B, S, MLA_HEADS, QK_ROPE_DIM))
    k = jnp.concatenate([k_nope, k_rope], axis=-1)
    q = rms_norm(q, g_qn)
    k = rms_norm(k, g_kn)
    q = jnp.concatenate([q[..., :QK_NOPE_DIM], apply_rope(q[..., QK_NOPE_DIM:], cos, sin)], axis=-1)
    k = jnp.concatenate([k[..., :QK_NOPE_DIM], apply_rope(k[..., QK_NOPE_DIM:], cos, sin)], axis=-1)
    o = block_causal_attention(q, k, v)
    return o.reshape(B, S, MLA_WIDTH)


def gmlp_branch(u_raw, v_raw, g_v, w_s, b_s):
    B, S, _ = u_raw.shape
    nb = S // GM_BLOCK
    u = jax.nn.gelu(u_raw).reshape(B, nb, GM_BLOCK, GM_GROUPS, GM_GROUP_DIM)
    v = rms_norm(jax.nn.gelu(v_raw).reshape(B, S, GM_GROUPS, GM_GROUP_DIM), g_v)
    v = v.reshape(B, nb, GM_BLOCK, GM_GROUPS, GM_GROUP_DIM)
    pos_chunk = jnp.arange(GM_BLOCK) // CHUNK
    mask = pos_chunk[None, :] <= pos_chunk[:, None]
    w = jnp.where(mask[None], w_s, jnp.zeros((), w_s.dtype))
    s = jnp.einsum('gtj,bnjgc->bntgc', w, v) + b_s.T[None, None, :, :, None]
    return (u * s).reshape(B, S, GM_WIDTH)


def hier_moe(xn, w_rg, w_re, w1, w3, w2):
    B, S, D = xn.shape
    T = B * S
    K = TOP_K_IN_GROUP
    xt = xn.reshape(T, D)
    lg = jnp.matmul(xt, w_rg, preferred_element_type=jnp.float32)
    pg = jax.nn.softmax(lg, axis=-1)
    g_sel = jnp.argmax(lg, axis=-1).astype(jnp.int32)
    p_sel = jnp.take_along_axis(pg, g_sel[:, None], axis=-1)
    le = jnp.matmul(xt, w_re, preferred_element_type=jnp.float32).reshape(T, N_EXPERT_GROUPS, EXPERTS_PER_GROUP)
    le_sel = jnp.take_along_axis(le, g_sel[:, None, None], axis=1)[:, 0]
    top_v, top_i = lax.top_k(le_sel, K)
    gates = p_sel * jax.nn.softmax(top_v, axis=-1)
    ids = (g_sel[:, None] * EXPERTS_PER_GROUP + top_i).reshape(-1).astype(jnp.int32)
    A = T * K
    tok = jnp.arange(A, dtype=jnp.int32) // K
    n_blocks = -(-A // MOE_BLOCK) + N_EXPERTS
    n_slots = n_blocks * MOE_BLOCK
    order = jnp.argsort(ids)
    s_ids = ids[order]
    counts = jnp.bincount(ids, length=N_EXPERTS).astype(jnp.int32)
    padded = (counts + MOE_BLOCK - 1) // MOE_BLOCK * MOE_BLOCK
    p_end = jnp.cumsum(padded)
    p_start = p_end - padded
    c_start = jnp.cumsum(counts) - counts
    dest = p_start[s_ids] + jnp.arange(A, dtype=jnp.int32) - c_start[s_ids]
    slot_tok = jnp.full((n_slots,), T, jnp.int32).at[dest].set(tok[order])
    slot_gate = jnp.zeros((n_slots,), jnp.float32).at[dest].set(gates.reshape(-1)[order])
    block_start = jnp.arange(n_blocks, dtype=jnp.int32) * MOE_BLOCK
    block_expert = jnp.minimum(jnp.sum(block_start[:, None] >= p_end[None, :], axis=1), N_EXPERTS - 1)
    x_pad = jnp.concatenate([xt, jnp.zeros((1, D), xt.dtype)], axis=0)
    x_slots = x_pad[slot_tok].reshape(n_blocks, MOE_BLOCK, D)

    def expert_block(args):
        xb, e = args
        return (jax.nn.silu(xb @ w1[e]) * (xb @ w3[e])) @ w2[e]

    y_slots = lax.map(expert_block, (x_slots, block_expert)).reshape(n_slots, D)
    y = jnp.zeros((T + 1, D), xt.dtype).at[slot_tok].add(y_slots * slot_gate[:, None].astype(xt.dtype))
    return y[:T].reshape(B, S, D)


def setup_inputs(seed: int = 0) -> dict:
    key = jax.random.key(seed)
    ks = jax.random.split(key, 32)
    L, D = DEPTH, D_MODEL

    def nrm(k, shape, scale):
        return jax.random.normal(k, shape, jnp.float32) * scale

    def gain(k, shape):
        return 1.0 + 0.1 * jax.random.normal(k, shape, jnp.float32)

    return {
        'x': nrm(ks[0], (BATCH, SEQ, D), 1.0),
        'p': nrm(ks[1], (DEPTH, BATCH, SEQ, PLE_DIM), 1.0),
        'g_mix_norm': gain(ks[2], (L, D)),
        'w_in': nrm(ks[3], (L, D, IN_WIDTH), D ** -0.5),
        'g_cq': gain(ks[4], (L, Q_RANK)),
        'g_ckv': gain(ks[5], (L, KV_RANK)),
        'w_uq': nrm(ks[6], (L, Q_RANK, MLA_HEADS * QK_DIM), Q_RANK ** -0.5),
        'w_ukv': nrm(ks[7], (L, KV_RANK, MLA_HEADS * (QK_NOPE_DIM + V_HEAD_DIM)), KV_RANK ** -0.5),
        'g_qn': gain(ks[8], (L, QK_DIM)),
        'g_kn': gain(ks[9], (L, QK_DIM)),
        'g_v': gain(ks[10], (L, GM_GROUPS, GM_GROUP_DIM)),
        'w_s': nrm(ks[11], (L, GM_GROUPS, GM_BLOCK, GM_BLOCK), GM_BLOCK ** -0.5),
        'b_s': gain(ks[12], (L, GM_GROUPS, GM_BLOCK)),
        'g_out_mla': gain(ks[13], (L, MLA_WIDTH)),
        'g_out_gmlp': gain(ks[14], (L, GM_WIDTH)),
        'w_out': nrm(ks[15], (L, MIX_WIDTH, D), MIX_WIDTH ** -0.5),
        'g_ffn_norm': gain(ks[16], (L, D)),
        'w_router_group': nrm(ks[17], (L, D, N_EXPERT_GROUPS), D ** -0.5),
        'w_router_expert': nrm(ks[18], (L, D, N_EXPERTS), D ** -0.5),
        'w1': nrm(ks[19], (L, N_EXPERTS, D, D_EXPERT), D ** -0.5),
        'w3': nrm(ks[20], (L, N_EXPERTS, D, D_EXPERT), D ** -0.5),
        'w2': nrm(ks[21], (L, N_EXPERTS, D_EXPERT, D), D_EXPERT ** -0.5),
        'g_ple': gain(ks[22], (L, D)),
        'w_ple_gate': nrm(ks[23], (L, D, D), D ** -0.5),
        'b_ple_gate': nrm(ks[24], (L, D), 0.02),
        'w_ple': nrm(ks[25], (L, PLE_DIM, D), PLE_DIM ** -0.5),
    }


def reference(x, p, g_mix_norm, w_in, g_cq, g_ckv, w_uq, w_ukv, g_qn, g_kn, g_v, w_s, b_s,
              g_out_mla, g_out_gmlp, w_out, g_ffn_norm, w_router_group, w_router_expert,
              w1, w3, w2, g_ple, w_ple_gate, b_ple_gate, w_ple):
    S = x.shape[1]
    cos, sin = rope_tables(S, x.dtype)
    s0 = Q_RANK
    s1 = s0 + KV_RANK
    s2 = s1 + QK_ROPE_DIM
    s3 = s2 + GM_WIDTH
    h = x
    for i in range(DEPTH):
        hn = rms_norm(h, g_mix_norm[i])
        proj = hn @ w_in[i]
        c_q = proj[..., :s0]
        c_kv = proj[..., s0:s1]
        k_r = proj[..., s1:s2]
        u_raw = proj[..., s2:s3]
        v_raw = proj[..., s3:]
        a = mla_branch(c_q, c_kv, k_r, g_cq[i], g_ckv[i], w_uq[i], w_ukv[i], g_qn[i], g_kn[i], cos, sin)
        m = gmlp_branch(u_raw, v_raw, g_v[i], w_s[i], b_s[i])
        mixed = jnp.concatenate([rms_norm(a, g_out_mla[i]), rms_norm(m, g_out_gmlp[i])], axis=-1)
        h = h + mixed @ w_out[i]
        h = h + hier_moe(rms_norm(h, g_ffn_norm[i]), w_router_group[i], w_router_expert[i], w1[i], w3[i], w2[i])
        gate = jax.nn.sigmoid(rms_norm(h, g_ple[i]) @ w_ple_gate[i] + b_ple_gate[i])
        h = h + (p[i] @ w_ple[i]) * gate
    return h
```

```cpp
#include <hip/hip_runtime.h>
#include <stdint.h>
#include <stdio.h>

typedef unsigned short bf16_t;
typedef short bf16x8 __attribute__((ext_vector_type(8)));
typedef float f32x4 __attribute__((ext_vector_type(4)));
typedef unsigned u32x4 __attribute__((ext_vector_type(4)));
typedef unsigned u32x2 __attribute__((ext_vector_type(2)));

constexpr int T = 32768, D = 1024, SEQ = 2048, NL = 4;
constexpr int NPROJ = 1536;
constexpr int NEXP = 32, DEXP = 512;
constexpr int MAXSLOT = 73728;
constexpr float EPS = 1e-6f;
constexpr float SM_SCALE = 0.10206207261596577f;

constexpr size_t MiB = 1u << 20;
constexpr size_t WS_ZERO = 0, ZERO_BYTES = 4 * MiB;
constexpr size_t Z_BAR = 0;
constexpr size_t Z_CNT = 16384;
constexpr size_t Z_SSQ = 65536;
constexpr size_t WS_SMALL = 4 * MiB;
constexpr size_t S_ROPE = WS_SMALL;
constexpr size_t S_SSQKR = WS_SMALL + 256 * 1024;
constexpr size_t S_RSTDM = S_SSQKR + 128 * 1024;
constexpr size_t S_RSTD2 = S_RSTDM + 128 * 1024;
constexpr size_t S_SLOTTOK = WS_SMALL + 1 * MiB;
constexpr size_t S_SLOTRSTD = WS_SMALL + 5 * MiB;
constexpr size_t S_SLOTGATE = WS_SMALL + 9 * MiB;
constexpr size_t S_FLAT = WS_SMALL + 13 * MiB;
constexpr size_t WS_W = 20 * MiB;
constexpr size_t W_IN = WS_W;
constexpr size_t W_UQ = W_IN + (size_t)NPROJ * 1024 * 2;
constexpr size_t W_UKV = W_UQ + 768 * 256 * 2;
constexpr size_t W_PLE = W_UKV + 1024 * 256 * 2;
constexpr size_t W_OUT = W_PLE + 1024 * 256 * 2;
constexpr size_t W_PG = W_OUT + 1024 * 1024 * 2;
constexpr size_t W_13 = W_PG + 1024 * 1024 * 2;
constexpr size_t W_2 = W_13 + (size_t)32 * 1024 * 1024 * 2;
constexpr size_t W_R = W_2 + (size_t)32 * 1024 * 512 * 2;
constexpr size_t W_S = W_R + 2 * 64 * 1024 * 2;
constexpr size_t W_END = W_S + 8 * 128 * 128 * 2;
static_assert(W_END <= 126 * MiB, "weights region");
constexpr size_t WS_X0 = 126 * MiB, WS_X1 = 190 * MiB;
constexpr size_t WS_PB = 254 * MiB;
constexpr size_t WS_CQ = 318 * MiB, WS_CKV = 334 * MiB, WS_U = 350 * MiB, WS_V = 382 * MiB;
constexpr size_t WS_H = 318 * MiB;
constexpr size_t WS_Q = 414 * MiB, WS_K = 462 * MiB, WS_VF = 510 * MiB;
constexpr size_t WS_Y0 = 414 * MiB, WS_Y1 = 478 * MiB;
constexpr size_t WS_AM = 542 * MiB;
constexpr size_t WS_E = 606 * MiB;
constexpr size_t WS_SCR = 670 * MiB;
constexpr size_t W_ALT = 682 * MiB;
constexpr size_t WS_X8 = 670 * MiB;
constexpr size_t WS_SSQHP = 958 * MiB;
constexpr size_t WS_SSQAP = 960 * MiB;
constexpr size_t WS_END = 961 * MiB;
static_assert((size_t)MAXSLOT * 512 * 2 <= 96 * MiB, "H overlay");

__device__ __forceinline__ float bf2f(bf16_t v) { return __uint_as_float((unsigned)v << 16); }
__device__ __forceinline__ bf16_t f2bf(float f) { unsigned u = __float_as_uint(f); return (bf16_t)((u + 0x7fffu + ((u >> 16) & 1u)) >> 16); }
__device__ __forceinline__ unsigned pk2(float lo, float hi) { return (unsigned)f2bf(lo) | ((unsigned)f2bf(hi) << 16); }
__device__ __forceinline__ float gelu_tanh(float x) { const float z = -2.3022081983740904f * (x + 0.044715f * x * x * x); return x * __builtin_amdgcn_rcpf(1.f + __builtin_amdgcn_exp2f(z)); }
__device__ __forceinline__ float silu_f(float x) { return x * __builtin_amdgcn_rcpf(1.f + __builtin_amdgcn_exp2f(-1.4426950408889634f * x)); }
__device__ __forceinline__ float sigmoid_f(float x) { return __builtin_amdgcn_rcpf(1.f + __builtin_amdgcn_exp2f(-1.4426950408889634f * x)); }
__device__ __forceinline__ float wave_sum(float v) {
#pragma unroll
    for (int o = 1; o < 64; o <<= 1) v += __shfl_xor(v, o);
    return v;
}
__host__ __device__ __forceinline__ int proj_src(int pc) {
    if (pc < 416) return pc;
    if (pc < 512) return -1;
    if (pc < 1024) return 416 + (pc - 512);
    const int q = pc - 1024, tv = q >> 8, r = q & 255, bj = r >> 7, wc = (r & 127) >> 5, x = r & 31;
    return 928 + 256 * tv + 64 * wc + 32 * bj + x;
}
__host__ __device__ __forceinline__ int ukv_src(int pc) {
    const int t = pc >> 8, r = pc & 255, bj = r >> 7, wc = (r & 127) >> 5, x = r & 31;
    return (2 * t + (wc >> 1)) * 128 + (wc & 1) * 64 + 32 * bj + x;
}

struct LayerW {
    const float *g_mix, *w_in, *g_cq, *g_ckv, *w_uq, *w_ukv, *g_qn, *g_kn, *g_v, *w_s, *b_s, *g_oa, *g_om, *w_out, *g_ffn, *w_rg, *w_re, *w1, *w3, *w2, *g_ple, *w_pg, *b_pg, *w_ple;
};

template <int PART, class Src>
__device__ __forceinline__ void transpose_part(const Src& src, int K, int N, bf16_t* out, int item, int lane, f32x4 (&v)[16]) {
    const int nblk = N / 32, kb_ = item / nblk, nb = item % nblk, kb = lane >> 3, ch = lane & 7, k0 = 64 * kb_ + 8 * kb, n0 = 32 * nb + 4 * ch;
    if (PART != 1) {
#pragma unroll
        for (int j = 0; j < 8; ++j) v[j] = src.load4(k0 + j, n0); }
    if (PART != 0) {
#pragma unroll
        for (int c = 0; c < 4; ++c) {
            u32x4 o; o.x = pk2(v[0][c], v[1][c]); o.y = pk2(v[2][c], v[3][c]); o.z = pk2(v[4][c], v[5][c]); o.w = pk2(v[6][c], v[7][c]);
            *(u32x4*)(out + (size_t)(n0 + c) * K + k0) = o; } }
}
template <class Src>
__device__ __forceinline__ void transpose_item(const Src& src, int K, int N, bf16_t* out, float*  , int item, int lane) { f32x4 v[16]; transpose_part<2>(src, K, N, out, item, lane, v); }
struct SrcIn { const float* w; const float* g; __device__ __forceinline__ f32x4 load4(int k, int n) const { const int s = proj_src(n); return s < 0 ? (f32x4){0.f, 0.f, 0.f, 0.f} : *(const f32x4*)(w + (size_t)k * 1440 + s) * g[k]; } };
struct SrcUq { const float* w; const float* g; __device__ __forceinline__ f32x4 load4(int k, int n) const { return *(const f32x4*)(w + (size_t)k * 768 + n) * g[k]; } };
struct SrcUkv { const float* w; const float* g; __device__ __forceinline__ f32x4 load4(int k, int n) const { return k < 128 ? *(const f32x4*)(w + (size_t)k * 1024 + ukv_src(n)) * g[k] : (f32x4){0.f, 0.f, 0.f, 0.f}; } };
struct SrcPlain { const float* w; int ldw; __device__ __forceinline__ f32x4 load4(int k, int n) const { return *(const f32x4*)(w + (size_t)k * ldw + n); } };
struct SrcOut { const float* w; const float* ga; const float* gm; __device__ __forceinline__ f32x4 load4(int k, int n) const { return *(const f32x4*)(w + (size_t)k * 1024 + n) * (k < 512 ? ga[k] : gm[k - 512]); } };
struct SrcPg { const float* w; const float* g; __device__ __forceinline__ f32x4 load4(int k, int n) const { return *(const f32x4*)(w + (size_t)k * 1024 + n) * g[k]; } };
struct Src13 { const float* w1; const float* w3; const float* g; __device__ __forceinline__ f32x4 load4(int k, int n) const { const int q = n >> 3; const long d13 = (long)(w3 - w1) * (long)((n >> 2) & 1); return *(const f32x4*)(w1 + d13 + (size_t)k * 512 + 4 * q) * g[k]; } };

#ifndef MOE_FP8
#define MOE_FP8 1
#endif
constexpr float W8_SCALE = 32.f, W8_INV = 1.f / 32.f;
__device__ __forceinline__ unsigned pk4_fp8(float a, float b, float c, float d) { int r = __builtin_amdgcn_cvt_pk_fp8_f32(a, b, 0, false); r = __builtin_amdgcn_cvt_pk_fp8_f32(c, d, r, true); return (unsigned)r; }
template <int PART, class Src>
__device__ __forceinline__ void transpose_part_fp8(const Src& src, int K, int N, unsigned char* out, int item, int lane, f32x4 (&v)[16]) {
    const int nblk = N / 32, kb_ = item / nblk, nb = item % nblk, kb = lane >> 3, ch = lane & 7, k0 = 128 * kb_ + 16 * kb, n0 = 32 * nb + 4 * ch;
    if (PART != 1) {
#pragma unroll
        for (int j = 0; j < 16; ++j) v[j] = src.load4(k0 + j, n0); }
    if (PART != 0) {
#pragma unroll
        for (int c = 0; c < 4; ++c) {
            u32x4 o; o.x = pk4_fp8(v[0][c], v[1][c], v[2][c], v[3][c]); o.y = pk4_fp8(v[4][c], v[5][c], v[6][c], v[7][c]); o.z = pk4_fp8(v[8][c], v[9][c], v[10][c], v[11][c]); o.w = pk4_fp8(v[12][c], v[13][c], v[14][c], v[15][c]);
            *(u32x4*)(out + (size_t)(n0 + c) * K + k0) = o; } }
}
template <class Src>
__device__ __forceinline__ void transpose_item_fp8(const Src& src, int K, int N, unsigned char* out, int item, int lane) { f32x4 v[16]; transpose_part_fp8<2>(src, K, N, out, item, lane, v); }
struct Src13F8 { const float* w1; const float* w3; const float* g; __device__ __forceinline__ f32x4 load4(int k, int pc) const {
    const int hcol = ((pc >> 8) << 7) + (((pc >> 5) & 3) << 5) + (((pc >> 3) & 3) << 3) + (((pc >> 7) & 1) << 2); const long d13 = (long)(w3 - w1) * (long)((pc >> 2) & 1);
    return __builtin_nontemporal_load((const f32x4*)(w1 + d13 + (size_t)k * 512 + hcol)) * (g[k] * W8_SCALE); } };
struct SrcPgF8 { const float* w; const float* g; __device__ __forceinline__ f32x4 load4(int k, int n) const { return *(const f32x4*)(w + (size_t)k * 1024 + n) * (g[k] * W8_SCALE); } };
struct SrcPlainF8 { const float* w; int ldw; __device__ __forceinline__ f32x4 load4(int k, int n) const { return __builtin_nontemporal_load((const f32x4*)(w + (size_t)k * ldw + n)) * W8_SCALE; } };
#if MOE_FP8
constexpr int IT_IN = 16 * 48, IT_UQ = 4 * 24, IT_UKV = 4 * 32, IT_PLE = 4 * 32, IT_OUT = 16 * 32, IT_PG = 8 * 32, IT_13 = 8 * 32, IT_2 = 4 * 32;
#else
constexpr int IT_IN = 16 * 48, IT_UQ = 4 * 24, IT_UKV = 4 * 32, IT_PLE = 4 * 32, IT_OUT = 16 * 32, IT_PG = 16 * 32, IT_13 = 16 * 32, IT_2 = 8 * 32;
#endif
constexpr int IT_SMALL = IT_IN + IT_UQ + IT_UKV + IT_PLE + IT_OUT + IT_PG;
constexpr int IT_TOTAL = IT_SMALL + 32 * IT_13 + 32 * IT_2;
__device__ __forceinline__ void convert_item(const LayerW& L, unsigned char* ws, int it, float* scr, int lane) {
    int r = it;
    if (r < IT_IN) { transpose_item(SrcIn{L.w_in, L.g_mix}, 1024, NPROJ, (bf16_t*)(ws + W_IN), scr, r, lane); return; } r -= IT_IN;
    if (r < IT_UQ) { transpose_item(SrcUq{L.w_uq, L.g_cq}, 256, 768, (bf16_t*)(ws + W_UQ), scr, r, lane); return; } r -= IT_UQ;
    if (r < IT_UKV) { transpose_item(SrcUkv{L.w_ukv, L.g_ckv}, 256, 1024, (bf16_t*)(ws + W_UKV), scr, r, lane); return; } r -= IT_UKV;
    if (r < IT_PLE) { transpose_item(SrcPlain{L.w_ple, 1024}, 256, 1024, (bf16_t*)(ws + W_PLE), scr, r, lane); return; } r -= IT_PLE;
    if (r < IT_OUT) { transpose_item(SrcOut{L.w_out, L.g_oa, L.g_om}, 1024, 1024, (bf16_t*)(ws + W_OUT), scr, r, lane); return; } r -= IT_OUT;
#if MOE_FP8
    if (r < IT_PG) { transpose_item_fp8(SrcPgF8{L.w_pg, L.g_ple}, 1024, 1024, ws + W_PG, r, lane); return; } r -= IT_PG;
#else
    if (r < IT_PG) { transpose_item(SrcPg{L.w_pg, L.g_ple}, 1024, 1024, (bf16_t*)(ws + W_PG), scr, r, lane); return; } r -= IT_PG;
#endif
#if MOE_FP8
    if (r < 32 * IT_13) { const int e = r / IT_13; transpose_item_fp8(Src13F8{L.w1 + (size_t)e * 1024 * 512, L.w3 + (size_t)e * 1024 * 512, L.g_ffn}, 1024, 1024, ws + W_13 + (size_t)e * 1024 * 1024, r % IT_13, lane); return; } r -= 32 * IT_13;
    { const int e = r / IT_2; transpose_item_fp8(SrcPlainF8{L.w2 + (size_t)e * 512 * 1024, 1024}, 512, 1024, ws + W_2 + (size_t)e * 1024 * 512, r % IT_2, lane); }
#else
    if (r < 32 * IT_13) { const int e = r / IT_13; transpose_item(Src13{L.w1 + (size_t)e * 1024 * 512, L.w3 + (size_t)e * 1024 * 512, L.g_ffn}, 1024, 1024, (bf16_t*)(ws + W_13) + (size_t)e * 1024 * 1024, scr, r % IT_13, lane); return; } r -= 32 * IT_13;
    { const int e = r / IT_2; transpose_item(SrcPlain{L.w2 + (size_t)e * 512 * 1024, 1024}, 512, 1024, (bf16_t*)(ws + W_2) + (size_t)e * 1024 * 512, scr, r % IT_2, lane); }
#endif
}
#if MOE_FP8
constexpr int IT_MOE = 32 * IT_13 + 32 * IT_2;
template <int PART>
__device__ __forceinline__ void convert_part_moe(const float* w1, const float* w3, const float* w2, const float* g_ffn, unsigned char* ws, int it, int lane, f32x4 (&v)[16], f32x4 (&gs)[4], u32x4 (&o)[4]) {
    const bool is13 = it < 32 * IT_13; const int r = is13 ? it : it - 32 * IT_13, per = is13 ? IT_13 : IT_2, e = r / per, item = r % per;
    const int kb_ = item >> 5, nb = item & 31, kb = lane >> 3, ch = lane & 7, k0 = 128 * kb_ + 16 * kb, n0 = 32 * nb + 4 * ch;
    if (PART == 0) {
        const int hcol = ((n0 >> 8) << 7) + (((n0 >> 5) & 3) << 5) + (((n0 >> 3) & 3) << 3) + (((n0 >> 7) & 1) << 2); const long d13 = (long)(w3 - w1) * (long)((n0 >> 2) & 1);
        const float* base = is13 ? w1 + (size_t)e * 1024 * 512 : w2 + (size_t)e * 512 * 1024; const long off = is13 ? d13 + hcol : (long)n0; const int ld = is13 ? 512 : 1024;
        const float* p = base + off + (size_t)k0 * ld;
#pragma unroll
        for (int j = 0; j < 16; ++j) v[j] = __builtin_nontemporal_load((const f32x4*)(p + (size_t)j * ld));
#pragma unroll
        for (int q = 0; q < 4; ++q) gs[q] = *(const f32x4*)(g_ffn + k0 + 4 * q);
    } else {
        const int K = is13 ? 1024 : 512; unsigned char* out = is13 ? ws + W_13 + (size_t)e * 1024 * 1024 : ws + W_2 + (size_t)e * 1024 * 512;
        f32x4 s[4];
#pragma unroll
        for (int q = 0; q < 4; ++q) s[q] = is13 ? gs[q] * W8_SCALE : (f32x4){W8_SCALE, W8_SCALE, W8_SCALE, W8_SCALE};
#pragma unroll
        for (int c = 0; c < 4; ++c) {
            o[c].x = pk4_fp8(v[0][c] * s[0][0], v[1][c] * s[0][1], v[2][c] * s[0][2], v[3][c] * s[0][3]); o[c].y = pk4_fp8(v[4][c] * s[1][0], v[5][c] * s[1][1], v[6][c] * s[1][2], v[7][c] * s[1][3]);
            o[c].z = pk4_fp8(v[8][c] * s[2][0], v[9][c] * s[2][1], v[10][c] * s[2][2], v[11][c] * s[2][3]); o[c].w = pk4_fp8(v[12][c] * s[3][0], v[13][c] * s[3][1], v[14][c] * s[3][2], v[15][c] * s[3][3]);
            *(u32x4*)(out + (size_t)(n0 + c) * K + k0) = o[c]; }
    }
}
__device__ __forceinline__ void convert_moe_stream(const float* w1, const float* w3, const float* w2, const float* g_ffn, unsigned char* ws, int it, int stride, int lane) {
    if (it >= IT_MOE) return;
    f32x4 va[16], vb[16], ga[4], gb[4]; u32x4 o[4];
#define CV_KEEP asm volatile("" :: "v"(o[0]), "v"(o[1]), "v"(o[2]), "v"(o[3]))
    convert_part_moe<0>(w1, w3, w2, g_ffn, ws, it, lane, va, ga, o);
#pragma unroll 1
    while (true) {
        const int itb = it + stride;
        if (itb >= IT_MOE) { convert_part_moe<1>(w1, w3, w2, g_ffn, ws, it, lane, va, ga, o); break; }
        convert_part_moe<0>(w1, w3, w2, g_ffn, ws, itb, lane, vb, gb, o); CV_KEEP;
        convert_part_moe<1>(w1, w3, w2, g_ffn, ws, it, lane, va, ga, o);
        it = itb + stride;
        if (it >= IT_MOE) { convert_part_moe<1>(w1, w3, w2, g_ffn, ws, itb, lane, vb, gb, o); break; }
        convert_part_moe<0>(w1, w3, w2, g_ffn, ws, it, lane, va, ga, o); CV_KEEP;
        convert_part_moe<1>(w1, w3, w2, g_ffn, ws, itb, lane, vb, gb, o);
    }
#undef CV_KEEP
}
#endif
__device__ __forceinline__ void convert_small(const LayerW& L, unsigned char* ws, int gtid, int gthreads) {
    bf16_t* hi = (bf16_t*)(ws + W_R); bf16_t* lo = hi + 64 * 1024;
    for (int i = gtid; i < 64 * 1024; i += gthreads) {
        const int n = i >> 10, k = i & 1023; float w = 0.f;
        if (n < 4) w = L.g_ffn[k] * L.w_rg[k * 4 + n]; else if (n < 36) w = L.g_ffn[k] * L.w_re[k * 32 + (n - 4)];
        const bf16_t h = f2bf(w); hi[i] = h; lo[i] = f2bf(w - bf2f(h));
    }
    bf16_t* wsb = (bf16_t*)(ws + W_S);
    for (int i = gtid; i < 8 * 128 * 128; i += gthreads) { const int t = (i >> 7) & 127, j = i & 127; wsb[i] = (t < 64 && j >= 64) ? (bf16_t)0 : f2bf(L.w_s[i]); }
}
__global__ void __launch_bounds__(256) k_convert(LayerW L, unsigned char* ws) {
    __shared__ float scr[4][64 * 33];
    const int lane = threadIdx.x & 63, w = threadIdx.x >> 6, gw = blockIdx.x * 4 + w, ngw = gridDim.x * 4;
    for (int it = gw; it < IT_TOTAL; it += ngw) convert_item(L, ws, it, scr[w], lane);
    convert_small(L, ws, blockIdx.x * 256 + threadIdx.x, gridDim.x * 256);
}

__global__ void __launch_bounds__(256) k_prologue(const float* x, const float* p, unsigned char* ws) {
    const int lane = threadIdx.x & 63, gw = (blockIdx.x * 256 + threadIdx.x) >> 6, ngw = gridDim.x * 4;
    bf16_t* X0 = (bf16_t*)(ws + WS_X0); float* ssqh = (float*)(ws + Z_SSQ) + (size_t)12 * T;
    for (int m = gw; m < T; m += ngw) {
        const f32x4* xr = (const f32x4*)(x + (size_t)m * D) + lane; float s = 0.f;
        u32x2* o = (u32x2*)(X0 + (size_t)m * D) + lane;
#pragma unroll
        for (int j = 0; j < 4; ++j) { const f32x4 v = xr[64 * j]; s += v.x * v.x + v.y * v.y + v.z * v.z + v.w * v.w; u32x2 w; w.x = pk2(v.x, v.y); w.y = pk2(v.z, v.w); o[64 * j] = w; }
        s = wave_sum(s); if (lane == 0) ssqh[m] = s;
        if (lane < 16) ((float*)(ws + WS_SSQHP))[(size_t)lane * T + m] = lane == 0 ? s : 0.f;
    }
    bf16_t* pb = (bf16_t*)(ws + WS_PB);
    const size_t n4 = (size_t)NL * T * 256 / 4, gt = (size_t)blockIdx.x * 256 + threadIdx.x, ngt = (size_t)gridDim.x * 256;
    for (size_t i = gt; i < n4; i += ngt) { const f32x4 v = ((const f32x4*)p)[i]; u32x2 w; w.x = pk2(v.x, v.y); w.y = pk2(v.z, v.w); ((u32x2*)pb)[i] = w; }
    float* rope = (float*)(ws + S_ROPE);
    for (size_t i = gt; i < 2048 * 16; i += ngt) {
        const int pos = (int)(i >> 4), k = (int)(i & 15);
        const double inv = exp(-(double)(2 * k) / 32.0 * log(10000.0)), ang = (double)pos * inv;
        rope[2 * i] = (float)cos(ang); rope[2 * i + 1] = (float)sin(ang);
    }
}

__global__ void __launch_bounds__(256) k_ngemm(const bf16_t* A, int lda, const int* gidx, const bf16_t* Bt, int ldb, const int* bsel, size_t bstride, float* C, int ldc, int K, const int* mlimit) {
    const int lane = threadIdx.x & 63, w = threadIdx.x >> 6, fr = lane & 15, fq = lane >> 4;
    const int row0 = blockIdx.y * 128 + (w >> 1) * 64, col0 = blockIdx.x * 128 + (w & 1) * 64;
    if (mlimit && blockIdx.y * 128 >= *mlimit) return;
    if (bsel) Bt += (size_t)bsel[blockIdx.y] * bstride;
    const bf16_t* ap[4]; const bf16_t* bp[4];
#pragma unroll
    for (int i = 0; i < 4; ++i) { const int r = row0 + 16 * i + fr; ap[i] = A + (size_t)(gidx ? gidx[r] : r) * lda + 8 * fq; bp[i] = Bt + (size_t)(col0 + 16 * i + fr) * ldb + 8 * fq; }
    f32x4 acc[4][4];
#pragma unroll
    for (int i = 0; i < 4; ++i)
#pragma unroll
        for (int j = 0; j < 4; ++j) acc[i][j] = (f32x4){0.f, 0.f, 0.f, 0.f};
    for (int k0 = 0; k0 < K; k0 += 32) {
        bf16x8 a[4], b[4];
#pragma unroll
        for (int i = 0; i < 4; ++i) { a[i] = *(const bf16x8*)(ap[i] + k0); b[i] = *(const bf16x8*)(bp[i] + k0); }
#pragma unroll
        for (int i = 0; i < 4; ++i)
#pragma unroll
            for (int j = 0; j < 4; ++j) acc[i][j] = __builtin_amdgcn_mfma_f32_16x16x32_bf16(b[j], a[i], acc[i][j], 0, 0, 0);
    }
#pragma unroll
    for (int i = 0; i < 4; ++i)
#pragma unroll
        for (int j = 0; j < 4; ++j) *(f32x4*)(C + (size_t)(row0 + 16 * i + fr) * ldc + col0 + 16 * j + 4 * fq) = acc[i][j];
}

__global__ void __launch_bounds__(256) k_post1(const float* scr, unsigned char* ws, int layer, const float* g_v) {
    const int lane = threadIdx.x & 63, row = (blockIdx.x * 256 + threadIdx.x) >> 6;
    const float* ssq = (const float*)(ws + Z_SSQ);
    const float rstd = rsqrtf(ssq[(size_t)(12 + layer) * T + row] * (1.f / 1024.f) + EPS);
    const float* s = scr + (size_t)row * NPROJ;
    bf16_t* cq = (bf16_t*)(ws + WS_CQ) + (size_t)row * 256; bf16_t* ckv = (bf16_t*)(ws + WS_CKV) + (size_t)row * 256;
    bf16_t* u = (bf16_t*)(ws + WS_U) + (size_t)row * 512; bf16_t* v = (bf16_t*)(ws + WS_V) + (size_t)row * 512;
    float a = 0.f, b = 0.f, c = 0.f;
    for (int i = lane; i < 256; i += 64) { const float x = s[i] * rstd; cq[i] = f2bf(x); a += x * x; }
    for (int i = lane; i < 256; i += 64) { const float x = s[256 + i] * rstd; ckv[i] = f2bf(x); if (i < 128) b += x * x; else if (i < 160) c += x * x; }
    a = wave_sum(a); b = wave_sum(b); c = wave_sum(c);
    if (lane == 0) { ((float*)(ws + Z_SSQ))[(size_t)(0 + layer) * T + row] = a; ((float*)(ws + Z_SSQ))[(size_t)(4 + layer) * T + row] = b; ((float*)(ws + S_SSQKR))[row] = c; }
    for (int i = lane; i < 512; i += 64) u[i] = f2bf(gelu_tanh(s[512 + i] * rstd));
    for (int g = 0; g < 8; ++g) {
        const int lc = 64 * g + lane;
        const int tv = lc >> 8, wc = (lc & 255) >> 6, bj = (lc & 63) >> 5, x = lc & 31, pc = 1024 + 256 * tv + 128 * bj + 32 * wc + x;
        const float val = gelu_tanh(s[pc] * rstd); const float q = wave_sum(val * val);
        v[lc] = f2bf(val * rsqrtf(q * (1.f / 64.f) + EPS) * g_v[g * 64 + lane]);
    }
}
__global__ void __launch_bounds__(256) k_post2a(const float* scr, unsigned char* ws, int layer) {
    const size_t i = (size_t)blockIdx.x * 256 + threadIdx.x; const int row = (int)(i / 768);
    const float rs = rsqrtf(((const float*)(ws + Z_SSQ))[(size_t)layer * T + row] * (1.f / 256.f) + EPS);
    ((bf16_t*)(ws + WS_Q))[i] = f2bf(scr[i] * rs);
}
__global__ void __launch_bounds__(256) k_post2b(const float* scr, unsigned char* ws, int layer, const float* g_kn) {
    const int lane = threadIdx.x & 63, gw = (blockIdx.x * 256 + threadIdx.x) >> 6, row = gw >> 3, h = gw & 7;
    const float rckv = rsqrtf(((const float*)(ws + Z_SSQ))[(size_t)(4 + layer) * T + row] * (1.f / 128.f) + EPS);
    const float ssqkr = ((const float*)(ws + S_SSQKR))[row];
    const int t = h >> 1, bj = lane >> 5, x = lane & 31;
    const float kn = scr[(size_t)row * 1024 + 256 * t + 128 * bj + 32 * (2 * (h & 1) + 0) + x] * rckv;
    const float vv = scr[(size_t)row * 1024 + 256 * t + 128 * bj + 32 * (2 * (h & 1) + 1) + x] * rckv;
    const float sk = wave_sum(kn * kn);
    const float rk = rsqrtf((sk + ssqkr) * (1.f / 96.f) + EPS);
    bf16_t* Kf = (bf16_t*)(ws + WS_K) + (size_t)row * 768 + h * 96; bf16_t* Vf = (bf16_t*)(ws + WS_VF) + (size_t)row * 512 + h * 64;
    Kf[lane] = f2bf(kn * rk * g_kn[lane]); Vf[lane] = f2bf(vv);
    if (lane < 16) {
        const bf16_t* kr = (const bf16_t*)(ws + WS_CKV) + (size_t)row * 256 + 128; const float* rope = (const float*)(ws + S_ROPE) + ((size_t)(row & 2047) * 16 + lane) * 2;
        const float x1 = bf2f(kr[lane]) * rk * g_kn[64 + lane], x2 = bf2f(kr[16 + lane]) * rk * g_kn[80 + lane], cs = rope[0], sn = rope[1];
        Kf[64 + lane] = f2bf(x1 * cs - x2 * sn); Kf[80 + lane] = f2bf(x2 * cs + x1 * sn);
    }
}
__global__ void __launch_bounds__(256) k_gmlp(unsigned char* ws, const float* b_s) {
    const size_t i = (size_t)blockIdx.x * 256 + threadIdx.x; const int tok = (int)(i >> 9), col = (int)(i & 511), g = col >> 6, t = tok & 127, blk = tok >> 7;
    const bf16_t* wsb = (const bf16_t*)(ws + W_S) + ((size_t)g * 128 + t) * 128; const bf16_t* v = (const bf16_t*)(ws + WS_V) + (size_t)blk * 128 * 512 + col;
    float s = 0.f;
    for (int j = 0; j < 128; ++j) s += bf2f(wsb[j]) * bf2f(v[(size_t)j * 512]);
    s += b_s[g * 128 + t];
    ((bf16_t*)(ws + WS_AM))[(size_t)tok * 1024 + 512 + col] = f2bf(bf2f(((const bf16_t*)(ws + WS_U))[i]) * s);
}
__global__ void __launch_bounds__(256) k_rowstat_am(unsigned char* ws, int layer, int mode) {
    const int lane = threadIdx.x & 63, row = (blockIdx.x * 256 + threadIdx.x) >> 6;
    const bf16_t* p = (const bf16_t*)(ws + WS_AM) + (size_t)row * 1024 + (mode ? 512 : 0); float s = 0.f;
    for (int i = lane; i < 512; i += 64) { const float x = bf2f(p[i]); s += x * x; }
    s = wave_sum(s);
    if (lane == 0) { if (mode) ((float*)(ws + S_RSTDM))[row] = rsqrtf(s * (1.f / 512.f) + EPS); else ((float*)(ws + Z_SSQ))[(size_t)(8 + layer) * T + row] = s; }
    if (!mode && lane < 8) ((float*)(ws + WS_SSQAP))[(size_t)lane * T + row] = lane == 0 ? s : 0.f;
}
__global__ void __launch_bounds__(256) k_norm_m(unsigned char* ws) {
    const size_t i = (size_t)blockIdx.x * 256 + threadIdx.x; const int row = (int)(i >> 9), c = (int)(i & 511);
    bf16_t* p = (bf16_t*)(ws + WS_AM) + (size_t)row * 1024 + 512 + c; *p = f2bf(bf2f(*p) * ((const float*)(ws + S_RSTDM))[row]);
}
__global__ void __launch_bounds__(256) k_tobf16(const float* scr, bf16_t* out) { const size_t i = (size_t)blockIdx.x * 256 + threadIdx.x; out[i] = f2bf(scr[i]); }
__global__ void __launch_bounds__(64) k_attn(unsigned char* ws, const float* g_qn) {
    const int t = (blockIdx.x & 31) * 64 + threadIdx.x, bh = blockIdx.x >> 5, h = bh & 7, b = bh >> 3, row = b * 2048 + t;
    const bf16_t* qr = (const bf16_t*)(ws + WS_Q) + (size_t)row * 768 + h * 96;
    float q[96]; float ss = 0.f;
#pragma unroll
    for (int d = 0; d < 96; ++d) { q[d] = bf2f(qr[d]); ss += q[d] * q[d]; }
    const float rq = rsqrtf(ss * (1.f / 96.f) + EPS);
#pragma unroll
    for (int d = 0; d < 96; ++d) q[d] = q[d] * rq * g_qn[d];
    const float* rope = (const float*)(ws + S_ROPE) + (size_t)t * 32;
#pragma unroll
    for (int i = 0; i < 16; ++i) { const float cs = rope[2 * i], sn = rope[2 * i + 1], x1 = q[64 + i], x2 = q[80 + i]; q[64 + i] = x1 * cs - x2 * sn; q[80 + i] = x2 * cs + x1 * sn; }
#pragma unroll
    for (int d = 0; d < 96; ++d) q[d] *= SM_SCALE;
    float o[64];
#pragma unroll
    for (int d = 0; d < 64; ++d) o[d] = 0.f;
    float m = -1e30f, l = 0.f;
    const int nk = ((t >> 6) + 1) * 64;
    const bf16_t* Kb = (const bf16_t*)(ws + WS_K) + (size_t)(b * 2048) * 768 + h * 96; const bf16_t* Vb = (const bf16_t*)(ws + WS_VF) + (size_t)(b * 2048) * 512 + h * 64;
    for (int j = 0; j < nk; ++j) {
        const bf16_t* kr = Kb + (size_t)j * 768; float s = 0.f;
#pragma unroll
        for (int d = 0; d < 96; ++d) s += q[d] * bf2f(kr[d]);
        const float mn = fmaxf(m, s), f = __expf(m - mn), pp = __expf(s - mn);
        l = l * f + pp; m = mn;
        const bf16_t* vr = Vb + (size_t)j * 512;
#pragma unroll
        for (int d = 0; d < 64; ++d) o[d] = o[d] * f + pp * bf2f(vr[d]);
    }
    const float il = 1.f / l; bf16_t* out = (bf16_t*)(ws + WS_AM) + (size_t)row * 1024 + h * 64;
#pragma unroll
    for (int d = 0; d < 64; ++d) out[d] = f2bf(o[d] * il);
}
__global__ void __launch_bounds__(256) k_post4(const float* scr, unsigned char* ws, int layer, const bf16_t* Xin, bf16_t* Xout) {
    const size_t i = (size_t)blockIdx.x * 256 + threadIdx.x; const int row = (int)(i >> 10);
    const float ra = rsqrtf(((const float*)(ws + Z_SSQ))[(size_t)(8 + layer) * T + row] * (1.f / 512.f) + EPS);
    Xout[i] = f2bf(bf2f(Xin[i]) + ra * scr[i] + scr[(size_t)T * 1024 + i]);
}
__global__ void __launch_bounds__(256) k_router(unsigned char* ws, int layer, const bf16_t* X) {
    const int lane = threadIdx.x & 63, tok = (blockIdx.x * 256 + threadIdx.x) >> 6;
    const bf16_t* xr = X + (size_t)tok * 1024; const bf16_t* hi = (const bf16_t*)(ws + W_R); const bf16_t* lo = hi + 64 * 1024;
    float xv[16]; float ss = 0.f;
#pragma unroll
    for (int j = 0; j < 16; ++j) { xv[j] = bf2f(xr[lane + 64 * j]); ss += xv[j] * xv[j]; }
    ss = wave_sum(ss); const float rstd = rsqrtf(ss * (1.f / 1024.f) + EPS);
    float lg[36];
#pragma unroll
    for (int n = 0; n < 36; ++n) { float s = 0.f;
#pragma unroll
        for (int j = 0; j < 16; ++j) s += xv[j] * (bf2f(hi[n * 1024 + lane + 64 * j]) + bf2f(lo[n * 1024 + lane + 64 * j]));
        lg[n] = wave_sum(s) * rstd; }
    if (lane == 0) {
        int gs = 0; float gm = lg[0];
#pragma unroll
        for (int g = 1; g < 4; ++g) if (lg[g] > gm) { gm = lg[g]; gs = g; }
        float den = 0.f;
#pragma unroll
        for (int g = 0; g < 4; ++g) den += __expf(lg[g] - gm);
        const float psel = 1.f / den;
        float le[8];
#pragma unroll
        for (int i = 0; i < 8; ++i) le[i] = gs == 0 ? lg[4 + i] : gs == 1 ? lg[12 + i] : gs == 2 ? lg[20 + i] : lg[28 + i];
        int i0 = 0; float v0 = le[0];
#pragma unroll
        for (int i = 1; i < 8; ++i) if (le[i] > v0) { v0 = le[i]; i0 = i; }
        int i1 = -1; float v1 = -3.0e38f;
#pragma unroll
        for (int i = 0; i < 8; ++i) if (i != i0 && le[i] > v1) { v1 = le[i]; i1 = i; }
        const float e1 = __expf(v1 - v0), g0 = psel / (1.f + e1), g1 = psel * e1 / (1.f + e1);
        int* cnt = (int*)(ws + Z_CNT) + layer * 64; int* stok = (int*)(ws + S_SLOTTOK); float* srs = (float*)(ws + S_SLOTRSTD); float* sg = (float*)(ws + S_SLOTGATE);
        const int ea = gs * 8 + i0, eb = gs * 8 + i1;
        const int pa = atomicAdd(cnt + ea, 1), pb = atomicAdd(cnt + eb, 1);
        stok[(size_t)ea * T + pa] = tok; srs[(size_t)ea * T + pa] = rstd; sg[(size_t)ea * T + pa] = g0;
        stok[(size_t)eb * T + pb] = tok | (1 << 30); srs[(size_t)eb * T + pb] = rstd; sg[(size_t)eb * T + pb] = g1;
    }
}
__global__ void __launch_bounds__(256) k_build(unsigned char* ws, int layer) {
    __shared__ int pbase[33], cnts[32];
    const int* cnt = (const int*)(ws + Z_CNT) + layer * 64;
    if (threadIdx.x == 0) { int b = 0; for (int e = 0; e < 32; ++e) { cnts[e] = cnt[e]; pbase[e] = b; b += (cnt[e] + 255) / 256 * 256; } pbase[32] = b; }
    __syncthreads();
    int* gidx = (int*)(ws + S_FLAT); float* fgate = (float*)(gidx + MAXSLOT); float* frstd = fgate + MAXSLOT; int* tile_e = (int*)(frstd + MAXSLOT); int* ftok = tile_e + MAXSLOT / 128; int* nrows = ftok + MAXSLOT;
    const int* stok = (const int*)(ws + S_SLOTTOK); const float* srs = (const float*)(ws + S_SLOTRSTD); const float* sg = (const float*)(ws + S_SLOTGATE);
    if (threadIdx.x == 0) nrows[0] = pbase[32];
    for (int e = 0; e < 32; ++e) {
        const int n = pbase[e + 1] - pbase[e];
        for (int i = threadIdx.x; i < n; i += 256) {
            const int s = pbase[e] + i; const bool ok = i < cnts[e];
            const int tk = ok ? stok[(size_t)e * T + i] : -1;
            gidx[s] = ok ? (tk & 0x3fffffff) : 0; ftok[s] = tk; fgate[s] = ok ? sg[(size_t)e * T + i] : 0.f; frstd[s] = ok ? srs[(size_t)e * T + i] : 0.f;
            if ((i & 127) == 0) tile_e[s >> 7] = e;
        }
    }
}
__global__ void __launch_bounds__(256) k_post6(const float* scr, unsigned char* ws) {
    const int* gidx = (const int*)(ws + S_FLAT); const float* frstd = (const float*)(gidx + 2 * MAXSLOT); const int* nrows = gidx + 3 * MAXSLOT + MAXSLOT / 128 + MAXSLOT;
    const size_t i = (size_t)blockIdx.x * 256 + threadIdx.x; const int slot = (int)(i >> 9), j = (int)(i & 511);
    if (slot >= nrows[0]) return;
    const float rs = frstd[slot]; const float* s = scr + (size_t)slot * 1024 + 8 * (j >> 2) + (j & 3);
    ((bf16_t*)(ws + WS_H))[i] = f2bf(silu_f(rs * s[0]) * (rs * s[4]));
}
__global__ void __launch_bounds__(256) k_post7(const float* scr, unsigned char* ws, const bf16_t* X1) {
    const int* gidx = (const int*)(ws + S_FLAT); const float* fgate = (const float*)(gidx + MAXSLOT); const int* ftok = gidx + 3 * MAXSLOT + MAXSLOT / 128; const int* nrows = ftok + MAXSLOT;
    const size_t i = (size_t)blockIdx.x * 256 + threadIdx.x; const int slot = (int)(i >> 10), n = (int)(i & 1023);
    if (slot >= nrows[0]) return;
    const int tk = ftok[slot]; if (tk < 0) return;
    const int tok = tk & 0x3fffffff, k = tk >> 30;
    const float v = fgate[slot] * scr[i];
    if (k == 0) ((bf16_t*)(ws + WS_Y0))[(size_t)tok * 1024 + n] = f2bf(bf2f(X1[(size_t)tok * 1024 + n]) + v);
    else ((bf16_t*)(ws + WS_Y1))[(size_t)tok * 1024 + n] = f2bf(v);
}
__global__ void __launch_bounds__(256) k_combine(unsigned char* ws, bf16_t* Xout) {
    const int lane = threadIdx.x & 63, row = (blockIdx.x * 256 + threadIdx.x) >> 6;
    const bf16_t* y0 = (const bf16_t*)(ws + WS_Y0) + (size_t)row * 1024; const bf16_t* y1 = (const bf16_t*)(ws + WS_Y1) + (size_t)row * 1024; float s = 0.f;
    for (int i = lane; i < 1024; i += 64) { const float v = bf2f(y0[i]) + bf2f(y1[i]); const bf16_t r = f2bf(v); Xout[(size_t)row * 1024 + i] = r; const float vr = bf2f(r); s += vr * vr; }
    s = wave_sum(s); if (lane == 0) ((float*)(ws + S_RSTD2))[row] = rsqrtf(s * (1.f / 1024.f) + EPS);
}
__global__ void __launch_bounds__(256) k_post9(const float* scr, unsigned char* ws, int layer, const bf16_t* Xin, bf16_t* Xout, float* fout, const float* b_pg) {
    const int lane = threadIdx.x & 63, row = (blockIdx.x * 256 + threadIdx.x) >> 6;
    const float rs = ((const float*)(ws + S_RSTD2))[row]; const bf16_t* e = (const bf16_t*)(ws + WS_E) + (size_t)row * 1024; float s = 0.f;
    for (int i = lane; i < 1024; i += 64) {
        const size_t o = (size_t)row * 1024 + i;
        const float v = bf2f(Xin[o]) + bf2f(e[i]) * sigmoid_f(rs * scr[o] + b_pg[i]);
        Xout[o] = f2bf(v); if (fout) fout[o] = v; s += v * v;
    }
    s = wave_sum(s); if (lane == 0) ((float*)(ws + Z_SSQ))[(size_t)(12 + layer + 1) * T + row] = s;
    if (lane < 16) ((float*)(ws + WS_SSQHP))[(size_t)lane * T + row] = lane == 0 ? s : 0.f;
}

#define LAS __attribute__((address_space(3)))
#define FILL_LAYERW(L, LF) \
            L.g_mix = LF(2, 1024); L.w_in = LF(3, 1024 * 1440); L.g_cq = LF(4, 256); L.g_ckv = LF(5, 128); L.w_uq = LF(6, 256 * 768); L.w_ukv = LF(7, 128 * 1024); \
            L.g_qn = LF(8, 96); L.g_kn = LF(9, 96); L.g_v = LF(10, 512); L.w_s = LF(11, 8 * 128 * 128); L.b_s = LF(12, 8 * 128); L.g_oa = LF(13, 512); L.g_om = LF(14, 512); \
            L.w_out = LF(15, 1024 * 1024); L.g_ffn = LF(16, 1024); L.w_rg = LF(17, 1024 * 4); L.w_re = LF(18, 1024 * 32); \
            L.w1 = LF(19, (size_t)32 * 1024 * 512); L.w3 = LF(20, (size_t)32 * 1024 * 512); L.w2 = LF(21, (size_t)32 * 512 * 1024); \
            L.g_ple = LF(22, 1024); L.w_pg = LF(23, 1024 * 1024); L.b_pg = LF(24, 1024); L.w_ple = LF(25, 256 * 1024);
typedef float f32x16 __attribute__((ext_vector_type(16)));
typedef short v4i16_t __attribute__((ext_vector_type(4)));
constexpr int NWAVES = 8, NTHREADS = 512;
constexpr int BM = 256, BK = 64, HALF = 128, HTB = HALF * BK * 2, NXCD = 8, WGM = 8;
constexpr int RING_BYTES = 131072, MAXU = 5;
constexpr int TABF_OFF = RING_BYTES, TABI_OFF = TABF_OFF + MAXU * 1024, TABG_OFF = TABI_OFF + MAXU * 1024;
constexpr int MISC_OFF = TABG_OFF + MAXU * 1024;
constexpr int LDS_BYTES = 155648;
constexpr int PTR_OFF = MISC_OFF + 1792;
static_assert(MISC_OFF + 384 + 320 * 4 <= PTR_OFF && PTR_OFF + 26 * 8 <= LDS_BYTES, "LDS map");
#define GAS __attribute__((address_space(1)))
__device__ __forceinline__ const float* lds_inptr(const LAS unsigned long long* tab, int i) {
    const unsigned long long v = tab[i]; const unsigned lo = __builtin_amdgcn_readfirstlane((unsigned)v), hi = __builtin_amdgcn_readfirstlane((unsigned)(v >> 32));
    return (const float*)(const GAS float*)(((unsigned long long)hi << 32) | lo);
}

__host__ __device__ __forceinline__ int lds_byte(int r, int c) { const int st = (r >> 4) * 2 + (c >> 5), rr = r & 15, cc = c & 31, ob = rr * 64 + cc * 2; return st * 1024 + (ob ^ (((ob >> 9) & 1) << 5)); }
__host__ __device__ __forceinline__ void stage_rc(int b, int& R, int& C) { const int st = b / 1024, sb = b % 1024, swz = sb ^ (((sb >> 9) & 1) << 5); R = (st >> 1) * 16 + swz / 64; C = (st & 1) * 32 + (swz % 64) / 2; }
__host__ __device__ __forceinline__ int perm32(int rho) { const int n = rho >> 4, i = rho & 15; return 8 * (i >> 2) + 4 * n + (i & 3); }
typedef float f32x2_t __attribute__((ext_vector_type(2))); typedef __bf16 bf16x2_t __attribute__((ext_vector_type(2)));
__device__ __forceinline__ unsigned cvt_pk_bf16(float lo, float hi) { f32x2_t v = {lo, hi}; bf16x2_t b = __builtin_convertvector(v, bf16x2_t); return __builtin_bit_cast(unsigned, b); }
__device__ __forceinline__ u32x4 pack8(const f32x4 a, const f32x4 b) { u32x4 w; w.x = cvt_pk_bf16(a[0], a[1]); w.y = cvt_pk_bf16(a[2], a[3]); w.z = cvt_pk_bf16(b[0], b[1]); w.w = cvt_pk_bf16(b[2], b[3]); return w; }
__device__ __forceinline__ f32x4 unpack_lo(u32x2 w) { return (f32x4){__uint_as_float(w.x << 16), __uint_as_float(w.x & 0xffff0000u), __uint_as_float(w.y << 16), __uint_as_float(w.y & 0xffff0000u)}; }
__device__ __forceinline__ f32x4 unpack_fp8x4(unsigned w) { typedef float f2 __attribute__((ext_vector_type(2))); const f2 lo = __builtin_amdgcn_cvt_pk_f32_fp8((int)w, false), hi = __builtin_amdgcn_cvt_pk_f32_fp8((int)w, true); return (f32x4){lo[0], lo[1], hi[0], hi[1]}; }
__device__ __forceinline__ float red4(float s) { s += __shfl_xor(s, 16); s += __shfl_xor(s, 32); return s; }
__device__ __forceinline__ float sq4(const f32x4 v) { return (v[0] * v[0] + v[1] * v[1]) + (v[2] * v[2] + v[3] * v[3]); }

__device__ __forceinline__ int opaque_v(int x) { asm volatile("" : "+v"(x)); return x; }
__device__ __forceinline__ int my_tid(int wv) { unsigned mk = ~0u; asm volatile("" : "+s"(mk)); return wv * 64 + (int)__builtin_amdgcn_mbcnt_hi(mk, __builtin_amdgcn_mbcnt_lo(mk, 0u)); }
struct Unit { int pm, pn, ti, e; };
struct SchedStatic {
    int nM, nN, nwg, G, c; const char* A; const char* B; size_t tstep;
    __device__ __forceinline__ void init(int M, int N, int K, int G_, int c_, const void* A_, const void* B_) { nM = M / BM; nN = N / BM; nwg = nM * nN; G = G_; c = c_; A = (const char*)A_; B = (const char*)B_; tstep = (size_t)BM * K * 2; }
    __device__ __forceinline__ bool next(int i, Unit& u) const {
        const long L = (long)i * G + c; if (L >= nwg) return false;
        int wgid = (int)L; { const int q = nwg / NXCD, r = nwg % NXCD, xcd = wgid % NXCD, off = wgid / NXCD; wgid = (xcd < r ? xcd * (q + 1) : r * (q + 1) + (xcd - r) * q) + off; }
        const int nig = WGM * nN, gid = wgid / nig, fm = gid * WGM, gsz = (nM - fm) < WGM ? (nM - fm) : WGM;
        u.pm = fm + ((wgid % nig) % gsz); u.pn = (wgid % nig) / gsz; u.ti = i; u.e = 0; return true;
    }
    __device__ __forceinline__ const char* aptr(const Unit& u) const { return A + (size_t)u.pm * tstep; }
    __device__ __forceinline__ const char* bptr(const Unit& u) const { return B + (size_t)u.pn * tstep; }
};
struct SchedE : SchedStatic {
    __device__ __forceinline__ bool next(int i, Unit& u) const {
        if ((G & 7) != 0 || G != 256) return SchedStatic::next(i, u);
        const int xcd = c & 7, rank = c >> 3, j = rank < 16 ? (i == 0 ? rank : -1) : (i < 3 ? 16 + (rank - 16) * 3 + i : -1);
        if (j < 0) return false;
        const int wgid = xcd * (nwg / NXCD) + j;
        const int nig = WGM * nN, gid = wgid / nig, fm = gid * WGM, gsz = (nM - fm) < WGM ? (nM - fm) : WGM;
        u.pm = fm + ((wgid % nig) % gsz); u.pn = (wgid % nig) / gsz; u.ti = i; u.e = 0; return true;
    }
};
struct SchedMoe {
    int ntiles, G, c; const LAS int* te; const char* A; const char* B; size_t astep, bestep, bnstep;
    __device__ __forceinline__ bool next(int i, Unit& u) const {
        int pm, pn;
        if ((G & 7) == 0) {
            const int x = c & 7, r = c >> 3, per = G >> 3, t0 = (ntiles * x) >> 3, t1 = (ntiles * (x + 1)) >> 3, j = i * per + r;
            if (j >= (t1 - t0) * 4) return false;
            pm = t0 + (j >> 2); pn = j & 3;
        } else { const int L = i * G + c; if (L >= ntiles * 4) return false; pm = L >> 2; pn = L & 3; }
        u.pm = pm; u.pn = pn; u.ti = i; u.e = __builtin_amdgcn_readfirstlane(te[pm]); return true;
    }
    __device__ __forceinline__ const char* aptr(const Unit& u) const { return A + (size_t)u.pm * astep; }
    __device__ __forceinline__ const char* bptr(const Unit& u) const { return B + (size_t)u.e * bestep + (size_t)u.pn * bnstep; }
};

typedef int i32x8 __attribute__((ext_vector_type(8)));
typedef int i32x4v __attribute__((ext_vector_type(4)));
template <class Epi, class Sched, bool GATHER, bool MIDK, bool FP8 = false>
__device__ __forceinline__ void gemm_phase(const int wv_, LAS unsigned char* lds, const int K, const Sched& S, const Epi& E, const LAS int* gtab) {
    const int tid = my_tid(wv_), wid = wv_, lane = tid & 63, wr = wid >> 2, wc = wid & 3, fr = lane & 15, fq = lane >> 4;
    const int nt = K / BK;
    const unsigned hstep = (unsigned)HALF * K * 2;
    unsigned vB[2], vAc[2][2];
#pragma unroll
    for (int i = 0; i < 2; ++i) { int R, C; stage_rc(tid * 16 + i * 8192, R, C); const int Rb = (R & ~31) + perm32(R & 31);
        vB[i] = (unsigned)(Rb * K + C) * 2u;
        vAc[0][i] = (unsigned)(R * K + C) * 2u; vAc[1][i] = vAc[0][i]; }
    const size_t hstepA = GATHER ? 0 : (size_t)hstep;
    const size_t kstep = (size_t)(BK * 2);
    const unsigned ldsw = (unsigned)wid * 1024u;
    const int aoff = lds_byte(wr * 64 + fr, fq * 8), boff = lds_byte(wc * 32 + fr, fq * 8);
#define G_SA(b, h) (((b) * 2 + (h)) * HTB)
#define G_SB(b, h) ((4 + (b) * 2 + (h)) * HTB)
#define G_STAGE_B(bufoff, h, ptr) do { _Pragma("unroll") for (int _i = 0; _i < 2; ++_i) \
        __builtin_amdgcn_global_load_lds((const unsigned*)((const char*)(ptr) + (size_t)(h) * hstep + (size_t)(unsigned)opaque_v((int)vB[_i])), (LAS unsigned*)(lds + (bufoff) + ldsw + _i * 8192), 16, 0, 0); } while (0)
#define G_STAGE_A(bufoff, h, ptr, NX) do { _Pragma("unroll") for (int _i = 0; _i < 2; ++_i) \
        __builtin_amdgcn_global_load_lds((const unsigned*)((const char*)(ptr) + (size_t)(h) * hstepA + (size_t)(unsigned)opaque_v((int)vAc[GATHER ? (h) : 0][_i])), (LAS unsigned*)(lds + (bufoff) + ldsw + _i * 8192), 16, 0, 0); } while (0)
#define G_LDA(dst, b, h) do { _Pragma("unroll") for (int m = 0; m < 4; ++m) _Pragma("unroll") for (int k = 0; k < 2; ++k) dst[m][k] = *(const LAS bf16x8*)(lds + G_SA(b, h) + aoff + m * 2048 + k * 1024); } while (0)
#define G_LDB(dst, b, h) do { _Pragma("unroll") for (int n = 0; n < 2; ++n) _Pragma("unroll") for (int k = 0; k < 2; ++k) dst[n][k] = *(const LAS bf16x8*)(lds + G_SB(b, h) + boff + n * 2048 + k * 1024); } while (0)
#define G_F8(F) __builtin_shufflevector(__builtin_bit_cast(i32x4v, F[0]), __builtin_bit_cast(i32x4v, F[1]), 0, 1, 2, 3, 4, 5, 6, 7)
#define G_MMA(ai, bj, At, Bt) do { __builtin_amdgcn_s_setprio(1); \
        if constexpr (FP8) { _Pragma("unroll") for (int m = 0; m < 4; ++m) _Pragma("unroll") for (int n = 0; n < 2; ++n) \
            acc[ai][bj][m][n] = __builtin_amdgcn_mfma_scale_f32_16x16x128_f8f6f4(G_F8(Bt[n]), G_F8(At[m]), acc[ai][bj][m][n], 0, 0, 0, 0, 0, 0); } \
        else { _Pragma("unroll") for (int m = 0; m < 4; ++m) _Pragma("unroll") for (int n = 0; n < 2; ++n) _Pragma("unroll") for (int k = 0; k < 2; ++k) \
            acc[ai][bj][m][n] = __builtin_amdgcn_mfma_f32_16x16x32_bf16(Bt[n][k], At[m][k], acc[ai][bj][m][n], 0, 0, 0); } \
        __builtin_amdgcn_s_setprio(0); } while (0)
#define G_WAIT_V(n) asm volatile("s_waitcnt vmcnt(" #n ")" ::: "memory")
#define G_WAIT_L(n) asm volatile("s_waitcnt lgkmcnt(" #n ")" ::: "memory")
#define G_BAR __builtin_amdgcn_s_barrier()
#define G_SCHED __builtin_amdgcn_sched_barrier(0)
#define G_LOADIDX(dst, u) do { if constexpr (GATHER) { _Pragma("unroll") for (int _h = 0; _h < 2; ++_h) _Pragma("unroll") for (int _i = 0; _i < 2; ++_i) { int R_, C_; stage_rc(tid * 16 + _i * 8192, R_, C_); \
        dst[_h][_i] = (unsigned)gtab[(u).ti * 256 + R_ + 128 * _h] * (unsigned)(K * 2) + (unsigned)C_ * 2u; } } } while (0)
    Unit cur, nxt; int ui = 0;
    if (!S.next(0, cur)) return;
    G_LOADIDX(vAc, cur);
    f32x4 acc[2][2][4][2];
#pragma unroll
    for (int a = 0; a < 2; ++a)
#pragma unroll
        for (int b = 0; b < 2; ++b)
#pragma unroll
            for (int m = 0; m < 4; ++m)
#pragma unroll
                for (int n = 0; n < 2; ++n) acc[a][b][m][n] = (f32x4){0.f, 0.f, 0.f, 0.f};
    bf16x8 At[4][2], B0[2][2], B1[2][2];
    const char* cA = S.aptr(cur); const char* cB = S.bptr(cur);
    G_STAGE_B(G_SB(0, 0), 0, cB); G_STAGE_B(G_SB(0, 1), 1, cB); G_STAGE_A(G_SA(0, 0), 0, cA, false); G_STAGE_A(G_SA(0, 1), 1, cA, false);
    if (wr == 1) G_BAR;
    G_WAIT_V(2); G_BAR;
    G_STAGE_B(G_SB(1, 0), 0, cB + kstep); G_STAGE_A(G_SA(1, 0), 0, cA + kstep, false); G_STAGE_B(G_SB(1, 1), 1, cB + kstep);
    G_WAIT_V(6); G_BAR;
    for (;;) {
        const bool has_next = S.next(ui + 1, nxt);
        const char* nA = has_next ? S.aptr(nxt) : cA; const char* nB = has_next ? S.bptr(nxt) : cB;
#pragma unroll 1
        for (int t = 0; t < nt; t += 2) {
            const bool last = (t == nt - 2);
            const char* a1 = cA + (size_t)(t + 1) * kstep;
            const char* a2 = last ? nA : cA + (size_t)(t + 2) * kstep; const char* b2 = last ? nB : cB + (size_t)(t + 2) * kstep;
            const char* a3 = a2 + kstep; const char* b3 = b2 + kstep;
            if constexpr (MIDK) { if (t == (nt >> 1)) { const int l2 = my_tid(wv_) & 63; E.midk(acc, cur, wr, l2 & 15); } }
            G_LDB(B0, 0, 0); G_LDB(B1, 0, 1); G_SCHED; G_LDA(At, 0, 0); G_STAGE_A(G_SA(1, 1), 1, a1, false);
            if constexpr (GATHER) { if (last && has_next) { G_LOADIDX(vAc, nxt); } }
            G_WAIT_V(8); G_WAIT_L(0); G_BAR; G_MMA(0, 0, At, B0); G_MMA(0, 1, At, B1); G_BAR; G_SCHED;
            G_LDA(At, 0, 1); G_STAGE_B(G_SB(0, 0), 0, b2); G_STAGE_B(G_SB(0, 1), 1, b2); G_STAGE_A(G_SA(0, 0), 0, a2, last);
            G_WAIT_V(8); G_WAIT_L(0); G_BAR; G_MMA(1, 0, At, B0); G_MMA(1, 1, At, B1); G_BAR; G_SCHED;
            G_LDB(B0, 1, 0); G_LDB(B1, 1, 1); G_SCHED; G_LDA(At, 1, 0); G_STAGE_A(G_SA(0, 1), 1, a2, last);
            G_WAIT_V(8); G_WAIT_L(0); G_BAR; G_MMA(0, 0, At, B0); G_MMA(0, 1, At, B1); G_BAR; G_SCHED;
            G_LDA(At, 1, 1); G_STAGE_B(G_SB(1, 0), 0, b3); G_STAGE_B(G_SB(1, 1), 1, b3); G_STAGE_A(G_SA(1, 0), 0, a3, last);
            G_WAIT_V(8); G_WAIT_L(0); G_BAR; G_MMA(1, 0, At, B0); G_MMA(1, 1, At, B1); G_BAR; G_SCHED;
        }
        if (wr == 0) G_BAR;
        { const int l2 = my_tid(wv_) & 63; E(acc, cur, wr, wc, l2 & 15, l2 >> 4); }
        if (!has_next) break;
#pragma unroll
        for (int a = 0; a < 2; ++a)
#pragma unroll
            for (int b = 0; b < 2; ++b)
#pragma unroll
                for (int m = 0; m < 4; ++m)
#pragma unroll
                    for (int n = 0; n < 2; ++n) acc[a][b][m][n] = (f32x4){0.f, 0.f, 0.f, 0.f};
        cur = nxt; cA = nA; cB = nB; ++ui;
        if (wr == 1) G_BAR;
    }
    G_WAIT_V(0);
    G_BAR;
#undef G_SA
#undef G_SB
#undef G_STAGE_A
#undef G_STAGE_B
#undef G_LDA
#undef G_LDB
#undef G_MMA
#undef G_F8
#undef G_WAIT_V
#undef G_WAIT_L
#undef G_BAR
#undef G_SCHED
#undef G_LOADIDX
}

#define EPI_ROWLOOP _Pragma("unroll") for (int ai = 0; ai < 2; ++ai) _Pragma("unroll") for (int m = 0; m < 4; ++m)
typedef f32x4 acc_t[2][2][4][2];
template <class TP> __device__ __forceinline__ TP* offp(TP* base, unsigned off) { return base + (size_t)off; }
struct Epi1 {
    bf16_t *cq, *ckv, *ub, *vb; const float* g_v; const LAS float* tabf;
    __device__ __forceinline__ void operator()(const acc_t& acc, const Unit& u, int wr, int wc, int fr, int fq) const {
        const LAS float* tf = tabf + u.ti * 256;
        const unsigned lc = wc * 32 + 8 * fq, rt0 = wr * 64 + fr, row0 = (unsigned)u.pm * BM + rt0;
        if (u.pn == 0) {
            EPI_ROWLOOP { const unsigned rt = rt0 + ai * HALF + m * 16, row = row0 + ai * HALF + m * 16; const float rs = tf[rt];
                const f32x4 v00 = acc[ai][0][m][0] * rs, v01 = acc[ai][0][m][1] * rs, v10 = acc[ai][1][m][0] * rs, v11 = acc[ai][1][m][1] * rs;
                *(u32x4*)offp(cq, row * 256 + lc) = pack8(v00, v01); *(u32x4*)offp(cq, row * 256 + HALF + lc) = pack8(v10, v11); }
        } else if (u.pn == 1) {
            EPI_ROWLOOP { const unsigned rt = rt0 + ai * HALF + m * 16, row = row0 + ai * HALF + m * 16; const float rs = tf[rt];
                const f32x4 v00 = acc[ai][0][m][0] * rs, v01 = acc[ai][0][m][1] * rs, v10 = acc[ai][1][m][0] * rs, v11 = acc[ai][1][m][1] * rs;
                *(u32x4*)offp(ckv, row * 256 + lc) = pack8(v00, v01); *(u32x4*)offp(ckv, row * 256 + HALF + lc) = pack8(v10, v11); }
        } else if (u.pn < 4) {
            const unsigned cb = (u.pn - 2) * 256 + lc;
            EPI_ROWLOOP { const unsigned rt = rt0 + ai * HALF + m * 16, row = row0 + ai * HALF + m * 16; const float rs = tf[rt];
#pragma unroll
                for (int bj = 0; bj < 2; ++bj) { f32x4 a = acc[ai][bj][m][0] * rs, b = acc[ai][bj][m][1] * rs;
#pragma unroll
                    for (int i = 0; i < 4; ++i) { a[i] = gelu_tanh(a[i]); b[i] = gelu_tanh(b[i]); }
                    *(u32x4*)offp(ub, row * 512 + cb + bj * HALF) = pack8(a, b); } }
        } else {
            const unsigned grp = 4 * (u.pn - 4) + wc, cb = (u.pn - 4) * 256 + 64 * wc + 8 * fq;
            const f32x4 g00 = *(const f32x4*)(g_v + grp * 64 + 8 * fq), g01 = *(const f32x4*)(g_v + grp * 64 + 8 * fq + 4), g10 = *(const f32x4*)(g_v + grp * 64 + 32 + 8 * fq), g11 = *(const f32x4*)(g_v + grp * 64 + 32 + 8 * fq + 4);
            EPI_ROWLOOP { const unsigned rt = rt0 + ai * HALF + m * 16, row = row0 + ai * HALF + m * 16; const float rs = tf[rt];
                f32x4 v00 = acc[ai][0][m][0] * rs, v01 = acc[ai][0][m][1] * rs, v10 = acc[ai][1][m][0] * rs, v11 = acc[ai][1][m][1] * rs;
#pragma unroll
                for (int i = 0; i < 4; ++i) { v00[i] = gelu_tanh(v00[i]); v01[i] = gelu_tanh(v01[i]); v10[i] = gelu_tanh(v10[i]); v11[i] = gelu_tanh(v11[i]); }
                const float s = red4(sq4(v00) + sq4(v01) + sq4(v10) + sq4(v11));
                const float rg = rsqrtf(s * (1.f / 64.f) + EPS);
                *(u32x4*)offp(vb, row * 512 + cb) = pack8(v00 * rg * g00, v01 * rg * g01); *(u32x4*)offp(vb, row * 512 + cb + 32) = pack8(v10 * rg * g10, v11 * rg * g11); }
        }
    }
};
template <bool SCALE> struct EpiStore {
    bf16_t* out; int ldc; const LAS float* tabf;
    __device__ __forceinline__ void operator()(const acc_t& acc, const Unit& u, int wr, int wc, int fr, int fq) const {
        const LAS float* tf = tabf + u.ti * 256;
        const unsigned rt0 = wr * 64 + fr, o0 = ((unsigned)u.pm * BM + rt0) * (unsigned)ldc + u.pn * BM + wc * 32 + 8 * fq;
        EPI_ROWLOOP { const unsigned rt = rt0 + ai * HALF + m * 16, o = o0 + (unsigned)(ai * HALF + m * 16) * (unsigned)ldc; const float rs = SCALE ? tf[rt] : 1.f;
#pragma unroll
            for (int bj = 0; bj < 2; ++bj) *(u32x4*)offp(out, o + bj * HALF) = pack8(acc[ai][bj][m][0] * rs, acc[ai][bj][m][1] * rs); }
    }
};
constexpr float E8_SCALE = 16.f, E8_INV = 1.f / 16.f;
struct EpiStoreF8 {
    unsigned char* out; int ldc;
    __device__ __forceinline__ void operator()(const acc_t& acc, const Unit& u, int wr, int wc, int fr, int fq) const {
        const unsigned rt0 = wr * 64 + fr, o0 = ((unsigned)u.pm * BM + rt0) * (unsigned)ldc + u.pn * BM + wc * 32 + 8 * fq;
        EPI_ROWLOOP { const unsigned o = o0 + (unsigned)(ai * HALF + m * 16) * (unsigned)ldc;
#pragma unroll
            for (int bj = 0; bj < 2; ++bj) { const f32x4 a = acc[ai][bj][m][0] * E8_SCALE, b = acc[ai][bj][m][1] * E8_SCALE; u32x2 q; q.x = pk4_fp8(a[0], a[1], a[2], a[3]); q.y = pk4_fp8(b[0], b[1], b[2], b[3]);
                *(u32x2*)offp(out, o + bj * HALF) = q; } }
    }
};
struct Epi2b {
    bf16_t *Kf, *Vf; const bf16_t* ckv; const float* g_kn; const float* rope; const LAS float* tabf; const LAS float* tabg;
    __device__ __forceinline__ void operator()(const acc_t& acc, const Unit& u, int wr, int wc, int fr, int fq) const {
        const LAS float* tf = tabf + u.ti * 256; const LAS float* tg = tabg + u.ti * 256;
        const unsigned head = 2 * u.pn + (wc >> 1), rt0 = wr * 64 + fr, row0 = (unsigned)u.pm * BM + rt0;
        if (wc & 1) {
            EPI_ROWLOOP { const unsigned rt = rt0 + ai * HALF + m * 16, row = row0 + ai * HALF + m * 16; const float rs = tf[rt];
#pragma unroll
                for (int bj = 0; bj < 2; ++bj) *(u32x4*)offp(Vf, row * 512 + head * 64 + 32 * bj + 8 * fq) = pack8(acc[ai][bj][m][0] * rs, acc[ai][bj][m][1] * rs); }
        } else {
            const f32x4 g00 = *(const f32x4*)(g_kn + 8 * fq), g01 = *(const f32x4*)(g_kn + 8 * fq + 4), g10 = *(const f32x4*)(g_kn + 32 + 8 * fq), g11 = *(const f32x4*)(g_kn + 32 + 8 * fq + 4);
            const f32x4 gr1 = *(const f32x4*)(g_kn + 64 + 4 * fq), gr2 = *(const f32x4*)(g_kn + 80 + 4 * fq);
#pragma unroll
            for (int ai = 0; ai < 2; ++ai)
#pragma unroll
            for (int mp = 0; mp < 2; ++mp) {
                u32x2 kr1[2], kr2[2]; f32x4 rp0[2], rp1[2];
#pragma unroll
                for (int mm = 0; mm < 2; ++mm) { const unsigned row = row0 + ai * HALF + (2 * mp + mm) * 16;
                    kr1[mm] = *(const u32x2*)offp(ckv, row * 256 + 128 + 4 * fq); kr2[mm] = *(const u32x2*)offp(ckv, row * 256 + 144 + 4 * fq);
                    const float* rp = offp(rope, ((row & 2047u) * 16 + 4 * fq) * 2); rp0[mm] = *(const f32x4*)rp; rp1[mm] = *(const f32x4*)(rp + 4); }
#pragma unroll
                for (int mm = 0; mm < 2; ++mm) { const int m = 2 * mp + mm; const unsigned rt = rt0 + ai * HALF + m * 16, row = row0 + ai * HALF + m * 16; const float rs = tf[rt];
                    const f32x4 v00 = acc[ai][0][m][0] * rs, v01 = acc[ai][0][m][1] * rs, v10 = acc[ai][1][m][0] * rs, v11 = acc[ai][1][m][1] * rs;
                    const float s = red4(sq4(v00) + sq4(v01) + sq4(v10) + sq4(v11));
                    const float rk = rsqrtf((s + tg[rt]) * (1.f / 96.f) + EPS);
                    const unsigned ko = row * 768 + head * 96;
                    *(u32x4*)offp(Kf, ko + 8 * fq) = pack8(v00 * rk * g00, v01 * rk * g01); *(u32x4*)offp(Kf, ko + 32 + 8 * fq) = pack8(v10 * rk * g10, v11 * rk * g11);
                    const f32x4 x1 = unpack_lo(kr1[mm]) * rk * gr1, x2 = unpack_lo(kr2[mm]) * rk * gr2;
                    const f32x4 cs = {rp0[mm][0], rp0[mm][2], rp1[mm][0], rp1[mm][2]}, sn = {rp0[mm][1], rp0[mm][3], rp1[mm][1], rp1[mm][3]};
                    const f32x4 o1 = x1 * cs - x2 * sn, o2 = x2 * cs + x1 * sn;
                    u32x2 w1, w2; w1.x = cvt_pk_bf16(o1[0], o1[1]); w1.y = cvt_pk_bf16(o1[2], o1[3]); w2.x = cvt_pk_bf16(o2[0], o2[1]); w2.y = cvt_pk_bf16(o2[2], o2[3]);
                    *(u32x2*)offp(Kf, ko + 64 + 4 * fq) = w1; *(u32x2*)offp(Kf, ko + 80 + 4 * fq) = w2; }
                asm volatile("" ::: "memory");
            }
        }
    }
};
struct Epi4 {
    const bf16_t* Xin; bf16_t* Xout; const LAS float* tabf; unsigned char* X8;
    __device__ __forceinline__ void midk(acc_t& acc, const Unit& u, int wr, int fr) const {
        const LAS float* tf = tabf + u.ti * 256;
        EPI_ROWLOOP { const float rs = tf[ai * HALF + wr * 64 + m * 16 + fr];
#pragma unroll
            for (int bj = 0; bj < 2; ++bj)
#pragma unroll
                for (int n = 0; n < 2; ++n) acc[ai][bj][m][n] *= rs; }
    }
    __device__ __forceinline__ void operator()(const acc_t& acc, const Unit& u, int wr, int wc, int fr, int fq) const {
        const unsigned o0 = ((unsigned)u.pm * BM + wr * 64 + fr) * 1024u + u.pn * BM + wc * 32 + 8 * fq;
#pragma unroll
        for (int ai = 0; ai < 2; ++ai) {
            u32x4 x[4][2];
#pragma unroll
            for (int m = 0; m < 4; ++m)
#pragma unroll
                for (int bj = 0; bj < 2; ++bj) x[m][bj] = *(const u32x4*)offp(Xin, o0 + (unsigned)(ai * HALF + m * 16) * 1024u + bj * HALF);
#pragma unroll
            for (int m = 0; m < 4; ++m)
#pragma unroll
                for (int bj = 0; bj < 2; ++bj) { const unsigned o = o0 + (unsigned)(ai * HALF + m * 16) * 1024u + bj * HALF;
                    const f32x4 h0 = acc[ai][bj][m][0] + unpack_lo((u32x2){x[m][bj].x, x[m][bj].y}), h1 = acc[ai][bj][m][1] + unpack_lo((u32x2){x[m][bj].z, x[m][bj].w});
                    const u32x4 w = pack8(h0, h1); *(u32x4*)offp(Xout, o) = w;
                    if (X8) { const f32x4 r0 = unpack_lo((u32x2){w.x, w.y}), r1 = unpack_lo((u32x2){w.z, w.w});
                        u32x2 q; q.x = pk4_fp8(r0[0], r0[1], r0[2], r0[3]); q.y = pk4_fp8(r1[0], r1[1], r1[2], r1[3]); *(u32x2*)offp(X8, o) = q; } }
            asm volatile("" ::: "memory");
        }
    }
};
struct Epi6F8 {
    unsigned char* H; const LAS float* tabf;
    __device__ __forceinline__ void operator()(const acc_t& acc, const Unit& u, int wr, int wc, int fr, int fq) const {
        const LAS float* tf = tabf + u.ti * 256;
        const unsigned rt0 = wr * 64 + fr, o0 = ((unsigned)u.pm * BM + rt0) * 512u + 128 * u.pn + 32 * wc + 8 * fq;
        EPI_ROWLOOP { const unsigned rt = rt0 + ai * HALF + m * 16; const float rs = tf[rt] * W8_INV; u32x2 w;
#pragma unroll
            for (int bj = 0; bj < 2; ++bj) { const f32x4 g = acc[ai][bj][m][0] * rs, up = acc[ai][bj][m][1] * rs; f32x4 h;
#pragma unroll
                for (int i = 0; i < 4; ++i) h[i] = silu_f(g[i]) * up[i];
                const unsigned p = pk4_fp8(h[0], h[1], h[2], h[3]); if (bj == 0) w.x = p; else w.y = p; }
            *(u32x2*)offp(H, o0 + (unsigned)(ai * HALF + m * 16) * 512u) = w; }
    }
};
struct Epi6 {
    bf16_t* H; const LAS float* tabf;
    __device__ __forceinline__ void operator()(const acc_t& acc, const Unit& u, int wr, int wc, int fr, int fq) const {
        const LAS float* tf = tabf + u.ti * 256;
        const unsigned rt0 = wr * 64 + fr, o0 = ((unsigned)u.pm * BM + rt0) * 512u + 128 * u.pn + 16 * wc + 4 * fq;
        EPI_ROWLOOP { const unsigned rt = rt0 + ai * HALF + m * 16; const float rs = tf[rt];
#pragma unroll
            for (int bj = 0; bj < 2; ++bj) { const f32x4 g = acc[ai][bj][m][0] * rs, up = acc[ai][bj][m][1] * rs; f32x4 h;
#pragma unroll
                for (int i = 0; i < 4; ++i) h[i] = silu_f(g[i]) * up[i];
                u32x2 w; w.x = cvt_pk_bf16(h[0], h[1]); w.y = cvt_pk_bf16(h[2], h[3]);
                *(u32x2*)offp(H, o0 + (unsigned)(ai * HALF + m * 16) * 512u + 64 * bj) = w; } }
    }
};
constexpr float Y8_SCALE = 32.f, Y8_INV = 1.f / 32.f;
struct Epi7 {
    bf16_t *y0, *y1; const LAS int* tabi; const LAS float* tabg; float wscale;
    __device__ __forceinline__ void operator()(const acc_t& acc, const Unit& u, int wr, int wc, int fr, int fq) const {
        const LAS int* ti = tabi + u.ti * 256; const LAS float* tg = tabg + u.ti * 256;
        const unsigned rt0 = wr * 64 + fr, c0 = u.pn * BM + wc * 32 + 8 * fq;
#if MOE_FP8
        unsigned char* yb0 = (unsigned char*)y0; const long dy = (long)((unsigned char*)y1 - (unsigned char*)y0);
        EPI_ROWLOOP {
            const unsigned rt = rt0 + ai * HALF + m * 16; const int tk = ti[rt]; const float gt = tg[rt] * (wscale * Y8_SCALE);
            if (tk >= 0) {
                unsigned char* yb = yb0 + dy * (long)(tk >> 30); const unsigned o0 = (unsigned)(tk & 0x3fffffff) * 1024u + c0;
#pragma unroll
                for (int bj = 0; bj < 2; ++bj) { const f32x4 a = acc[ai][bj][m][0] * gt, b = acc[ai][bj][m][1] * gt; u32x2 q; q.x = pk4_fp8(a[0], a[1], a[2], a[3]); q.y = pk4_fp8(b[0], b[1], b[2], b[3]);
                    *(u32x2*)offp(yb, o0 + bj * HALF) = q; }
            }
        }
#else
        const long dy = (long)(y1 - y0);
        EPI_ROWLOOP {
            const unsigned rt = rt0 + ai * HALF + m * 16; const int tk = ti[rt]; const float gt = tg[rt] * wscale;
            if (tk >= 0) {
                bf16_t* yb = y0 + dy * (long)(tk >> 30); const unsigned o0 = (unsigned)(tk & 0x3fffffff) * 1024u + c0;
#pragma unroll
                for (int bj = 0; bj < 2; ++bj) *(u32x4*)offp(yb, o0 + bj * HALF) = pack8(acc[ai][bj][m][0] * gt, acc[ai][bj][m][1] * gt);
            }
        }
#endif
    }
};
struct Epi9 {
    const bf16_t* Xin; const unsigned char* e; bf16_t* Xout; float* fout; float* ssq; const float* b_pg; const LAS float* tabf;
    __device__ __forceinline__ void operator()(const acc_t& acc, const Unit& u, int wr, int wc, int fr, int fq) const {
        const LAS float* tf = tabf + u.ti * 256;
        const unsigned rt0 = wr * 64 + fr, row0 = (unsigned)u.pm * BM + rt0, col0 = u.pn * BM + wc * 32 + 8 * fq;
        const f32x4 b00 = *(const f32x4*)(b_pg + col0), b01 = *(const f32x4*)(b_pg + col0 + 4), b10 = *(const f32x4*)(b_pg + col0 + HALF), b11 = *(const f32x4*)(b_pg + col0 + HALF + 4);
#pragma unroll
        for (int ai = 0; ai < 2; ++ai)
#pragma unroll
            for (int mp = 0; mp < 2; ++mp) {
                u32x4 xv[2][2]; u32x2 ev[2][2];
#pragma unroll
                for (int mm = 0; mm < 2; ++mm)
#pragma unroll
                    for (int bj = 0; bj < 2; ++bj) { const unsigned o = (row0 + ai * HALF + (2 * mp + mm) * 16) * 1024u + col0 + bj * HALF; xv[mm][bj] = *(const u32x4*)offp(Xin, o); ev[mm][bj] = *(const u32x2*)offp(e, o); }
#pragma unroll
                for (int mm = 0; mm < 2; ++mm) {
                    const int m = 2 * mp + mm; const unsigned rt = rt0 + ai * HALF + m * 16, row = row0 + ai * HALF + m * 16; const float rs = tf[rt]; float s = 0.f;
#pragma unroll
                    for (int bj = 0; bj < 2; ++bj) { const unsigned o = row * 1024u + col0 + bj * HALF;
                        const u32x4 x = xv[mm][bj]; const u32x2 evv = ev[mm][bj];
                        const f32x4 b0 = bj ? b10 : b00, b1 = bj ? b11 : b01;
                        const f32x4 x0 = unpack_lo((u32x2){x.x, x.y}), x1 = unpack_lo((u32x2){x.z, x.w}), e0 = unpack_fp8x4(evv.x) * E8_INV, e1 = unpack_fp8x4(evv.y) * E8_INV;
                        f32x4 h0, h1;
#pragma unroll
                        for (int i = 0; i < 4; ++i) { h0[i] = x0[i] + e0[i] * sigmoid_f(rs * acc[ai][bj][m][0][i] + b0[i]); h1[i] = x1[i] + e1[i] * sigmoid_f(rs * acc[ai][bj][m][1][i] + b1[i]); }
                        s += sq4(h0) + sq4(h1);
                        *(u32x4*)offp(Xout, o) = pack8(h0, h1);
                        if (fout) { __builtin_nontemporal_store(h0, (f32x4*)offp(fout, o)); __builtin_nontemporal_store(h1, (f32x4*)offp(fout, o + 4)); } }
                    s = red4(s); if (fq == 0) *offp(ssq, (u.pn * 4 + wc) * (unsigned)T + row) = s;
                }
                asm volatile("" ::: "memory");
            }
    }
};

struct EpiNull {
    float* sink;
    __device__ __forceinline__ void operator()(const acc_t& acc, const Unit& u, int wr, int wc, int fr, int fq) const {
        float s = 0.f;
        EPI_ROWLOOP {
#pragma unroll
            for (int bj = 0; bj < 2; ++bj) s += acc[ai][bj][m][0][0] + acc[ai][bj][m][1][3]; }
        if (s == 1.2345e30f) sink[threadIdx.x] = s;
    }
};
struct MkArgs { const float* in[26]; float* out; unsigned char* ws; int ph_lo, ph_hi; };
struct Frame {
    LAS unsigned char* lds; unsigned char* ws; int G, vcu, c, wv;
    LAS float* tabf; LAS int* tabi; LAS float* tabg;
};
#define XB_TMO      128
#define XB_XCNT(j)  (256  + 64 * (j))
#define XB_XSUB(j)  (1280 + 64 * (j))
#define XB_XGEN(j)  (2304 + 64 * (j))
#define XB_TOP      3328
#define XB_TOPGEN   3392
#define XCD_BAR_WORDS 3456
#define XB_SPIN_CAP (1u << 18)
__device__ __forceinline__ unsigned xb_ld(unsigned* p)              { return __hip_atomic_load(p, __ATOMIC_RELAXED, __HIP_MEMORY_SCOPE_AGENT); }
__device__ __forceinline__ unsigned xb_add(unsigned* p, unsigned v) { return __hip_atomic_fetch_add(p, v, __ATOMIC_RELAXED, __HIP_MEMORY_SCOPE_AGENT); }
__device__ __forceinline__ unsigned xb_xcc_id() { return (unsigned)__builtin_amdgcn_s_getreg((3 << 11) | 20) & 0xFu; }
#define XB_SPIN(cond, bar) do { unsigned _sp = 0; while (cond) { __builtin_amdgcn_s_sleep(1); \
    if ((++_sp & 255u) == 0u) { if (xb_ld(&(bar)[XB_TMO])) break; if (_sp > XB_SPIN_CAP) { atomicAdd(&(bar)[XB_TMO], 1u); break; } } } } while (0)
struct XcdBarrier { unsigned* bar; unsigned x; volatile LAS unsigned* st; };
__device__ __forceinline__ XcdBarrier xcd_barrier_post(unsigned* bar, volatile LAS unsigned* st) {
    XcdBarrier b; b.bar = bar; b.x = xb_xcc_id(); b.st = st;
    if (threadIdx.x == 0) (void)xb_add(&bar[XB_XCNT(b.x)], 1u);
    return b;
}
__device__ __forceinline__ void xcd_barrier_complete(unsigned* bar, unsigned x, unsigned& nloc, unsigned& nx) {
    const unsigned G = gridDim.x * gridDim.y * gridDim.z;
    unsigned sum, cnt, mine, sp = 0u;
    for (;;) {
        sum = 0u; cnt = 0u; mine = 0u;
#pragma unroll
        for (unsigned j = 0; j < 16; ++j) { const unsigned c = xb_ld(&bar[XB_XCNT(j)]); sum += c; cnt += (c > 0u) ? 1u : 0u; mine = (j == x) ? c : mine; }
        if (sum == G) break;
        __builtin_amdgcn_s_sleep(1);
        if ((++sp & 255u) == 0u) { if (xb_ld(&bar[XB_TMO])) break; if (sp > XB_SPIN_CAP) { atomicAdd(&bar[XB_TMO], 1u); break; } }
    }
    nloc = mine > 0u ? mine : 1u; nx = cnt > 0u ? cnt : 1u;
}
__device__ __forceinline__ void xcd_barrier(const XcdBarrier& b, const int tid_) {
    asm volatile("s_waitcnt vmcnt(0)" ::: "memory");
    __syncthreads();
    if (tid_ == 0) {
        unsigned* bar = b.bar;
        __builtin_amdgcn_s_waitcnt(0);
        unsigned nloc = b.st[0], nx = b.st[1];
        if (nloc == 0u) { xcd_barrier_complete(bar, b.x, nloc, nx); b.st[0] = nloc; b.st[1] = nx; }
        const unsigned old = xb_add(&bar[XB_XSUB(b.x)], 1u);
        const unsigned gen = old / nloc;
        if (old + 1u == (gen + 1u) * nloc) {
            __builtin_amdgcn_fence(__ATOMIC_RELEASE, "agent");
            asm volatile("s_waitcnt vmcnt(0)" ::: "memory");
            const unsigned og = xb_add(&bar[XB_TOP], 1u);
            const unsigned tg = og / nx;
            if (og + 1u == (tg + 1u) * nx) xb_add(&bar[XB_TOPGEN], 1u);
            else XB_SPIN(xb_ld(&bar[XB_TOPGEN]) == tg, bar);
            __builtin_amdgcn_fence(__ATOMIC_ACQUIRE, "agent");
            xb_add(&bar[XB_XGEN(b.x)], 1u);
            asm volatile("s_waitcnt vmcnt(0)" ::: "memory");
        } else {
            XB_SPIN(xb_ld(&bar[XB_XGEN(b.x)]) == gen, bar);
            __builtin_amdgcn_fence(__ATOMIC_ACQUIRE, "agent");
            asm volatile("s_waitcnt vmcnt(0)" ::: "memory");
        }
    }
    __syncthreads();
}

constexpr size_t Z_LBAR = 32768;
__device__ __forceinline__ void xcc_local_barrier(unsigned* lbar, unsigned* gbar, const unsigned x, const unsigned nloc, const int tid_) {
    asm volatile("s_waitcnt vmcnt(0)" ::: "memory");
    __syncthreads();
    if (tid_ == 0) {
        __builtin_amdgcn_s_waitcnt(0);
        const unsigned old = xb_add(&lbar[64 * x], 1u), gen = old / nloc;
        if (old + 1u == (gen + 1u) * nloc) xb_add(&lbar[1024 + 64 * x], 1u);
        else XB_SPIN(xb_ld(&lbar[1024 + 64 * x]) == gen, gbar);
        __builtin_amdgcn_fence(__ATOMIC_ACQUIRE, "agent");
        asm volatile("s_waitcnt vmcnt(0)" ::: "memory");
    }
    __syncthreads();
}
template <class Sched, class FF> __device__ __forceinline__ void fill_tab_static(Frame& F, const Sched& S, const FF& ff) {
    Unit u; const int t_ = my_tid(F.wv);
    for (int i = 0; i < MAXU && S.next(i, u); ++i)
        for (int r = t_; r < 256; r += NTHREADS) ff(i, r, u.pm * 256 + r);
    __syncthreads();
}

#ifndef CV_INTERLEAVE
#define CV_INTERLEAVE 0
#endif
struct CvCtx { int stride, nl; unsigned char* wsw; const LAS unsigned long long* ptab; };
__device__ __forceinline__ void cv_stream(const CvCtx cv, int it, int lane) {
#if MOE_FP8
    convert_moe_stream(lds_inptr(cv.ptab, 19) + (size_t)cv.nl * ((size_t)32 * 1024 * 512), lds_inptr(cv.ptab, 20) + (size_t)cv.nl * ((size_t)32 * 1024 * 512), lds_inptr(cv.ptab, 21) + (size_t)cv.nl * ((size_t)32 * 512 * 1024),
                       lds_inptr(cv.ptab, 16) + (size_t)cv.nl * 1024, cv.wsw, it, cv.stride, lane);
#endif
}
__device__ __forceinline__ float max3f(float a, float b, float c) { float r; asm("v_max3_f32 %0, %1, %2, %3" : "=v"(r) : "v"(a), "v"(b), "v"(c)); return r; }
constexpr int AK_STRIDE = 208, AV_STRIDE = 144, AK_BYTES = 64 * AK_STRIDE, ABUF = AK_BYTES + 64 * AV_STRIDE;
template <int VAR = 0> __device__ __forceinline__ void attn_unit(Frame& F, int b, int h, int qb, const bf16_t* qraw, const bf16_t* Kf, const bf16_t* Vf, bf16_t* am, float* ssq_a, const float* g_qn, const float* rope, const CvCtx cv, int& cv_it, int& cv_iter) {
    const int tid = my_tid(F.wv), lane = tid & 63, wid = __builtin_amdgcn_readfirstlane(tid >> 6), r32 = lane & 31, hi = lane >> 5;
    const int q0 = qb * 256 + wid * 32; const size_t row = (size_t)b * 2048 + q0 + r32;
    bf16x8 qf[6];
    {
        float qv[6][8]; float ss = 0.f; const bf16_t* qp = qraw + row * 768 + h * 96 + 8 * hi;
#pragma unroll
        for (int d0 = 0; d0 < 6; ++d0) { const bf16x8 raw = *(const bf16x8*)(qp + 16 * d0);
#pragma unroll
            for (int j = 0; j < 8; ++j) { qv[d0][j] = bf2f((bf16_t)raw[j]); ss += qv[d0][j] * qv[d0][j]; } }
        ss += __shfl_xor(ss, 32);
        const float rq = rsqrtf(ss * (1.f / 96.f) + EPS) * (SM_SCALE * 1.4426950408889634f);
#pragma unroll
        for (int d0 = 0; d0 < 6; ++d0)
#pragma unroll
            for (int j = 0; j < 8; ++j) qv[d0][j] *= rq * g_qn[16 * d0 + 8 * hi + j];
        const float* rp = rope + ((size_t)(q0 + r32) * 16 + 8 * hi) * 2;
#pragma unroll
        for (int j = 0; j < 8; ++j) { const float cs = rp[2 * j], sn = rp[2 * j + 1], x1 = qv[4][j], x2 = qv[5][j]; qv[4][j] = x1 * cs - x2 * sn; qv[5][j] = x2 * cs + x1 * sn; }
#pragma unroll
        for (int d0 = 0; d0 < 6; ++d0) { u32x4 w; w.x = cvt_pk_bf16(qv[d0][0], qv[d0][1]); w.y = cvt_pk_bf16(qv[d0][2], qv[d0][3]); w.z = cvt_pk_bf16(qv[d0][4], qv[d0][5]); w.w = cvt_pk_bf16(qv[d0][6], qv[d0][7]); qf[d0] = __builtin_bit_cast(bf16x8, w); }
    }
    const int ntile = 4 * qb + 4, nstep = ntile >> 1, mylast = 4 * qb + (wid >> 1);
    const int kc0 = tid, kc1 = tid + 512;
    const bf16_t* Kg = Kf + (size_t)b * 2048 * 768 + h * 96; const bf16_t* Vg = Vf + (size_t)b * 2048 * 512 + h * 64;
    const size_t kg0 = (size_t)(kc0 / 12) * 768 + (kc0 % 12) * 8, kg1 = (size_t)(kc1 / 12) * 768 + (kc1 % 12) * 8, vg0 = (size_t)(tid >> 3) * 512 + (tid & 7) * 8;
    const int kl0 = (kc0 / 12) * AK_STRIDE + (kc0 % 12) * 16, kl1 = (kc1 / 12) * AK_STRIDE + (kc1 % 12) * 16, vl0 = AK_BYTES + (tid >> 3) * AV_STRIDE + (tid & 7) * 16;
    LAS unsigned char* lds = F.lds;
    u32x4 kr[2][2], vr[2];
#pragma unroll
    for (int e = 0; e < 2; ++e) { kr[e][1] = (u32x4){0u, 0u, 0u, 0u}; const size_t ko = (size_t)e * 64 * 768, vo = (size_t)e * 64 * 512;
        kr[e][0] = *(const u32x4*)(Kg + ko + kg0); if (tid < 256) kr[e][1] = *(const u32x4*)(Kg + ko + kg1); vr[e] = *(const u32x4*)(Vg + vo + vg0); }
#pragma unroll
    for (int e = 0; e < 2; ++e) { LAS unsigned char* nb = lds + e * ABUF; *(LAS u32x4*)(nb + kl0) = kr[e][0]; if (tid < 256) *(LAS u32x4*)(nb + kl1) = kr[e][1]; *(LAS u32x4*)(nb + vl0) = vr[e]; }
    asm volatile("s_waitcnt lgkmcnt(0)" ::: "memory"); __builtin_amdgcn_s_barrier(); asm volatile("" ::: "memory");
    f32x16 o0, o1;
#pragma unroll
    for (int r = 0; r < 16; ++r) { o0[r] = 0.f; o1[r] = 0.f; }
    float m_run = 0.f, l_run = 0.f;
    f32x16 negm;
#pragma unroll
    for (int r = 0; r < 16; ++r) negm[r] = 0.f;
    const int q4 = (lane & 15) >> 2, p4 = lane & 3, blk = (lane >> 4) & 1;
#define ATT_QK(P0, P1, KB) do { \
        if (!(VAR & 4)) { _Pragma("unroll") for (int dh = 0; dh < 2; ++dh) { bf16x8 ka_[3], kb_[3]; \
            _Pragma("unroll") for (int d0 = 0; d0 < 3; ++d0) { ka_[d0] = *(const LAS bf16x8*)((KB) + r32 * AK_STRIDE + 32 * (3 * dh + d0) + 16 * hi); kb_[d0] = *(const LAS bf16x8*)((KB) + (32 + r32) * AK_STRIDE + 32 * (3 * dh + d0) + 16 * hi); } \
            __builtin_amdgcn_sched_barrier(0);        \
            _Pragma("unroll") for (int d0 = 0; d0 < 3; ++d0) { \
                if (dh == 0 && d0 == 0) { P0 = __builtin_amdgcn_mfma_f32_32x32x16_bf16(ka_[0], qf[0], negm, 0, 0, 0); P1 = __builtin_amdgcn_mfma_f32_32x32x16_bf16(kb_[0], qf[0], negm, 0, 0, 0); } \
                else { P0 = __builtin_amdgcn_mfma_f32_32x32x16_bf16(ka_[d0], qf[3 * dh + d0], P0, 0, 0, 0); P1 = __builtin_amdgcn_mfma_f32_32x32x16_bf16(kb_[d0], qf[3 * dh + d0], P1, 0, 0, 0); } } \
            __builtin_amdgcn_sched_barrier(0); } } else { P0 = negm; P1 = negm; } } while (0)
#define ATT_SM(P0, P1, PF) do { float mx_ = 0.f; \
        asm volatile("s_nop 15\n\ts_nop 7" : "+v"(P0), "+v"(P1));        \
        if (!(VAR & 1)) { float ma_ = max3f(P0[0], P0[1], P0[2]), mb_ = max3f(P1[0], P1[1], P1[2]); \
            _Pragma("unroll") for (int r = 3; r < 15; r += 2) { ma_ = max3f(ma_, P0[r], P0[r + 1]); mb_ = max3f(mb_, P1[r], P1[r + 1]); } \
            mx_ = max3f(ma_, mb_, fmaxf(P0[15], P1[15])); mx_ = fmaxf(mx_, __shfl_xor(mx_, 32)); } \
        if (__builtin_expect(!(VAR & 1) && __any(mx_ > 8.0f), 0)) { const float dl_ = fmaxf(mx_, 0.f), al_ = __builtin_amdgcn_exp2f(-dl_); m_run += dl_; l_run *= al_; \
            _Pragma("unroll") for (int r = 0; r < 16; ++r) { P0[r] -= dl_; P1[r] -= dl_; o0[r] *= al_; o1[r] *= al_; negm[r] = -m_run; } } \
        float ls_ = 0.f; _Pragma("unroll") for (int r = 0; r < 16; ++r) { if (!(VAR & 1)) { P0[r] = __builtin_amdgcn_exp2f(P0[r]); P1[r] = __builtin_amdgcn_exp2f(P1[r]); } ls_ += P0[r] + P1[r]; } \
        l_run += ls_; u32x4 w_; \
        w_.x = cvt_pk_bf16(P0[0], P0[1]); w_.y = cvt_pk_bf16(P0[2], P0[3]); w_.z = cvt_pk_bf16(P0[4], P0[5]); w_.w = cvt_pk_bf16(P0[6], P0[7]); PF[0] = __builtin_bit_cast(bf16x8, w_); \
        w_.x = cvt_pk_bf16(P0[8], P0[9]); w_.y = cvt_pk_bf16(P0[10], P0[11]); w_.z = cvt_pk_bf16(P0[12], P0[13]); w_.w = cvt_pk_bf16(P0[14], P0[15]); PF[1] = __builtin_bit_cast(bf16x8, w_); \
        w_.x = cvt_pk_bf16(P1[0], P1[1]); w_.y = cvt_pk_bf16(P1[2], P1[3]); w_.z = cvt_pk_bf16(P1[4], P1[5]); w_.w = cvt_pk_bf16(P1[6], P1[7]); PF[2] = __builtin_bit_cast(bf16x8, w_); \
        w_.x = cvt_pk_bf16(P1[8], P1[9]); w_.y = cvt_pk_bf16(P1[10], P1[11]); w_.z = cvt_pk_bf16(P1[12], P1[13]); w_.w = cvt_pk_bf16(P1[14], P1[15]); PF[3] = __builtin_bit_cast(bf16x8, w_); } while (0)
#define ATT_PV(PF, VB) do { if (!(VAR & 2)) { v4i16_t lo0_[4], hi0_[4], lo1_[4], hi1_[4]; \
            _Pragma("unroll") for (int ks = 0; ks < 4; ++ks) { const int krow_ = 32 * (ks >> 1) + 16 * (ks & 1) + 4 * hi + q4; const LAS unsigned char* vp_ = (VB) + krow_ * AV_STRIDE + 32 * blk + 8 * p4; \
                lo0_[ks] = __builtin_amdgcn_ds_read_tr16_b64_v4i16((LAS v4i16_t*)(vp_)); hi0_[ks] = __builtin_amdgcn_ds_read_tr16_b64_v4i16((LAS v4i16_t*)(vp_ + 8 * AV_STRIDE)); \
                lo1_[ks] = __builtin_amdgcn_ds_read_tr16_b64_v4i16((LAS v4i16_t*)(vp_ + 64)); hi1_[ks] = __builtin_amdgcn_ds_read_tr16_b64_v4i16((LAS v4i16_t*)(vp_ + 8 * AV_STRIDE + 64)); } \
            __builtin_amdgcn_sched_barrier(0);        \
            _Pragma("unroll") for (int ks = 0; ks < 4; ++ks) { \
                const bf16x8 v0_ = {lo0_[ks][0], lo0_[ks][1], lo0_[ks][2], lo0_[ks][3], hi0_[ks][0], hi0_[ks][1], hi0_[ks][2], hi0_[ks][3]}; const bf16x8 v1_ = {lo1_[ks][0], lo1_[ks][1], lo1_[ks][2], lo1_[ks][3], hi1_[ks][0], hi1_[ks][1], hi1_[ks][2], hi1_[ks][3]}; \
                o0 = __builtin_amdgcn_mfma_f32_32x32x16_bf16(v0_, PF[ks], o0, 0, 0, 0); o1 = __builtin_amdgcn_mfma_f32_32x32x16_bf16(v1_, PF[ks], o1, 0, 0, 0); } \
            __builtin_amdgcn_sched_barrier(0); } } while (0)
    for (int st = 0; st < nstep; ++st) {
        const bool more = st + 1 < nstep;
        if (more) {
#pragma unroll
            for (int e = 0; e < 2; ++e) { const size_t ko = (size_t)(2 * st + 2 + e) * 64 * 768, vo = (size_t)(2 * st + 2 + e) * 64 * 512;
                kr[e][0] = *(const u32x4*)(Kg + ko + kg0); if (tid < 256) kr[e][1] = *(const u32x4*)(Kg + ko + kg1); vr[e] = *(const u32x4*)(Vg + vo + vg0); } }
        if (2 * st <= mylast) {
            const LAS unsigned char* kbA = lds + (st & 1) * 2 * ABUF; const LAS unsigned char* kbB = kbA + ABUF;
            const bool actB = 2 * st + 1 <= mylast;
            f32x16 pA0, pA1, pB0, pB1; bf16x8 pf[4];
            ATT_QK(pA0, pA1, kbA);
            const float mrefB = m_run;
            if (actB) ATT_QK(pB0, pB1, kbB);
            ATT_SM(pA0, pA1, pf);
            ATT_PV(pf, kbA + AK_BYTES);
            if (actB) {
                const float adj = m_run - mrefB;
                if (__builtin_expect(__any(adj != 0.f), 0)) {
#pragma unroll
                    for (int r = 0; r < 16; ++r) { pB0[r] -= adj; pB1[r] -= adj; } }
                ATT_SM(pB0, pB1, pf);
                ATT_PV(pf, kbB + AK_BYTES);
            }
        }
        if (more) {
#pragma unroll
            for (int e = 0; e < 2; ++e) { LAS unsigned char* nb = lds + ((st + 1) & 1) * 2 * ABUF + e * ABUF;
                *(LAS u32x4*)(nb + kl0) = kr[e][0]; if (tid < 256) *(LAS u32x4*)(nb + kl1) = kr[e][1]; *(LAS u32x4*)(nb + vl0) = vr[e]; } }
        asm volatile("s_waitcnt lgkmcnt(0)" ::: "memory"); __builtin_amdgcn_s_barrier(); asm volatile("" ::: "memory");
    }
#undef ATT_QK
#undef ATT_SM
#undef ATT_PV
    const float l = l_run + __shfl_xor(l_run, 32), il = 1.f / l;
    float s = 0.f; bf16_t* op = am + row * 1024 + h * 64 + 4 * hi;
#pragma unroll
    for (int g = 0; g < 4; ++g) {
        const float a0 = o0[4 * g] * il, a1 = o0[4 * g + 1] * il, a2 = o0[4 * g + 2] * il, a3 = o0[4 * g + 3] * il;
        const float b0 = o1[4 * g] * il, b1 = o1[4 * g + 1] * il, b2 = o1[4 * g + 2] * il, b3 = o1[4 * g + 3] * il;
        s += (a0 * a0 + a1 * a1) + (a2 * a2 + a3 * a3) + (b0 * b0 + b1 * b1) + (b2 * b2 + b3 * b3);
        u32x2 w0, w1; w0.x = cvt_pk_bf16(a0, a1); w0.y = cvt_pk_bf16(a2, a3); w1.x = cvt_pk_bf16(b0, b1); w1.y = cvt_pk_bf16(b2, b3);
        *(u32x2*)(op + 8 * g) = w0; *(u32x2*)(op + 32 + 8 * g) = w1;
    }
    s += __shfl_xor(s, 32);
    if (hi == 0) ssq_a[(size_t)h * T + row] = s;
}

constexpr int GV_STRIDE = 136;
__device__ __forceinline__ void gmlp_unit(Frame& F, int blk128, const bf16_t* ub, const bf16_t* vb, const bf16_t* wsb, const float* b_s, bf16_t* am) {
    const int tid_ = my_tid(F.wv), lane = tid_ & 63, g = __builtin_amdgcn_readfirstlane(tid_ >> 6), fr = lane & 15, fq = lane >> 4, q4 = (lane & 15) >> 2, p4 = lane & 3;
    LAS unsigned char* vl = F.lds + g * (128 * GV_STRIDE);
    LAS float* red = (LAS float*)(F.lds + 8 * 128 * GV_STRIDE);
    const size_t tok0 = (size_t)blk128 * 128;
    u32x4 st[16];
#pragma unroll
    for (int u = 0; u < 16; ++u) { const int c = lane + 64 * u; st[u] = *(const u32x4*)(vb + (tok0 + (c >> 3)) * 512 + g * 64 + (c & 7) * 8); }
    bf16x8 wfa[4][2];
#pragma unroll
    for (int mm = 0; mm < 4; ++mm)
#pragma unroll
        for (int ks = 0; ks < 2; ++ks) wfa[mm][ks] = *(const bf16x8*)(wsb + ((size_t)g * 128 + 16 * mm + fr) * 128 + 32 * ks + 8 * fq);
#pragma unroll
    for (int u = 0; u < 16; ++u) { const int c = lane + 64 * u; *(LAS u32x4*)(vl + (c >> 3) * GV_STRIDE + (c & 7) * 16) = st[u]; }
    asm volatile("s_waitcnt lgkmcnt(0)" ::: "memory");
#define GM_VF(VF, KS4) do { _Pragma("unroll") for (int n = 0; n < 4; ++n) { const LAS unsigned char* vp_ = vl + (32 * (KS4) + 8 * fq + q4) * GV_STRIDE + 32 * n + 8 * p4; \
        const v4i16_t lo_ = __builtin_amdgcn_ds_read_tr16_b64_v4i16((LAS v4i16_t*)(vp_)), hi_ = __builtin_amdgcn_ds_read_tr16_b64_v4i16((LAS v4i16_t*)(vp_ + 4 * GV_STRIDE)); \
        VF[n] = (bf16x8){lo_[0], lo_[1], lo_[2], lo_[3], hi_[0], hi_[1], hi_[2], hi_[3]}; } } while (0)
#define GM_EPI(ACC, MBASE, UU, BSV) do { \
        _Pragma("unroll") for (int mm = 0; mm < 4; ++mm) { const int t = 16 * ((MBASE) + mm) + fr; float s_ = 0.f; \
            _Pragma("unroll") for (int n = 0; n < 4; ++n) { ACC[mm][n] = (ACC[mm][n] + BSV[mm]) * unpack_lo(UU[mm][n]); s_ += sq4(ACC[mm][n]); } \
            s_ = red4(s_); if (fq == 0) red[g * 128 + t] = s_; } \
        __syncthreads(); \
        _Pragma("unroll") for (int mm = 0; mm < 4; ++mm) { const int t = 16 * ((MBASE) + mm) + fr; float tot_ = 0.f; \
            _Pragma("unroll") for (int gg = 0; gg < 8; ++gg) tot_ += red[gg * 128 + t]; \
            const float rs_ = rsqrtf(tot_ * (1.f / 512.f) + EPS); \
            _Pragma("unroll") for (int n = 0; n < 4; ++n) { const f32x4 o_ = ACC[mm][n] * rs_; u32x2 w_; w_.x = cvt_pk_bf16(o_[0], o_[1]); w_.y = cvt_pk_bf16(o_[2], o_[3]); \
                *(u32x2*)(am + (tok0 + t) * 1024 + 512 + g * 64 + 16 * n + 4 * fq) = w_; } } } while (0)
    {
        bf16x8 wfb[4][4];
#pragma unroll
        for (int mm = 0; mm < 4; ++mm)
#pragma unroll
            for (int ks = 0; ks < 4; ++ks) wfb[mm][ks] = *(const bf16x8*)(wsb + ((size_t)g * 128 + 16 * (4 + mm) + fr) * 128 + 32 * ks + 8 * fq);
        u32x2 uu[4][4]; float bsv[4];
#pragma unroll
        for (int mm = 0; mm < 4; ++mm) { const int t = 16 * mm + fr; bsv[mm] = b_s[g * 128 + t];
#pragma unroll
            for (int n = 0; n < 4; ++n) uu[mm][n] = *(const u32x2*)(ub + (tok0 + t) * 512 + g * 64 + 16 * n + 4 * fq); }
        f32x4 acc[4][4];
#pragma unroll
        for (int mm = 0; mm < 4; ++mm)
#pragma unroll
            for (int n = 0; n < 4; ++n) acc[mm][n] = (f32x4){0.f, 0.f, 0.f, 0.f};
#pragma unroll
        for (int ks = 0; ks < 2; ++ks) { bf16x8 vf[4]; GM_VF(vf, ks);
#pragma unroll
            for (int mm = 0; mm < 4; ++mm)
#pragma unroll
                for (int n = 0; n < 4; ++n) acc[mm][n] = __builtin_amdgcn_mfma_f32_16x16x32_bf16(vf[n], wfa[mm][ks], acc[mm][n], 0, 0, 0); }
        GM_EPI(acc, 0, uu, bsv);
        u32x2 uv[4][4]; float bsw[4];
#pragma unroll
        for (int mm = 0; mm < 4; ++mm) { const int t = 16 * (4 + mm) + fr; bsw[mm] = b_s[g * 128 + t];
#pragma unroll
            for (int n = 0; n < 4; ++n) uv[mm][n] = *(const u32x2*)(ub + (tok0 + t) * 512 + g * 64 + 16 * n + 4 * fq); }
        f32x4 acb[4][4];
#pragma unroll
        for (int mm = 0; mm < 4; ++mm)
#pragma unroll
            for (int n = 0; n < 4; ++n) acb[mm][n] = (f32x4){0.f, 0.f, 0.f, 0.f};
#pragma unroll
        for (int ks = 0; ks < 4; ++ks) { bf16x8 vf[4]; GM_VF(vf, ks);
#pragma unroll
            for (int mm = 0; mm < 4; ++mm)
#pragma unroll
                for (int n = 0; n < 4; ++n) acb[mm][n] = __builtin_amdgcn_mfma_f32_16x16x32_bf16(vf[n], wfb[mm][ks], acb[mm][n], 0, 0, 0); }
        __syncthreads();
        GM_EPI(acb, 4, uv, bsw);
    }
#undef GM_VF
#undef GM_EPI
    __syncthreads();
}

__device__ __forceinline__ void router_unit(Frame& F, int blk128, const bf16_t* X, const bf16_t* wr_hi, int* gcnt, int* stok, float* srs, float* sg) {
    const int tid = my_tid(F.wv), lane = tid & 63, w = __builtin_amdgcn_readfirstlane(tid >> 6), fr = lane & 15, fq = lane >> 4;
    LAS float* lg = (LAS float*)F.lds;
    LAS float* ssq = lg + 128 * 49;
    LAS int* hist = (LAS int*)(ssq + 128);
    if (tid < 64) hist[tid] = 0;
    const size_t tok0 = (size_t)blk128 * 128;
    const bf16_t* wr_lo = wr_hi + 64 * 1024;
    {
        const bf16_t* xrow = X + (tok0 + 16 * w + fr) * 1024 + 8 * fq; const size_t wo = (size_t)fr * 1024 + 8 * fq;
        f32x4 acc[3] = {{0.f, 0.f, 0.f, 0.f}, {0.f, 0.f, 0.f, 0.f}, {0.f, 0.f, 0.f, 0.f}}; float ss = 0.f;
#pragma unroll 4
        for (int ks = 0; ks < 32; ++ks) {
            const bf16x8 a = *(const bf16x8*)(xrow + 32 * ks);
#pragma unroll
            for (int j = 0; j < 8; ++j) { const float x = bf2f((bf16_t)a[j]); ss += x * x; }
#pragma unroll
            for (int nt = 0; nt < 3; ++nt) { const bf16x8 bh = *(const bf16x8*)(wr_hi + wo + (size_t)nt * 16 * 1024 + 32 * ks), bl = *(const bf16x8*)(wr_lo + wo + (size_t)nt * 16 * 1024 + 32 * ks);
                acc[nt] = __builtin_amdgcn_mfma_f32_16x16x32_bf16(a, bh, acc[nt], 0, 0, 0); acc[nt] = __builtin_amdgcn_mfma_f32_16x16x32_bf16(a, bl, acc[nt], 0, 0, 0); }
        }
#pragma unroll
        for (int nt = 0; nt < 3; ++nt)
#pragma unroll
            for (int i = 0; i < 4; ++i) lg[(16 * w + 4 * fq + i) * 49 + 16 * nt + fr] = acc[nt][i];
        ss = red4(ss);
        if (fq == 0) ssq[16 * w + fr] = ss;
    }
    __syncthreads();
    int ea = 0, eb = 0, ra = 0, rbk = 0; float g0 = 0.f, g1 = 0.f, rstd = 0.f;
    if (tid < 128) {
        rstd = rsqrtf(ssq[tid] * (1.f / 1024.f) + EPS);
        const LAS float* l = lg + tid * 49;
        int gs = 0; float gm = l[0] * rstd;
#pragma unroll
        for (int g = 1; g < 4; ++g) { const float v = l[g] * rstd; if (v > gm) { gm = v; gs = g; } }
        float den = 0.f;
#pragma unroll
        for (int g = 0; g < 4; ++g) den += __expf(l[g] * rstd - gm);
        const float psel = 1.f / den;
        int i0 = 0; float v0 = l[4 + gs * 8] * rstd;
        for (int i = 1; i < 8; ++i) { const float v = l[4 + gs * 8 + i] * rstd; if (v > v0) { v0 = v; i0 = i; } }
        int i1 = -1; float v1 = -3.0e38f;
        for (int i = 0; i < 8; ++i) { const float v = l[4 + gs * 8 + i] * rstd; if (i != i0 && v > v1) { v1 = v; i1 = i; } }
        const float e1 = __expf(v1 - v0); g0 = psel / (1.f + e1); g1 = psel * e1 / (1.f + e1);
        ea = gs * 8 + i0; eb = gs * 8 + i1;
        ra = __hip_atomic_fetch_add(&hist[ea], 1, __ATOMIC_RELAXED, __HIP_MEMORY_SCOPE_WORKGROUP); rbk = __hip_atomic_fetch_add(&hist[eb], 1, __ATOMIC_RELAXED, __HIP_MEMORY_SCOPE_WORKGROUP);
    }
    __syncthreads();
    if (tid < 32) { const int n = hist[tid]; hist[32 + tid] = n ? atomicAdd(gcnt + tid, n) : 0; }
    __syncthreads();
    if (tid < 128) {
        const int tok = (int)tok0 + tid; const size_t pa = (size_t)ea * T + hist[32 + ea] + ra, pb = (size_t)eb * T + hist[32 + eb] + rbk;
        stok[pa] = tok; srs[pa] = rstd; sg[pa] = g0;
        stok[pb] = tok | (1 << 30); srs[pb] = rstd; sg[pb] = g1;
    }
    __syncthreads();
}

__global__ void __launch_bounds__(NTHREADS, 2) mk_fwd(MkArgs args) {
    extern __shared__ __attribute__((aligned(16))) unsigned char lds_raw[];
    Frame F;
    F.lds = (LAS unsigned char*)lds_raw; F.ws = args.ws;
    F.wv = __builtin_amdgcn_readfirstlane((int)threadIdx.x >> 6);
    F.G = gridDim.x; F.c = blockIdx.x; F.vcu = (F.G % 8 == 0) ? (F.c % 8) * (F.G / 8) + F.c / 8 : F.c;
    F.tabf = (LAS float*)(F.lds + TABF_OFF); F.tabi = (LAS int*)(F.lds + TABI_OFF); F.tabg = (LAS float*)(F.lds + TABG_OFF);
    unsigned char* ws = args.ws;
    volatile LAS unsigned* misc = (volatile LAS unsigned*)(F.lds + MISC_OFF);
    if ((int)threadIdx.x < 8) misc[(int)threadIdx.x] = 0u;
    if ((int)threadIdx.x < 26) ((LAS unsigned long long*)(F.lds + PTR_OFF))[(int)threadIdx.x] = (unsigned long long)args.in[(int)threadIdx.x];
    __syncthreads();
    XcdBarrier bar; bar.bar = (unsigned*)(ws + Z_BAR); bar.x = xb_xcc_id(); bar.st = misc;
    if ((int)threadIdx.x == 0) {
        const unsigned rank = xb_add(&bar.bar[XB_XCNT(bar.x)], 1u);
        unsigned nloc, nx; xcd_barrier_complete(bar.bar, bar.x, nloc, nx);
        bool ok = (gridDim.x == 256u) && nx == 8u && bar.x < 8u;
#pragma unroll
        for (unsigned j = 0; j < 8; ++j) ok = ok && (xb_ld(&bar.bar[XB_XCNT(j)]) == 32u);
        misc[0] = nloc; misc[1] = nx; misc[4] = rank; misc[5] = ok ? 1u : 0u;
    }
    __syncthreads();
    const bool local_ok = __builtin_amdgcn_readfirstlane(misc[5]) != 0u;
    const int my_rank = (int)__builtin_amdgcn_readfirstlane(misc[4]), my_xcc = (int)bar.x;
    unsigned* const lbar = (unsigned*)(ws + Z_LBAR);
    if (local_ok) { F.c = my_rank * 8 + my_xcc; F.vcu = my_xcc * 32 + my_rank; }
    const int p2sel = (args.ph_lo >= 44) ? args.ph_lo - 44 : -1;
    const int lo = (p2sel >= 0) ? 33 : args.ph_lo, hi = (p2sel >= 0) ? 34 : args.ph_hi;
#ifndef PHMASK
#define PHMASK 0x7fff
#endif
#define IN(k) (lo <= (k) && (k) < hi)
#define PHON(b) (((PHMASK) >> (b)) & 1)
#define SEAM(k) do { if ((k) + 1 < hi) xcd_barrier(bar, my_tid(F.wv)); } while (0)
#define SEAM_L(k) do { if ((k) + 1 < hi) { if (local_ok) xcc_local_barrier(lbar, bar.bar, (unsigned)my_xcc, 32u, my_tid(F.wv)); else xcd_barrier(bar, my_tid(F.wv)); } } while (0)

    if (PHON(0) && IN(0)) {
        const float* x = lds_inptr((const LAS unsigned long long*)(F.lds + PTR_OFF), 0); const float* p = lds_inptr((const LAS unsigned long long*)(F.lds + PTR_OFF), 1);
        const int tid_ = my_tid(F.wv), lane = tid_ & 63, gw = F.vcu * NWAVES + (tid_ >> 6), ngw = F.G * NWAVES;
        float* ssqh = (float*)(ws + Z_SSQ) + (size_t)12 * T;
        for (int m = gw; m < T; m += ngw) {
            const f32x4* xr = (const f32x4*)(x + (size_t)m * D) + lane; float s = 0.f; u32x2* o = (u32x2*)((bf16_t*)(ws + WS_X0) + (size_t)m * D) + lane;
#pragma unroll
            for (int j = 0; j < 4; ++j) { const f32x4 v = __builtin_nontemporal_load(xr + 64 * j); s += v.x * v.x + v.y * v.y + v.z * v.z + v.w * v.w; u32x2 w; w.x = cvt_pk_bf16(v.x, v.y); w.y = cvt_pk_bf16(v.z, v.w); o[64 * j] = w; }
            s = wave_sum(s); if (lane == 0) ssqh[m] = s;
            if (lane < 16) ((float*)(ws + WS_SSQHP))[(size_t)lane * T + m] = lane == 0 ? s : 0.f;
        }
        bf16_t* pb = (bf16_t*)(ws + WS_PB);
        const size_t n4 = (size_t)T * 256 / 4, gt = (size_t)F.c * NTHREADS + tid_, ngt = (size_t)F.G * NTHREADS;
        for (size_t i = gt; i < n4; i += ngt) { const f32x4 v = __builtin_nontemporal_load((const f32x4*)p + i); u32x2 w; w.x = cvt_pk_bf16(v.x, v.y); w.y = cvt_pk_bf16(v.z, v.w); ((u32x2*)pb)[i] = w; }
        float* rope = (float*)(ws + S_ROPE);
        for (size_t i = gt; i < 2048 * 16; i += ngt) {
            const int pos = (int)(i >> 4), k = (int)(i & 15);
            const double inv = exp(-(double)(2 * k) / 32.0 * log(10000.0)), ang = (double)pos * inv;
            rope[2 * i] = (float)cos(ang); rope[2 * i + 1] = (float)sin(ang);
        }
    }

    for (int l = 0; l < NL; ++l) {
        const int pb0 = 1 + 10 * l;
        if (hi <= pb0 || lo >= pb0 + 10) continue;
#define LF(i, per) (lds_inptr((const LAS unsigned long long*)(F.lds + PTR_OFF), (i)) + (size_t)l * (per))
        { int c_ = local_ok ? my_rank * 8 + my_xcc : (int)blockIdx.x, g_ = gridDim.x; asm volatile("" : "+s"(c_), "+s"(g_)); F.c = c_; F.G = g_; F.vcu = (g_ % 8 == 0) ? (c_ % 8) * (g_ / 8) + c_ / 8 : c_; }
        { unsigned lb = 0u; asm volatile("" : "+s"(lb)); F.lds = (LAS unsigned char*)lds_raw + lb; size_t wo = 0; asm volatile("" : "+s"(wo)); ws = args.ws + wo; F.ws = ws; }
        F.tabf = (LAS float*)(F.lds + TABF_OFF); F.tabi = (LAS int*)(F.lds + TABI_OFF); F.tabg = (LAS float*)(F.lds + TABG_OFF);
        LAS int* moe_cnt = (LAS int*)(F.lds + MISC_OFF + 64); LAS int* moe_tb = (LAS int*)(F.lds + MISC_OFF + 192); LAS int* moe_te = (LAS int*)(F.lds + MISC_OFF + 384);
        unsigned char* wsw = ws + ((l & 1) ? W_ALT : 0);
#define ZSSQ(k) ((float*)(ws + Z_SSQ) + (size_t)(k) * T)
#define XIN ((bf16_t*)(ws + ((l & 1) ? WS_X1 : WS_X0)))
#define XMID ((bf16_t*)(ws + ((l & 1) ? WS_X0 : WS_X1)))
#define ROPE ((const float*)(ws + S_ROPE))
#define GCNT ((int*)(ws + Z_CNT) + l * 64)
        if (PHON(1) && IN(pb0 + 0) && (l == 0 || !MOE_FP8)) {
            LayerW L; FILL_LAYERW(L, LF)
            const int tid_ = my_tid(F.wv), wv = __builtin_amdgcn_readfirstlane(tid_ >> 6);
            float* scr = (float*)(F.lds + wv * 8448);
            const int gw = F.vcu * NWAVES + wv, ngw = F.G * NWAVES;
#if MOE_FP8
            for (int it = gw; it < IT_SMALL; it += ngw) convert_item(L, wsw, it, scr, tid_ & 63);
            convert_moe_stream(L.w1, L.w3, L.w2, L.g_ffn, wsw, gw, ngw, tid_ & 63);
#else
            for (int it = gw; it < IT_TOTAL; it += ngw) convert_item(L, wsw, it, scr, tid_ & 63);
#endif
            convert_small(L, wsw, F.c * NTHREADS + tid_, F.G * NTHREADS);
            SEAM(pb0 + 0);
        }
        if (PHON(2) && IN(pb0 + 1)) {
            SchedStatic S; S.init(T, NPROJ, 1024, F.G, F.c, XIN, wsw + W_IN); const float* hp = (const float*)(ws + WS_SSQHP);
            fill_tab_static(F, S, [&](int i, int r, int row) { float s = 0.f;
#pragma unroll
                for (int k = 0; k < 16; ++k) s += hp[(size_t)k * T + row];
                F.tabf[i * 256 + r] = rsqrtf(s * (1.f / 1024.f) + EPS); });
            Epi1 E{(bf16_t*)(ws + WS_CQ), (bf16_t*)(ws + WS_CKV), (bf16_t*)(ws + WS_U), (bf16_t*)(ws + WS_V), LF(10, 512), F.tabf};
            gemm_phase<Epi1, SchedStatic, false, false>(F.wv, F.lds, 1024, S, E, nullptr);
            SEAM_L(pb0 + 1);
        }
        if (PHON(3) && IN(pb0 + 2)) {
            if (PHON(11) && (p2sel < 0 || p2sel == 0)) {
                SchedStatic S; S.init(T, 768, 256, F.G, F.c, ws + WS_CQ, wsw + W_UQ);
                { Unit u; const int t_ = my_tid(F.wv), r = t_ >> 1, hf = t_ & 1;
                  for (int i = 0; i < MAXU && S.next(i, u); ++i) {
                      const u32x4* p = (const u32x4*)((const bf16_t*)(ws + WS_CQ) + (size_t)(u.pm * 256 + r) * 256 + hf * 128); float s = 0.f;
                      u32x4 xx[16];
#pragma unroll
                      for (int k = 0; k < 16; ++k) xx[k] = p[k];
#pragma unroll
                      for (int k = 0; k < 16; ++k) s += sq4(unpack_lo((u32x2){xx[k].x, xx[k].y})) + sq4(unpack_lo((u32x2){xx[k].z, xx[k].w}));
                      s += __shfl_xor(s, 1);
                      if (hf == 0) F.tabf[i * 256 + r] = rsqrtf(s * (1.f / 256.f) + EPS); }
                  __syncthreads(); }
                EpiStore<true> E{(bf16_t*)(ws + WS_Q), 768, F.tabf};
                gemm_phase<EpiStore<true>, SchedStatic, false, false>(F.wv, F.lds, 256, S, E, nullptr);
            }
            if (PHON(12) && (p2sel < 0 || p2sel == 1)) {
                SchedStatic S; S.init(T, 1024, 256, F.G, F.c, ws + WS_CKV, wsw + W_UKV);
                { Unit u; const int t_ = my_tid(F.wv), r = t_ >> 1, hf = t_ & 1;
                  for (int i = 0; i < MAXU && S.next(i, u); ++i) {
                      const u32x4* p = (const u32x4*)((const bf16_t*)(ws + WS_CKV) + (size_t)(u.pm * 256 + r) * 256); float s = 0.f, sk = 0.f;
#pragma unroll
                      for (int k = 0; k < 8; ++k) { const u32x4 x = p[hf * 8 + k]; s += sq4(unpack_lo((u32x2){x.x, x.y})) + sq4(unpack_lo((u32x2){x.z, x.w})); }
#pragma unroll
                      for (int k = 0; k < 2; ++k) { const u32x4 x = p[16 + hf * 2 + k]; sk += sq4(unpack_lo((u32x2){x.x, x.y})) + sq4(unpack_lo((u32x2){x.z, x.w})); }
                      s += __shfl_xor(s, 1); sk += __shfl_xor(sk, 1);
                      if (hf == 0) { F.tabf[i * 256 + r] = rsqrtf(s * (1.f / 128.f) + EPS); F.tabg[i * 256 + r] = sk; } }
                  __syncthreads(); }
                Epi2b E{(bf16_t*)(ws + WS_K), (bf16_t*)(ws + WS_VF), (const bf16_t*)(ws + WS_CKV), LF(9, 96), ROPE, F.tabf, F.tabg};
                gemm_phase<Epi2b, SchedStatic, false, false>(F.wv, F.lds, 256, S, E, nullptr);
            }
            if (PHON(13) && (p2sel < 0 || p2sel == 2)) {
                SchedE S; S.init(T, 1024, 256, F.G, F.c, ws + WS_PB + (size_t)l * T * 256 * 2, wsw + W_PLE);
#if MOE_FP8
                EpiStoreF8 E{(unsigned char*)(ws + WS_E), 1024};
                gemm_phase<EpiStoreF8, SchedE, false, false>(F.wv, F.lds, 256, S, E, nullptr);
#else
                EpiStore<false> E{(bf16_t*)(ws + WS_E), 1024, F.tabf};
                gemm_phase<EpiStore<false>, SchedStatic, false, false>(F.wv, F.lds, 256, S, E, nullptr);
#endif
            }
            if (PHON(14) && (p2sel < 0 || p2sel == 3)) for (int u = F.vcu; u < T / 128; u += F.G) gmlp_unit(F, u, (const bf16_t*)(ws + WS_U), (const bf16_t*)(ws + WS_V), (const bf16_t*)(wsw + W_S), LF(12, 8 * 128), (bf16_t*)(ws + WS_AM));
            SEAM_L(pb0 + 2);
        }
        if (PHON(4) && IN(pb0 + 3)) {
            CvCtx cv; cv.nl = -1; cv.wsw = ws; cv.stride = 1; cv.ptab = (const LAS unsigned long long*)(F.lds + PTR_OFF); int cv_it = 0, cv_iter = 0;
            const int grp = (F.c >> 3) & 3;
            for (int v = F.vcu; v < 256; v += F.G) {
                const int bh = v >> 1, j = v & 1;
                const int cvp = (MOE_FP8 && l + 1 < NL && v == F.vcu) ? ((grp == 1) ? 1 + j : grp) : -1;
#pragma unroll 1
                for (int i = 0; i < 4; ++i) {
                    if (i == cvp) {
                        CvCtx c2; c2.nl = l + 1; c2.wsw = ws + (((l + 1) & 1) ? W_ALT : 0); c2.stride = F.G * NWAVES; c2.ptab = (const LAS unsigned long long*)(F.lds + PTR_OFF);
                        const int tid_ = my_tid(F.wv);
                        cv_stream(c2, F.vcu * NWAVES + __builtin_amdgcn_readfirstlane(tid_ >> 6), tid_ & 63);
                    }
                    const int ii = (grp == 1) ? ((i == 0) ? 2 : (i == 1) ? 0 : (i == 2) ? 1 : 3) : i;
                    const int qb = (ii == 0) ? j : (ii == 1) ? 7 - j : (ii == 2) ? 3 - j : 4 + j;
                    attn_unit(F, bh >> 3, bh & 7, qb, (const bf16_t*)(ws + WS_Q), (const bf16_t*)(ws + WS_K), (const bf16_t*)(ws + WS_VF), (bf16_t*)(ws + WS_AM), (float*)(ws + WS_SSQAP), LF(8, 96), ROPE, cv, cv_it, cv_iter);
                }
            }
            SEAM_L(pb0 + 3);
        }
        if (PHON(5) && IN(pb0 + 4)) {
            SchedStatic S; S.init(T, 1024, 1024, F.G, F.c, ws + WS_AM, wsw + W_OUT); const float* ap = (const float*)(ws + WS_SSQAP);
            fill_tab_static(F, S, [&](int i, int r, int row) { float s = 0.f;
#pragma unroll
                for (int k = 0; k < 8; ++k) s += ap[(size_t)k * T + row];
                F.tabf[i * 256 + r] = rsqrtf(s * (1.f / 512.f) + EPS); });
            Epi4 E{XIN, XMID, F.tabf, MOE_FP8 ? (unsigned char*)(ws + WS_X8) : nullptr};
            gemm_phase<Epi4, SchedStatic, false, true>(F.wv, F.lds, 1024, S, E, nullptr);
            SEAM_L(pb0 + 4);
        }
        if (PHON(6) && IN(pb0 + 5)) {
            for (int u = F.vcu; u < T / 128; u += F.G) router_unit(F, u, XMID, (const bf16_t*)(wsw + W_R), GCNT, (int*)(ws + S_SLOTTOK), (float*)(ws + S_SLOTRSTD), (float*)(ws + S_SLOTGATE));
            SEAM(pb0 + 5);
        }
        if (PHON(7) && IN(pb0 + 6) && MOE_FP8 && l + 1 < NL) {
            CvCtx cv; int cv_it; cv.nl = l + 1; cv.wsw = ws + (((l + 1) & 1) ? W_ALT : 0);
            const int tid_ = my_tid(F.wv); cv_it = F.vcu * NWAVES + __builtin_amdgcn_readfirstlane(tid_ >> 6); cv.stride = F.G * NWAVES; cv.ptab = (const LAS unsigned long long*)(F.lds + PTR_OFF);
            { LayerW Ln; const int l_ = l; { const int l = l_ + 1; FILL_LAYERW(Ln, LF) } convert_small(Ln, cv.wsw, F.c * NTHREADS + tid_, F.G * NTHREADS);
              for (int it = cv_it; it < IT_SMALL; it += cv.stride) convert_item(Ln, cv.wsw, it, nullptr, tid_ & 63); }
        }
        if ((PHON(7) && IN(pb0 + 6)) || (PHON(8) && IN(pb0 + 7))) {
            const int t_ = my_tid(F.wv);
            if (t_ < 32) moe_cnt[t_] = __hip_atomic_load(GCNT + t_, __ATOMIC_RELAXED, __HIP_MEMORY_SCOPE_AGENT);
            __syncthreads();
            if (t_ == 0) { int b = 0; for (int e = 0; e < 32; ++e) { moe_tb[e] = b; const int n = (moe_cnt[e] + 255) >> 8; for (int k = 0; k < n; ++k) moe_te[b + k] = e; b += n; } moe_tb[32] = b; }
            __syncthreads();
        }
        if (PHON(7) && IN(pb0 + 6)) {
            const int* stok = (const int*)(ws + S_SLOTTOK); const float* srs = (const float*)(ws + S_SLOTRSTD);
#if MOE_FP8
            SchedMoe S{moe_tb[32], F.G, F.c, moe_te, (const char*)(ws + WS_X8), (const char*)(wsw + W_13), 0, (size_t)1024 * 1024, (size_t)256 * 1024};
#else
            SchedMoe S{moe_tb[32], F.G, F.c, moe_te, (const char*)XMID, (const char*)(wsw + W_13), 0, (size_t)1024 * 1024 * 2, (size_t)256 * 1024 * 2};
#endif
            { Unit u; for (int i = 0; i < MAXU && S.next(i, u); ++i) for (int r = my_tid(F.wv); r < 256; r += NTHREADS) {
                const int pos = (u.pm - moe_tb[u.e]) * 256 + r; const bool ok = pos < moe_cnt[u.e]; const size_t o = (size_t)u.e * T + pos;
                F.tabi[i * 256 + r] = ok ? (stok[o] & 0x3fffffff) : 0; F.tabf[i * 256 + r] = ok ? srs[o] : 0.f; }
              __syncthreads(); }
#if MOE_FP8
            Epi6F8 E{(unsigned char*)(ws + WS_H), F.tabf};
            gemm_phase<Epi6F8, SchedMoe, true, false, true>(F.wv, F.lds, 512, S, E, F.tabi);
#else
            Epi6 E{(bf16_t*)(ws + WS_H), F.tabf};
            gemm_phase<Epi6, SchedMoe, true, false>(F.wv, F.lds, 1024, S, E, F.tabi);
#endif
            SEAM_L(pb0 + 6);
        }
        if (PHON(8) && IN(pb0 + 7)) {
            const int* stok = (const int*)(ws + S_SLOTTOK); const float* sg = (const float*)(ws + S_SLOTGATE);
#if MOE_FP8
            SchedMoe S{moe_tb[32], F.G, F.c, moe_te, (const char*)(ws + WS_H), (const char*)(wsw + W_2), (size_t)256 * 512, (size_t)1024 * 512, (size_t)256 * 512};
#else
            SchedMoe S{moe_tb[32], F.G, F.c, moe_te, (const char*)(ws + WS_H), (const char*)(wsw + W_2), (size_t)256 * 512 * 2, (size_t)1024 * 512 * 2, (size_t)256 * 512 * 2};
#endif
            { Unit u; for (int i = 0; i < MAXU && S.next(i, u); ++i) for (int r = my_tid(F.wv); r < 256; r += NTHREADS) {
                const int pos = (u.pm - moe_tb[u.e]) * 256 + r; const bool ok = pos < moe_cnt[u.e]; const size_t o = (size_t)u.e * T + pos;
                F.tabi[i * 256 + r] = ok ? stok[o] : -1; F.tabg[i * 256 + r] = ok ? sg[o] : 0.f; }
              __syncthreads(); }
#if MOE_FP8
            Epi7 E{(bf16_t*)(ws + WS_Y0), (bf16_t*)(ws + WS_Y1), F.tabi, F.tabg, W8_INV};
            gemm_phase<Epi7, SchedMoe, false, false, true>(F.wv, F.lds, 256, S, E, nullptr);
#else
            Epi7 E{(bf16_t*)(ws + WS_Y0), (bf16_t*)(ws + WS_Y1), F.tabi, F.tabg, 1.f};
            gemm_phase<Epi7, SchedMoe, false, false>(F.wv, F.lds, 512, S, E, nullptr);
#endif
            SEAM(pb0 + 7);
        }
        if (PHON(9) && IN(pb0 + 8)) {
            const int tid_ = my_tid(F.wv), lane = tid_ & 63, gw = F.vcu * NWAVES + (tid_ >> 6), ngw = F.G * NWAVES;
            for (int mk = 0; mk < T / ngw; ++mk) { const int m = (gw >> 8) * 4096 + mk * 256 + (gw & 255);
#if MOE_FP8
                const u32x2* a = (const u32x2*)(ws + WS_Y0 + (size_t)m * 1024) + lane; const u32x2* b = (const u32x2*)(ws + WS_Y1 + (size_t)m * 1024) + lane; const u32x4* hh = (const u32x4*)(XMID + (size_t)m * 1024) + lane; u32x4* o = (u32x4*)(XIN + (size_t)m * 1024) + lane; float s = 0.f;
#pragma unroll
                for (int j = 0; j < 2; ++j) {
                    const u32x2 x = __builtin_nontemporal_load(a + 64 * j), y = __builtin_nontemporal_load(b + 64 * j); const u32x4 z = __builtin_nontemporal_load(hh + 64 * j);
                    const f32x4 v0 = unpack_lo((u32x2){z.x, z.y}) + (unpack_fp8x4(x.x) + unpack_fp8x4(y.x)) * Y8_INV, v1 = unpack_lo((u32x2){z.z, z.w}) + (unpack_fp8x4(x.y) + unpack_fp8x4(y.y)) * Y8_INV;
#else
                const u32x4* a = (const u32x4*)(ws + WS_Y0 + (size_t)m * 2048) + lane; const u32x4* b = (const u32x4*)(ws + WS_Y1 + (size_t)m * 2048) + lane; const u32x4* hh = (const u32x4*)(XMID + (size_t)m * 1024) + lane; u32x4* o = (u32x4*)(XIN + (size_t)m * 1024) + lane; float s = 0.f;
#pragma unroll
                for (int j = 0; j < 2; ++j) {
                    const u32x4 x = a[64 * j], y = b[64 * j], z = hh[64 * j];
                    const f32x4 v0 = unpack_lo((u32x2){z.x, z.y}) + (unpack_lo((u32x2){x.x, x.y}) + unpack_lo((u32x2){y.x, y.y})), v1 = unpack_lo((u32x2){z.z, z.w}) + (unpack_lo((u32x2){x.z, x.w}) + unpack_lo((u32x2){y.z, y.w}));
#endif
                    const u32x4 w = pack8(v0, v1); o[64 * j] = w;
                    const f32x4 r0 = unpack_lo((u32x2){w.x, w.y}), r1 = unpack_lo((u32x2){w.z, w.w});
                    if (MOE_FP8) { u32x2 q; q.x = pk4_fp8(r0[0], r0[1], r0[2], r0[3]); q.y = pk4_fp8(r1[0], r1[1], r1[2], r1[3]); ((u32x2*)(ws + WS_X8 + (size_t)m * 1024))[lane + 64 * j] = q; }
                    s += sq4(r0) + sq4(r1);
                }
                if (l + 1 < NL) { const f32x4 pv = __builtin_nontemporal_load((const f32x4*)(lds_inptr((const LAS unsigned long long*)(F.lds + PTR_OFF), 1) + ((size_t)(l + 1) * T + m) * 256) + lane); u32x2 pw; pw.x = cvt_pk_bf16(pv.x, pv.y); pw.y = cvt_pk_bf16(pv.z, pv.w);
                    ((u32x2*)((bf16_t*)(ws + WS_PB) + ((size_t)(l + 1) * T + m) * 256))[lane] = pw; }
                s = wave_sum(s); if (lane == 0) ((float*)(ws + S_RSTD2))[m] = rsqrtf(s * (1.f / 1024.f) + EPS);
            }
            SEAM_L(pb0 + 8);
        }
        if (PHON(10) && IN(pb0 + 9)) {
#if MOE_FP8
            SchedStatic S; S.init(T, 1024, 512, F.G, F.c, ws + WS_X8, wsw + W_PG); const float* rstd2 = (const float*)(ws + S_RSTD2);
            fill_tab_static(F, S, [&](int i, int r, int row) { F.tabf[i * 256 + r] = rstd2[row] * W8_INV; });
#else
            SchedStatic S; S.init(T, 1024, 1024, F.G, F.c, XIN, wsw + W_PG); const float* rstd2 = (const float*)(ws + S_RSTD2);
            fill_tab_static(F, S, [&](int i, int r, int row) { F.tabf[i * 256 + r] = rstd2[row]; });
#endif
            Epi9 E{XIN, (const unsigned char*)(ws + WS_E), XMID, (l == NL - 1) ? args.out : nullptr, (float*)(ws + WS_SSQHP), LF(24, 1024), F.tabf};
#if MOE_FP8
            gemm_phase<Epi9, SchedStatic, false, false, true>(F.wv, F.lds, 512, S, E, nullptr);
#else
            gemm_phase<Epi9, SchedStatic, false, false>(F.wv, F.lds, 1024, S, E, nullptr);
#endif
            SEAM_L(pb0 + 9);
        }
    }
#undef IN
#undef SEAM
}

#ifdef PROBE_EXTRA
__global__ void __launch_bounds__(NTHREADS, 2) mk_probe(MkArgs args) {
    extern __shared__ __attribute__((aligned(16))) unsigned char lds_raw[];
    Frame F; F.lds = (LAS unsigned char*)lds_raw; F.ws = args.ws; F.wv = __builtin_amdgcn_readfirstlane((int)threadIdx.x >> 6);
    F.G = gridDim.x; F.c = blockIdx.x; F.vcu = F.c; F.tabf = (LAS float*)(F.lds + TABF_OFF); F.tabi = (LAS int*)(F.lds + TABI_OFF); F.tabg = (LAS float*)(F.lds + TABG_OFF);
    unsigned char* ws = args.ws; const int sel = args.ph_lo;
    for (int i = threadIdx.x; i < MAXU * 256; i += NTHREADS) F.tabf[i] = 1.f;
    __syncthreads();
    if (sel >= 10 && sel < 18) {
        CvCtx cv; cv.nl = -1; cv.wsw = ws; cv.stride = 1; cv.ptab = nullptr; int cv_it = 0, cv_iter = 0;
        const float* gq = (const float*)(ws + S_ROPE); const float* rope = (const float*)(ws + S_ROPE);
        const int v = (F.c % 8) * (F.G / 8) + F.c / 8, bh = v >> 1, j = v & 1;
#pragma unroll 1
        for (int i = 0; i < 4; ++i) { const int qb = (i == 0) ? j : (i == 1) ? 7 - j : (i == 2) ? 3 - j : 4 + j;
#define PATT(V) attn_unit<V>(F, bh >> 3, bh & 7, qb, (const bf16_t*)(ws + WS_AM), (const bf16_t*)(ws + WS_X0), (const bf16_t*)(ws + WS_X1), (bf16_t*)(ws + WS_SCR), (float*)(ws + WS_SCR + 64 * MiB), gq, rope, cv, cv_it, cv_iter)
            if (sel == 10) PATT(0); else if (sel == 11) PATT(1); else if (sel == 12) PATT(2); else if (sel == 13) PATT(3); else if (sel == 14) PATT(4); else if (sel == 17) PATT(7);
#undef PATT
        }
    }
    if (sel >= 30 && sel < 40) {
        if ((int)threadIdx.x < 26) ((LAS unsigned long long*)(F.lds + PTR_OFF))[(int)threadIdx.x] = (unsigned long long)args.in[(int)threadIdx.x];
        __syncthreads();
        CvCtx c2; c2.nl = 3; c2.wsw = ws + W_ALT; c2.ptab = (const LAS unsigned long long*)(F.lds + PTR_OFF);
        const int tid_ = my_tid(F.wv); const int wv_ = __builtin_amdgcn_readfirstlane(tid_ >> 6);
        const bool on = (sel == 30) || ((F.c & 3) == 0);
        const int first = (sel == 32) ? (F.c >> 2) * NWAVES + wv_ : F.c * NWAVES + wv_;
        c2.stride = (sel == 32) ? (F.G / 4) * NWAVES : F.G * NWAVES;
        if (on) cv_stream(c2, first, tid_ & 63);
    }
    if (sel == 0) { SchedStatic S; S.init(T, 1024, 256, F.G, F.c, ws + WS_CKV, ws + W_UKV); EpiNull E{(float*)(ws + WS_SCR)}; gemm_phase<EpiNull, SchedStatic, false, false>(F.wv, F.lds, 256, S, E, nullptr); }
    if (sel == 1) { SchedStatic S; S.init(T, 1024, 1024, F.G, F.c, ws + WS_AM, ws + W_OUT); EpiNull E{(float*)(ws + WS_SCR)}; gemm_phase<EpiNull, SchedStatic, false, false>(F.wv, F.lds, 1024, S, E, nullptr); }
    if (sel == 2) { SchedStatic S; S.init(T, 1024, 256, F.G, F.c, ws + WS_CKV, ws + W_UKV); EpiStore<false> E{(bf16_t*)(ws + WS_SCR), 1024, F.tabf}; gemm_phase<EpiStore<false>, SchedStatic, false, false>(F.wv, F.lds, 256, S, E, nullptr); }
    if (sel == 3) { SchedStatic S; S.init(T, 1024, 1024, F.G, F.c, ws + WS_AM, ws + W_OUT); EpiStore<false> E{(bf16_t*)(ws + WS_SCR), 1024, F.tabf}; gemm_phase<EpiStore<false>, SchedStatic, false, false>(F.wv, F.lds, 1024, S, E, nullptr); }
}
#endif

#ifndef FASTMASK
#define FASTMASK 0x7ff
#endif
static void launch_mk(const MkArgs& base, int lo, int hi, int grid, hipStream_t stream) {
    MkArgs a = base; a.ph_lo = lo; a.ph_hi = hi;
    hipLaunchKernelGGL(mk_fwd, dim3(grid), dim3(NTHREADS), LDS_BYTES, stream, a);
}
extern "C" void kernel_launch(void* const* d_in, const int* in_sizes, int n_in, void* d_out, int out_size, void* d_ws, size_t ws_size, hipStream_t stream) {
    static int grid = 0;
    if (grid == 0) {
        if (n_in != 26 || ws_size < WS_END) { fprintf(stderr, "kernel_launch: unexpected n_in %d or ws_size %zu\n", n_in, ws_size); grid = -1; return; }
        int dev = 0, cus = 0;
        if (hipGetDevice(&dev) != hipSuccess || hipDeviceGetAttribute(&cus, hipDeviceAttributeMultiprocessorCount, dev) != hipSuccess) { grid = -1; return; }
        if (hipFuncSetAttribute((const void*)mk_fwd, hipFuncAttributeMaxDynamicSharedMemorySize, LDS_BYTES) != hipSuccess) { fprintf(stderr, "kernel_launch: hipFuncSetAttribute failed\n"); grid = -1; return; }
        int per_cu = 0;
        if (hipOccupancyMaxActiveBlocksPerMultiprocessor(&per_cu, (const void*)mk_fwd, NTHREADS, LDS_BYTES) != hipSuccess || per_cu < 1) fprintf(stderr, "kernel_launch: occupancy query says %d\n", per_cu);
        (void)hipGetLastError();
        grid = cus;
    }
    if (grid < 0) return;
    unsigned char* ws = (unsigned char*)d_ws;
    (void)hipMemsetAsync(ws + WS_ZERO, 0, ZERO_BYTES, stream);
    MkArgs A{};
    for (int i = 0; i < 26; ++i) A.in[i] = (const float*)d_in[i];
    A.out = (float*)d_out; A.ws = ws;
    constexpr unsigned FM = FASTMASK;
    if (FM == 0x7ffu) {
        launch_mk(A, 0, 1 + 10 * NL, grid, stream);
#ifdef PROBE_PH
#ifdef PROBE_EXTRA
        { static bool once = false; if (!once) { (void)hipFuncSetAttribute((const void*)mk_probe, hipFuncAttributeMaxDynamicSharedMemorySize, LDS_BYTES); once = true; }
          MkArgs a = A; a.ph_lo = PROBE_PH; a.ph_hi = 0; for (int r_ = 0; r_ < PROBE_REP; ++r_) hipLaunchKernelGGL(mk_probe, dim3(grid), dim3(NTHREADS), LDS_BYTES, stream, a); }
#else
        for (int r_ = 0; r_ < PROBE_REP; ++r_) launch_mk(A, 31 + PROBE_PH, 32 + PROBE_PH, grid, stream);
#endif
#endif
        return; }
    const float* x = (const float*)d_in[0]; const float* p = (const float*)d_in[1];
    if (FM & 1u) launch_mk(A, 0, 1, grid, stream); else k_prologue<<<1024, 256, 0, stream>>>(x, p, ws);
    float* scr = (float*)(ws + WS_SCR);
    bf16_t* X[2] = {(bf16_t*)(ws + WS_X0), (bf16_t*)(ws + WS_X1)};
    int* gidx = (int*)(ws + S_FLAT); int* tile_e = gidx + 3 * MAXSLOT; int* nrows = tile_e + MAXSLOT / 128 + MAXSLOT;
    for (int l = 0; l < NL; ++l) {
        auto F = [&](int i, size_t per) { return (const float*)d_in[i] + (size_t)l * per; };
        LayerW L;
        L.g_mix = F(2, 1024); L.w_in = F(3, 1024 * 1440); L.g_cq = F(4, 256); L.g_ckv = F(5, 128); L.w_uq = F(6, 256 * 768); L.w_ukv = F(7, 128 * 1024);
        L.g_qn = F(8, 96); L.g_kn = F(9, 96); L.g_v = F(10, 512); L.w_s = F(11, 8 * 128 * 128); L.b_s = F(12, 8 * 128); L.g_oa = F(13, 512); L.g_om = F(14, 512);
        L.w_out = F(15, 1024 * 1024); L.g_ffn = F(16, 1024); L.w_rg = F(17, 1024 * 4); L.w_re = F(18, 1024 * 32);
        L.w1 = F(19, (size_t)32 * 1024 * 512); L.w3 = F(20, (size_t)32 * 1024 * 512); L.w2 = F(21, (size_t)32 * 512 * 1024);
        L.g_ple = F(22, 1024); L.w_pg = F(23, 1024 * 1024); L.b_pg = F(24, 1024); L.w_ple = F(25, 256 * 1024);
        bf16_t* Xin = X[l & 1]; bf16_t* Xmid = X[(l & 1) ^ 1];
        const int pb0 = 1 + 10 * l;
        if (FM & 2u) launch_mk(A, pb0 + 0, pb0 + 1, grid, stream); else k_convert<<<1024, 256, 0, stream>>>(L, ws);
        if (FM & 4u) launch_mk(A, pb0 + 1, pb0 + 2, grid, stream);
        else {
            k_ngemm<<<dim3(NPROJ / 128, T / 128), 256, 0, stream>>>(Xin, 1024, nullptr, (const bf16_t*)(ws + W_IN), 1024, nullptr, 0, scr, NPROJ, 1024, nullptr);
            k_post1<<<T / 4, 256, 0, stream>>>(scr, ws, l, L.g_v);
        }
        if (FM & 8u) launch_mk(A, pb0 + 2, pb0 + 3, grid, stream);
        else {
            k_ngemm<<<dim3(768 / 128, T / 128), 256, 0, stream>>>((const bf16_t*)(ws + WS_CQ), 256, nullptr, (const bf16_t*)(ws + W_UQ), 256, nullptr, 0, scr, 768, 256, nullptr);
            k_post2a<<<T * 768 / 256, 256, 0, stream>>>(scr, ws, l);
            k_ngemm<<<dim3(1024 / 128, T / 128), 256, 0, stream>>>((const bf16_t*)(ws + WS_CKV), 256, nullptr, (const bf16_t*)(ws + W_UKV), 256, nullptr, 0, scr, 1024, 256, nullptr);
            k_post2b<<<T * 8 / 4, 256, 0, stream>>>(scr, ws, l, L.g_kn);
            k_gmlp<<<T * 512 / 256, 256, 0, stream>>>(ws, L.b_s);
            k_rowstat_am<<<T / 4, 256, 0, stream>>>(ws, l, 1);
            k_norm_m<<<T * 512 / 256, 256, 0, stream>>>(ws);
            k_ngemm<<<dim3(1024 / 128, T / 128), 256, 0, stream>>>((const bf16_t*)(ws + WS_PB) + (size_t)l * T * 256, 256, nullptr, (const bf16_t*)(ws + W_PLE), 256, nullptr, 0, scr, 1024, 256, nullptr);
            k_tobf16<<<T * 1024 / 256, 256, 0, stream>>>(scr, (bf16_t*)(ws + WS_E));
        }
        if (FM & 16u) launch_mk(A, pb0 + 3, pb0 + 4, grid, stream);
        else {
            k_attn<<<T * 8 / 64, 64, 0, stream>>>(ws, L.g_qn);
            k_rowstat_am<<<T / 4, 256, 0, stream>>>(ws, l, 0);
        }
        if (FM & 32u) launch_mk(A, pb0 + 4, pb0 + 5, grid, stream);
        else {
            k_ngemm<<<dim3(1024 / 128, T / 128), 256, 0, stream>>>((const bf16_t*)(ws + WS_AM), 1024, nullptr, (const bf16_t*)(ws + W_OUT), 1024, nullptr, 0, scr, 1024, 512, nullptr);
            k_ngemm<<<dim3(1024 / 128, T / 128), 256, 0, stream>>>((const bf16_t*)(ws + WS_AM) + 512, 1024, nullptr, (const bf16_t*)(ws + W_OUT) + 512, 1024, nullptr, 0, scr + (size_t)T * 1024, 1024, 512, nullptr);
            k_post4<<<T * 1024 / 256, 256, 0, stream>>>(scr, ws, l, Xin, Xmid);
        }
        if (FM & 64u) launch_mk(A, pb0 + 5, pb0 + 6, grid, stream); else k_router<<<T / 4, 256, 0, stream>>>(ws, l, Xmid);
        if ((FM & 384u) != 384u) k_build<<<1, 256, 0, stream>>>(ws, l);
        if (FM & 128u) launch_mk(A, pb0 + 6, pb0 + 7, grid, stream);
        else {
            k_ngemm<<<dim3(1024 / 128, MAXSLOT / 128), 256, 0, stream>>>(Xmid, 1024, gidx, (const bf16_t*)(ws + W_13), 1024, tile_e, (size_t)1024 * 1024, scr, 1024, 1024, nrows);
            k_post6<<<MAXSLOT * 512 / 256, 256, 0, stream>>>(scr, ws);
        }
        if (FM & 256u) launch_mk(A, pb0 + 7, pb0 + 8, grid, stream);
        else {
            k_ngemm<<<dim3(1024 / 128, MAXSLOT / 128), 256, 0, stream>>>((const bf16_t*)(ws + WS_H), 512, nullptr, (const bf16_t*)(ws + W_2), 512, tile_e, (size_t)1024 * 512, scr, 1024, 512, nrows);
            k_post7<<<MAXSLOT * 1024 / 256, 256, 0, stream>>>(scr, ws, Xmid);
        }
        if (FM & 512u) launch_mk(A, pb0 + 8, pb0 + 9, grid, stream); else k_combine<<<T / 4, 256, 0, stream>>>(ws, Xin);
        if (FM & 1024u) launch_mk(A, pb0 + 9, pb0 + 10, grid, stream);
        else {
            k_ngemm<<<dim3(1024 / 128, T / 128), 256, 0, stream>>>(Xin, 1024, nullptr, (const bf16_t*)(ws + W_PG), 1024, nullptr, 0, scr, 1024, 1024, nullptr);
            k_post9<<<T / 4, 256, 0, stream>>>(scr, ws, l, Xin, Xmid, l == NL - 1 ? (float*)d_out : nullptr, L.b_pg);
        }
    }
}
```

```cpp
#include <hip/hip_runtime.h>
#include <stdint.h>
#include <stdio.h>

typedef unsigned short bf16_t;
typedef short bf16x8 __attribute__((ext_vector_type(8)));
typedef float f32x4 __attribute__((ext_vector_type(4)));
typedef unsigned u32x4 __attribute__((ext_vector_type(4)));
typedef unsigned u32x2 __attribute__((ext_vector_type(2)));

constexpr int T = 32768, D = 1024, SEQ = 2048, NL = 4;
constexpr int NPROJ = 1536;
constexpr int NEXP = 32, DEXP = 512;
constexpr int MAXSLOT = 73728;
constexpr float EPS = 1e-6f;
constexpr float SM_SCALE = 0.10206207261596577f;

constexpr size_t MiB = 1u << 20;
constexpr size_t WS_ZERO = 0, ZERO_BYTES = 4 * MiB;
constexpr size_t Z_BAR = 0;
constexpr size_t Z_CNT = 16384;
constexpr size_t Z_SSQ = 65536;
constexpr size_t WS_SMALL = 4 * MiB;
constexpr size_t S_ROPE = WS_SMALL;
constexpr size_t S_SSQKR = WS_SMALL + 256 * 1024;
constexpr size_t S_RSTDM = S_SSQKR + 128 * 1024;
constexpr size_t S_RSTD2 = S_RSTDM + 128 * 1024;
constexpr size_t S_SLOTTOK = WS_SMALL + 1 * MiB;
constexpr size_t S_SLOTRSTD = WS_SMALL + 5 * MiB;
constexpr size_t S_SLOTGATE = WS_SMALL + 9 * MiB;
constexpr size_t S_FLAT = WS_SMALL + 13 * MiB;
constexpr size_t WS_W = 20 * MiB;
constexpr size_t W_IN = WS_W;
constexpr size_t W_UQ = W_IN + (size_t)NPROJ * 1024 * 2;
constexpr size_t W_UKV = W_UQ + 768 * 256 * 2;
constexpr size_t W_PLE = W_UKV + 1024 * 256 * 2;
constexpr size_t W_OUT = W_PLE + 1024 * 256 * 2;
constexpr size_t W_PG = W_OUT + 1024 * 1024 * 2;
constexpr size_t W_13 = W_PG + 1024 * 1024 * 2;
constexpr size_t W_2 = W_13 + (size_t)32 * 1024 * 1024 * 2;
constexpr size_t W_R = W_2 + (size_t)32 * 1024 * 512 * 2;
constexpr size_t W_S = W_R + 2 * 64 * 1024 * 2;
constexpr size_t W_END = W_S + 8 * 128 * 128 * 2;
static_assert(W_END <= 126 * MiB, "weights region");
constexpr size_t WS_X0 = 126 * MiB, WS_X1 = 190 * MiB;
constexpr size_t WS_PB = 254 * MiB;
constexpr size_t WS_CQ = 318 * MiB, WS_CKV = 334 * MiB, WS_U = 350 * MiB, WS_V = 382 * MiB;
constexpr size_t WS_H = 318 * MiB;
constexpr size_t WS_Q = 414 * MiB, WS_K = 462 * MiB, WS_VF = 510 * MiB;
constexpr size_t WS_Y0 = 414 * MiB, WS_Y1 = 478 * MiB;
constexpr size_t WS_AM = 542 * MiB;
constexpr size_t WS_E = 606 * MiB;
constexpr size_t WS_SCR = 670 * MiB;
constexpr size_t W_ALT = 682 * MiB;
constexpr size_t WS_X8 = 670 * MiB;
constexpr size_t WS_SSQHP = 958 * MiB;
constexpr size_t WS_SSQAP = 960 * MiB;
constexpr size_t WS_END = 961 * MiB;
static_assert((size_t)MAXSLOT * 512 * 2 <= 96 * MiB, "H overlay");

__device__ __forceinline__ float bf2f(bf16_t v) { return __uint_as_float((unsigned)v << 16); }
__device__ __forceinline__ bf16_t f2bf(float f) { unsigned u = __float_as_uint(f); return (bf16_t)((u + 0x7fffu + ((u >> 16) & 1u)) >> 16); }
__device__ __forceinline__ unsigned pk2(float lo, float hi) { return (unsigned)f2bf(lo) | ((unsigned)f2bf(hi) << 16); }
__device__ __forceinline__ float gelu_tanh(float x) { const float z = -2.3022081983740904f * (x + 0.044715f * x * x * x); return x * __builtin_amdgcn_rcpf(1.f + __builtin_amdgcn_exp2f(z)); }
__device__ __forceinline__ float silu_f(float x) { return x * __builtin_amdgcn_rcpf(1.f + __builtin_amdgcn_exp2f(-1.4426950408889634f * x)); }
__device__ __forceinline__ float sigmoid_f(float x) { return __builtin_amdgcn_rcpf(1.f + __builtin_amdgcn_exp2f(-1.4426950408889634f * x)); }
__device__ __forceinline__ float wave_sum(float v) {
#pragma unroll
    for (int o = 1; o < 64; o <<= 1) v += __shfl_xor(v, o);
    return v;
}
__host__ __device__ __forceinline__ int proj_src(int pc) {
    if (pc < 416) return pc;
    if (pc < 512) return -1;
    if (pc < 1024) return 416 + (pc - 512);
    const int q = pc - 1024, tv = q >> 8, r = q & 255, bj = r >> 7, wc = (r & 127) >> 5, x = r & 31;
    return 928 + 256 * tv + 64 * wc + 32 * bj + x;
}
__host__ __device__ __forceinline__ int ukv_src(int pc) {
    const int t = pc >> 8, r = pc & 255, bj = r >> 7, wc = (r & 127) >> 5, x = r & 31;
    return (2 * t + (wc >> 1)) * 128 + (wc & 1) * 64 + 32 * bj + x;
}

struct LayerW {
    const float *g_mix, *w_in, *g_cq, *g_ckv, *w_uq, *w_ukv, *g_qn, *g_kn, *g_v, *w_s, *b_s, *g_oa, *g_om, *w_out, *g_ffn, *w_rg, *w_re, *w1, *w3, *w2, *g_ple, *w_pg, *b_pg, *w_ple;
};

template <int PART, class Src>
__device__ __forceinline__ void transpose_part(const Src& src, int K, int N, bf16_t* out, int item, int lane, f32x4 (&v)[16]) {
    const int nblk = N / 32, kb_ = item / nblk, nb = item % nblk, kb = lane >> 3, ch = lane & 7, k0 = 64 * kb_ + 8 * kb, n0 = 32 * nb + 4 * ch;
    if (PART != 1) {
#pragma unroll
        for (int j = 0; j < 8; ++j) v[j] = src.load4(k0 + j, n0); }
    if (PART != 0) {
#pragma unroll
        for (int c = 0; c < 4; ++c) {
            u32x4 o; o.x = pk2(v[0][c], v[1][c]); o.y = pk2(v[2][c], v[3][c]); o.z = pk2(v[4][c], v[5][c]); o.w = pk2(v[6][c], v[7][c]);
            *(u32x4*)(out + (size_t)(n0 + c) * K + k0) = o; } }
}
template <class Src>
__device__ __forceinline__ void transpose_item(const Src& src, int K, int N, bf16_t* out, float*  , int item, int lane) { f32x4 v[16]; transpose_part<2>(src, K, N, out, item, lane, v); }
struct SrcIn { const float* w; const float* g; __device__ __forceinline__ f32x4 load4(int k, int n) const { const int s = proj_src(n); return s < 0 ? (f32x4){0.f, 0.f, 0.f, 0.f} : *(const f32x4*)(w + (size_t)k * 1440 + s) * g[k]; } };
struct SrcUq { const float* w; const float* g; __device__ __forceinline__ f32x4 load4(int k, int n) const { return *(const f32x4*)(w + (size_t)k * 768 + n) * g[k]; } };
struct SrcUkv { const float* w; const float* g; __device__ __forceinline__ f32x4 load4(int k, int n) const { return k < 128 ? *(const f32x4*)(w + (size_t)k * 1024 + ukv_src(n)) * g[k] : (f32x4){0.f, 0.f, 0.f, 0.f}; } };
struct SrcPlain { const float* w; int ldw; __device__ __forceinline__ f32x4 load4(int k, int n) const { return *(const f32x4*)(w + (size_t)k * ldw + n); } };
struct SrcOut { const float* w; const float* ga; const float* gm; __device__ __forceinline__ f32x4 load4(int k, int n) const { return *(const f32x4*)(w + (size_t)k * 1024 + n) * (k < 512 ? ga[k] : gm[k - 512]); } };
struct SrcPg { const float* w; const float* g; __device__ __forceinline__ f32x4 load4(int k, int n) const { return *(const f32x4*)(w + (size_t)k * 1024 + n) * g[k]; } };
struct Src13 { const float* w1; const float* w3; const float* g; __device__ __forceinline__ f32x4 load4(int k, int n) const { const int q = n >> 3; const long d13 = (long)(w3 - w1) * (long)((n >> 2) & 1); return *(const f32x4*)(w1 + d13 + (size_t)k * 512 + 4 * q) * g[k]; } };

#ifndef MOE_FP8
#define MOE_FP8 1
#endif
constexpr float W8_SCALE = 32.f, W8_INV = 1.f / 32.f;
__device__ __forceinline__ unsigned pk4_fp8(float a, float b, float c, float d) { int r = __builtin_amdgcn_cvt_pk_fp8_f32(a, b, 0, false); r = __builtin_amdgcn_cvt_pk_fp8_f32(c, d, r, true); return (unsigned)r; }
template <int PART, class Src>
__device__ __forceinline__ void transpose_part_fp8(const Src& src, int K, int N, unsigned char* out, int item, int lane, f32x4 (&v)[16]) {
    const int nblk = N / 32, kb_ = item / nblk, nb = item % nblk, kb = lane >> 3, ch = lane & 7, k0 = 128 * kb_ + 16 * kb, n0 = 32 * nb + 4 * ch;
    if (PART != 1) {
#pragma unroll
        for (int j = 0; j < 16; ++j) v[j] = src.load4(k0 + j, n0); }
    if (PART != 0) {
#pragma unroll
        for (int c = 0; c < 4; ++c) {
            u32x4 o; o.x = pk4_fp8(v[0][c], v[1][c], v[2][c], v[3][c]); o.y = pk4_fp8(v[4][c], v[5][c], v[6][c], v[7][c]); o.z = pk4_fp8(v[8][c], v[9][c], v[10][c], v[11][c]); o.w = pk4_fp8(v[12][c], v[13][c], v[14][c], v[15][c]);
            *(u32x4*)(out + (size_t)(n0 + c) * K + k0) = o; } }
}
template <class Src>
__device__ __forceinline__ void transpose_item_fp8(const Src& src, int K, int N, unsigned char* out, int item, int lane) { f32x4 v[16]; transpose_part_fp8<2>(src, K, N, out, item, lane, v); }
struct Src13F8 { const float* w1; const float* w3; const float* g; __device__ __forceinline__ f32x4 load4(int k, int pc) const {
    const int hcol = ((pc >> 8) << 7) + (((pc >> 5) & 3) << 5) + (((pc >> 3) & 3) << 3) + (((pc >> 7) & 1) << 2); const long d13 = (long)(w3 - w1) * (long)((pc >> 2) & 1);
    return __builtin_nontemporal_load((const f32x4*)(w1 + d13 + (size_t)k * 512 + hcol)) * (g[k] * W8_SCALE); } };
struct SrcPgF8 { const float* w; const float* g; __device__ __forceinline__ f32x4 load4(int k, int n) const { return *(const f32x4*)(w + (size_t)k * 1024 + n) * (g[k] * W8_SCALE); } };
struct SrcPlainF8 { const float* w; int ldw; __device__ __forceinline__ f32x4 load4(int k, int n) const { return __builtin_nontemporal_load((const f32x4*)(w + (size_t)k * ldw + n)) * W8_SCALE; } };
#if MOE_FP8
constexpr int IT_IN = 16 * 48, IT_UQ = 4 * 24, IT_UKV = 4 * 32, IT_PLE = 4 * 32, IT_OUT = 16 * 32, IT_PG = 8 * 32, IT_13 = 8 * 32, IT_2 = 4 * 32;
#else
constexpr int IT_IN = 16 * 48, IT_UQ = 4 * 24, IT_UKV = 4 * 32, IT_PLE = 4 * 32, IT_OUT = 16 * 32, IT_PG = 16 * 32, IT_13 = 16 * 32, IT_2 = 8 * 32;
#endif
constexpr int IT_SMALL = IT_IN + IT_UQ + IT_UKV + IT_PLE + IT_OUT + IT_PG;
constexpr int IT_TOTAL = IT_SMALL + 32 * IT_13 + 32 * IT_2;
__device__ __forceinline__ void convert_item(const LayerW& L, unsigned char* ws, int it, float* scr, int lane) {
    int r = it;
    if (r < IT_IN) { transpose_item(SrcIn{L.w_in, L.g_mix}, 1024, NPROJ, (bf16_t*)(ws + W_IN), scr, r, lane); return; } r -= IT_IN;
    if (r < IT_UQ) { transpose_item(SrcUq{L.w_uq, L.g_cq}, 256, 768, (bf16_t*)(ws + W_UQ), scr, r, lane); return; } r -= IT_UQ;
    if (r < IT_UKV) { transpose_item(SrcUkv{L.w_ukv, L.g_ckv}, 256, 1024, (bf16_t*)(ws + W_UKV), scr, r, lane); return; } r -= IT_UKV;
    if (r < IT_PLE) { transpose_item(SrcPlain{L.w_ple, 1024}, 256, 1024, (bf16_t*)(ws + W_PLE), scr, r, lane); return; } r -= IT_PLE;
    if (r < IT_OUT) { transpose_item(SrcOut{L.w_out, L.g_oa, L.g_om}, 1024, 1024, (bf16_t*)(ws + W_OUT), scr, r, lane); return; } r -= IT_OUT;
#if MOE_FP8
    if (r < IT_PG) { transpose_item_fp8(SrcPgF8{L.w_pg, L.g_ple}, 1024, 1024, ws + W_PG, r, lane); return; } r -= IT_PG;
#else
    if (r < IT_PG) { transpose_item(SrcPg{L.w_pg, L.g_ple}, 1024, 1024, (bf16_t*)(ws + W_PG), scr, r, lane); return; } r -= IT_PG;
#endif
#if MOE_FP8
    if (r < 32 * IT_13) { const int e = r / IT_13; transpose_item_fp8(Src13F8{L.w1 + (size_t)e * 1024 * 512, L.w3 + (size_t)e * 1024 * 512, L.g_ffn}, 1024, 1024, ws + W_13 + (size_t)e * 1024 * 1024, r % IT_13, lane); return; } r -= 32 * IT_13;
    { const int e = r / IT_2; transpose_item_fp8(SrcPlainF8{L.w2 + (size_t)e * 512 * 1024, 1024}, 512, 1024, ws + W_2 + (size_t)e * 1024 * 512, r % IT_2, lane); }
#else
    if (r < 32 * IT_13) { const int e = r / IT_13; transpose_item(Src13{L.w1 + (size_t)e * 1024 * 512, L.w3 + (size_t)e * 1024 * 512, L.g_ffn}, 1024, 1024, (bf16_t*)(ws + W_13) + (size_t)e * 1024 * 1024, scr, r % IT_13, lane); return; } r -= 32 * IT_13;
    { const int e = r / IT_2; transpose_item(SrcPlain{L.w2 + (size_t)e * 512 * 1024, 1024}, 512, 1024, (bf16_t*)(ws + W_2) + (size_t)e * 1024 * 512, scr, r % IT_2, lane); }
#endif
}
#if MOE_FP8
constexpr int IT_MOE = 32 * IT_13 + 32 * IT_2;
template <int PART>
__device__ __forceinline__ void convert_part_moe(const float* w1, const float* w3, const float* w2, const float* g_ffn, unsigned char* ws, int it, int lane, f32x4 (&v)[16]) {
    if (it < 32 * IT_13) { const int e = it / IT_13; transpose_part_fp8<PART>(Src13F8{w1 + (size_t)e * 1024 * 512, w3 + (size_t)e * 1024 * 512, g_ffn}, 1024, 1024, ws + W_13 + (size_t)e * 1024 * 1024, it % IT_13, lane, v); }
    else { const int r = it - 32 * IT_13, e = r / IT_2; transpose_part_fp8<PART>(SrcPlainF8{w2 + (size_t)e * 512 * 1024, 1024}, 512, 1024, ws + W_2 + (size_t)e * 1024 * 512, r % IT_2, lane, v); }
}
#endif
__device__ __forceinline__ void convert_small(const LayerW& L, unsigned char* ws, int gtid, int gthreads) {
    bf16_t* hi = (bf16_t*)(ws + W_R); bf16_t* lo = hi + 64 * 1024;
    for (int i = gtid; i < 64 * 1024; i += gthreads) {
        const int n = i >> 10, k = i & 1023; float w = 0.f;
        if (n < 4) w = L.g_ffn[k] * L.w_rg[k * 4 + n]; else if (n < 36) w = L.g_ffn[k] * L.w_re[k * 32 + (n - 4)];
        const bf16_t h = f2bf(w); hi[i] = h; lo[i] = f2bf(w - bf2f(h));
    }
    bf16_t* wsb = (bf16_t*)(ws + W_S);
    for (int i = gtid; i < 8 * 128 * 128; i += gthreads) { const int t = (i >> 7) & 127, j = i & 127; wsb[i] = (t < 64 && j >= 64) ? (bf16_t)0 : f2bf(L.w_s[i]); }
}
__global__ void __launch_bounds__(256) k_convert(LayerW L, unsigned char* ws) {
    __shared__ float scr[4][64 * 33];
    const int lane = threadIdx.x & 63, w = threadIdx.x >> 6, gw = blockIdx.x * 4 + w, ngw = gridDim.x * 4;
    for (int it = gw; it < IT_TOTAL; it += ngw) convert_item(L, ws, it, scr[w], lane);
    convert_small(L, ws, blockIdx.x * 256 + threadIdx.x, gridDim.x * 256);
}

__global__ void __launch_bounds__(256) k_prologue(const float* x, const float* p, unsigned char* ws) {
    const int lane = threadIdx.x & 63, gw = (blockIdx.x * 256 + threadIdx.x) >> 6, ngw = gridDim.x * 4;
    bf16_t* X0 = (bf16_t*)(ws + WS_X0); float* ssqh = (float*)(ws + Z_SSQ) + (size_t)12 * T;
    for (int m = gw; m < T; m += ngw) {
        const f32x4* xr = (const f32x4*)(x + (size_t)m * D) + lane; float s = 0.f;
        u32x2* o = (u32x2*)(X0 + (size_t)m * D) + lane;
#pragma unroll
        for (int j = 0; j < 4; ++j) { const f32x4 v = xr[64 * j]; s += v.x * v.x + v.y * v.y + v.z * v.z + v.w * v.w; u32x2 w; w.x = pk2(v.x, v.y); w.y = pk2(v.z, v.w); o[64 * j] = w; }
        s = wave_sum(s); if (lane == 0) ssqh[m] = s;
        if (lane < 16) ((float*)(ws + WS_SSQHP))[(size_t)lane * T + m] = lane == 0 ? s : 0.f;
    }
    bf16_t* pb = (bf16_t*)(ws + WS_PB);
    const size_t n4 = (size_t)NL * T * 256 / 4, gt = (size_t)blockIdx.x * 256 + threadIdx.x, ngt = (size_t)gridDim.x * 256;
    for (size_t i = gt; i < n4; i += ngt) { const f32x4 v = ((const f32x4*)p)[i]; u32x2 w; w.x = pk2(v.x, v.y); w.y = pk2(v.z, v.w); ((u32x2*)pb)[i] = w; }
    float* rope = (float*)(ws + S_ROPE);
    for (size_t i = gt; i < 2048 * 16; i += ngt) {
        const int pos = (int)(i >> 4), k = (int)(i & 15);
        const double inv = exp(-(double)(2 * k) / 32.0 * log(10000.0)), ang = (double)pos * inv;
        rope[2 * i] = (float)cos(ang); rope[2 * i + 1] = (float)sin(ang);
    }
}

__global__ void __launch_bounds__(256) k_ngemm(const bf16_t* A, int lda, const int* gidx, const bf16_t* Bt, int ldb, const int* bsel, size_t bstride, float* C, int ldc, int K, const int* mlimit) {
    const int lane = threadIdx.x & 63, w = threadIdx.x >> 6, fr = lane & 15, fq = lane >> 4;
    const int row0 = blockIdx.y * 128 + (w >> 1) * 64, col0 = blockIdx.x * 128 + (w & 1) * 64;
    if (mlimit && blockIdx.y * 128 >= *mlimit) return;
    if (bsel) Bt += (size_t)bsel[blockIdx.y] * bstride;
    const bf16_t* ap[4]; const bf16_t* bp[4];
#pragma unroll
    for (int i = 0; i < 4; ++i) { const int r = row0 + 16 * i + fr; ap[i] = A + (size_t)(gidx ? gidx[r] : r) * lda + 8 * fq; bp[i] = Bt + (size_t)(col0 + 16 * i + fr) * ldb + 8 * fq; }
    f32x4 acc[4][4];
#pragma unroll
    for (int i = 0; i < 4; ++i)
#pragma unroll
        for (int j = 0; j < 4; ++j) acc[i][j] = (f32x4){0.f, 0.f, 0.f, 0.f};
    for (int k0 = 0; k0 < K; k0 += 32) {
        bf16x8 a[4], b[4];
#pragma unroll
        for (int i = 0; i < 4; ++i) { a[i] = *(const bf16x8*)(ap[i] + k0); b[i] = *(const bf16x8*)(bp[i] + k0); }
#pragma unroll
        for (int i = 0; i < 4; ++i)
#pragma unroll
            for (int j = 0; j < 4; ++j) acc[i][j] = __builtin_amdgcn_mfma_f32_16x16x32_bf16(b[j], a[i], acc[i][j], 0, 0, 0);
    }
#pragma unroll
    for (int i = 0; i < 4; ++i)
#pragma unroll
        for (int j = 0; j < 4; ++j) *(f32x4*)(C + (size_t)(row0 + 16 * i + fr) * ldc + col0 + 16 * j + 4 * fq) = acc[i][j];
}

__global__ void __launch_bounds__(256) k_post1(const float* scr, unsigned char* ws, int layer, const float* g_v) {
    const int lane = threadIdx.x & 63, row = (blockIdx.x * 256 + threadIdx.x) >> 6;
    const float* ssq = (const float*)(ws + Z_SSQ);
    const float rstd = rsqrtf(ssq[(size_t)(12 + layer) * T + row] * (1.f / 1024.f) + EPS);
    const float* s = scr + (size_t)row * NPROJ;
    bf16_t* cq = (bf16_t*)(ws + WS_CQ) + (size_t)row * 256; bf16_t* ckv = (bf16_t*)(ws + WS_CKV) + (size_t)row * 256;
    bf16_t* u = (bf16_t*)(ws + WS_U) + (size_t)row * 512; bf16_t* v = (bf16_t*)(ws + WS_V) + (size_t)row * 512;
    float a = 0.f, b = 0.f, c = 0.f;
    for (int i = lane; i < 256; i += 64) { const float x = s[i] * rstd; cq[i] = f2bf(x); a += x * x; }
    for (int i = lane; i < 256; i += 64) { const float x = s[256 + i] * rstd; ckv[i] = f2bf(x); if (i < 128) b += x * x; else if (i < 160) c += x * x; }
    a = wave_sum(a); b = wave_sum(b); c = wave_sum(c);
    if (lane == 0) { ((float*)(ws + Z_SSQ))[(size_t)(0 + layer) * T + row] = a; ((float*)(ws + Z_SSQ))[(size_t)(4 + layer) * T + row] = b; ((float*)(ws + S_SSQKR))[row] = c; }
    for (int i = lane; i < 512; i += 64) u[i] = f2bf(gelu_tanh(s[512 + i] * rstd));
    for (int g = 0; g < 8; ++g) {
        const int lc = 64 * g + lane;
        const int tv = lc >> 8, wc = (lc & 255) >> 6, bj = (lc & 63) >> 5, x = lc & 31, pc = 1024 + 256 * tv + 128 * bj + 32 * wc + x;
        const float val = gelu_tanh(s[pc] * rstd); const float q = wave_sum(val * val);
        v[lc] = f2bf(val * rsqrtf(q * (1.f / 64.f) + EPS) * g_v[g * 64 + lane]);
    }
}
__global__ void __launch_bounds__(256) k_post2a(const float* scr, unsigned char* ws, int layer) {
    const size_t i = (size_t)blockIdx.x * 256 + threadIdx.x; const int row = (int)(i / 768);
    const float rs = rsqrtf(((const float*)(ws + Z_SSQ))[(size_t)layer * T + row] * (1.f / 256.f) + EPS);
    ((bf16_t*)(ws + WS_Q))[i] = f2bf(scr[i] * rs);
}
__global__ void __launch_bounds__(256) k_post2b(const float* scr, unsigned char* ws, int layer, const float* g_kn) {
    const int lane = threadIdx.x & 63, gw = (blockIdx.x * 256 + threadIdx.x) >> 6, row = gw >> 3, h = gw & 7;
    const float rckv = rsqrtf(((const float*)(ws + Z_SSQ))[(size_t)(4 + layer) * T + row] * (1.f / 128.f) + EPS);
    const float ssqkr = ((const float*)(ws + S_SSQKR))[row];
    const int t = h >> 1, bj = lane >> 5, x = lane & 31;
    const float kn = scr[(size_t)row * 1024 + 256 * t + 128 * bj + 32 * (2 * (h & 1) + 0) + x] * rckv;
    const float vv = scr[(size_t)row * 1024 + 256 * t + 128 * bj + 32 * (2 * (h & 1) + 1) + x] * rckv;
    const float sk = wave_sum(kn * kn);
    const float rk = rsqrtf((sk + ssqkr) * (1.f / 96.f) + EPS);
    bf16_t* Kf = (bf16_t*)(ws + WS_K) + (size_t)row * 768 + h * 96; bf16_t* Vf = (bf16_t*)(ws + WS_VF) + (size_t)row * 512 + h * 64;
    Kf[lane] = f2bf(kn * rk * g_kn[lane]); Vf[lane] = f2bf(vv);
    if (lane < 16) {
        const bf16_t* kr = (const bf16_t*)(ws + WS_CKV) + (size_t)row * 256 + 128; const float* rope = (const float*)(ws + S_ROPE) + ((size_t)(row & 2047) * 16 + lane) * 2;
        const float x1 = bf2f(kr[lane]) * rk * g_kn[64 + lane], x2 = bf2f(kr[16 + lane]) * rk * g_kn[80 + lane], cs = rope[0], sn = rope[1];
        Kf[64 + lane] = f2bf(x1 * cs - x2 * sn); Kf[80 + lane] = f2bf(x2 * cs + x1 * sn);
    }
}
__global__ void __launch_bounds__(256) k_gmlp(unsigned char* ws, const float* b_s) {
    const size_t i = (size_t)blockIdx.x * 256 + threadIdx.x; const int tok = (int)(i >> 9), col = (int)(i & 511), g = col >> 6, t = tok & 127, blk = tok >> 7;
    const bf16_t* wsb = (const bf16_t*)(ws + W_S) + ((size_t)g * 128 + t) * 128; const bf16_t* v = (const bf16_t*)(ws + WS_V) + (size_t)blk * 128 * 512 + col;
    float s = 0.f;
    for (int j = 0; j < 128; ++j) s += bf2f(wsb[j]) * bf2f(v[(size_t)j * 512]);
    s += b_s[g * 128 + t];
    ((bf16_t*)(ws + WS_AM))[(size_t)tok * 1024 + 512 + col] = f2bf(bf2f(((const bf16_t*)(ws + WS_U))[i]) * s);
}
__global__ void __launch_bounds__(256) k_rowstat_am(unsigned char* ws, int layer, int mode) {
    const int lane = threadIdx.x & 63, row = (blockIdx.x * 256 + threadIdx.x) >> 6;
    const bf16_t* p = (const bf16_t*)(ws + WS_AM) + (size_t)row * 1024 + (mode ? 512 : 0); float s = 0.f;
    for (int i = lane; i < 512; i += 64) { const float x = bf2f(p[i]); s += x * x; }
    s = wave_sum(s);
    if (lane == 0) { if (mode) ((float*)(ws + S_RSTDM))[row] = rsqrtf(s * (1.f / 512.f) + EPS); else ((float*)(ws + Z_SSQ))[(size_t)(8 + layer) * T + row] = s; }
    if (!mode && lane < 8) ((float*)(ws + WS_SSQAP))[(size_t)lane * T + row] = lane == 0 ? s : 0.f;
}
__global__ void __launch_bounds__(256) k_norm_m(unsigned char* ws) {
    const size_t i = (size_t)blockIdx.x * 256 + threadIdx.x; const int row = (int)(i >> 9), c = (int)(i & 511);
    bf16_t* p = (bf16_t*)(ws + WS_AM) + (size_t)row * 1024 + 512 + c; *p = f2bf(bf2f(*p) * ((const float*)(ws + S_RSTDM))[row]);
}
__global__ void __launch_bounds__(256) k_tobf16(const float* scr, bf16_t* out) { const size_t i = (size_t)blockIdx.x * 256 + threadIdx.x; out[i] = f2bf(scr[i]); }
__global__ void __launch_bounds__(64) k_attn(unsigned char* ws, const float* g_qn) {
    const int t = (blockIdx.x & 31) * 64 + threadIdx.x, bh = blockIdx.x >> 5, h = bh & 7, b = bh >> 3, row = b * 2048 + t;
    const bf16_t* qr = (const bf16_t*)(ws + WS_Q) + (size_t)row * 768 + h * 96;
    float q[96]; float ss = 0.f;
#pragma unroll
    for (int d = 0; d < 96; ++d) { q[d] = bf2f(qr[d]); ss += q[d] * q[d]; }
    const float rq = rsqrtf(ss * (1.f / 96.f) + EPS);
#pragma unroll
    for (int d = 0; d < 96; ++d) q[d] = q[d] * rq * g_qn[d];
    const float* rope = (const float*)(ws + S_ROPE) + (size_t)t * 32;
#pragma unroll
    for (int i = 0; i < 16; ++i) { const float cs = rope[2 * i], sn = rope[2 * i + 1], x1 = q[64 + i], x2 = q[80 + i]; q[64 + i] = x1 * cs - x2 * sn; q[80 + i] = x2 * cs + x1 * sn; }
#pragma unroll
    for (int d = 0; d < 96; ++d) q[d] *= SM_SCALE;
    float o[64];
#pragma unroll
    for (int d = 0; d < 64; ++d) o[d] = 0.f;
    float m = -1e30f, l = 0.f;
    const int nk = ((t >> 6) + 1) * 64;
    const bf16_t* Kb = (const bf16_t*)(ws + WS_K) + (size_t)(b * 2048) * 768 + h * 96; const bf16_t* Vb = (const bf16_t*)(ws + WS_VF) + (size_t)(b * 2048) * 512 + h * 64;
    for (int j = 0; j < nk; ++j) {
        const bf16_t* kr = Kb + (size_t)j * 768; float s = 0.f;
#pragma unroll
        for (int d = 0; d < 96; ++d) s += q[d] * bf2f(kr[d]);
        const float mn = fmaxf(m, s), f = __expf(m - mn), pp = __expf(s - mn);
        l = l * f + pp; m = mn;
        const bf16_t* vr = Vb + (size_t)j * 512;
#pragma unroll
        for (int d = 0; d < 64; ++d) o[d] = o[d] * f + pp * bf2f(vr[d]);
    }
    const float il = 1.f / l; bf16_t* out = (bf16_t*)(ws + WS_AM) + (size_t)row * 1024 + h * 64;
#pragma unroll
    for (int d = 0; d < 64; ++d) out[d] = f2bf(o[d] * il);
}
__global__ void __launch_bounds__(256) k_post4(const float* scr, unsigned char* ws, int layer, const bf16_t* Xin, bf16_t* Xout) {
    const size_t i = (size_t)blockIdx.x * 256 + threadIdx.x; const int row = (int)(i >> 10);
    const float ra = rsqrtf(((const float*)(ws + Z_SSQ))[(size_t)(8 + layer) * T + row] * (1.f / 512.f) + EPS);
    Xout[i] = f2bf(bf2f(Xin[i]) + ra * scr[i] + scr[(size_t)T * 1024 + i]);
}
__global__ void __launch_bounds__(256) k_router(unsigned char* ws, int layer, const bf16_t* X) {
    const int lane = threadIdx.x & 63, tok = (blockIdx.x * 256 + threadIdx.x) >> 6;
    const bf16_t* xr = X + (size_t)tok * 1024; const bf16_t* hi = (const bf16_t*)(ws + W_R); const bf16_t* lo = hi + 64 * 1024;
    float xv[16]; float ss = 0.f;
#pragma unroll
    for (int j = 0; j < 16; ++j) { xv[j] = bf2f(xr[lane + 64 * j]); ss += xv[j] * xv[j]; }
    ss = wave_sum(ss); const float rstd = rsqrtf(ss * (1.f / 1024.f) + EPS);
    float lg[36];
#pragma unroll
    for (int n = 0; n < 36; ++n) { float s = 0.f;
#pragma unroll
        for (int j = 0; j < 16; ++j) s += xv[j] * (bf2f(hi[n * 1024 + lane + 64 * j]) + bf2f(lo[n * 1024 + lane + 64 * j]));
        lg[n] = wave_sum(s) * rstd; }
    if (lane == 0) {
        int gs = 0; float gm = lg[0];
#pragma unroll
        for (int g = 1; g < 4; ++g) if (lg[g] > gm) { gm = lg[g]; gs = g; }
        float den = 0.f;
#pragma unroll
        for (int g = 0; g < 4; ++g) den += __expf(lg[g] - gm);
        const float psel = 1.f / den;
        float le[8];
#pragma unroll
        for (int i = 0; i < 8; ++i) le[i] = gs == 0 ? lg[4 + i] : gs == 1 ? lg[12 + i] : gs == 2 ? lg[20 + i] : lg[28 + i];
        int i0 = 0; float v0 = le[0];
#pragma unroll
        for (int i = 1; i < 8; ++i) if (le[i] > v0) { v0 = le[i]; i0 = i; }
        int i1 = -1; float v1 = -3.0e38f;
#pragma unroll
        for (int i = 0; i < 8; ++i) if (i != i0 && le[i] > v1) { v1 = le[i]; i1 = i; }
        const float e1 = __expf(v1 - v0), g0 = psel / (1.f + e1), g1 = psel * e1 / (1.f + e1);
        int* cnt = (int*)(ws + Z_CNT) + layer * 64; int* stok = (int*)(ws + S_SLOTTOK); float* srs = (float*)(ws + S_SLOTRSTD); float* sg = (float*)(ws + S_SLOTGATE);
        const int ea = gs * 8 + i0, eb = gs * 8 + i1;
        const int pa = atomicAdd(cnt + ea, 1), pb = atomicAdd(cnt + eb, 1);
        stok[(size_t)ea * T + pa] = tok; srs[(size_t)ea * T + pa] = rstd; sg[(size_t)ea * T + pa] = g0;
        stok[(size_t)eb * T + pb] = tok | (1 << 30); srs[(size_t)eb * T + pb] = rstd; sg[(size_t)eb * T + pb] = g1;
    }
}
__global__ void __launch_bounds__(256) k_build(unsigned char* ws, int layer) {
    __shared__ int pbase[33], cnts[32];
    const int* cnt = (const int*)(ws + Z_CNT) + layer * 64;
    if (threadIdx.x == 0) { int b = 0; for (int e = 0; e < 32; ++e) { cnts[e] = cnt[e]; pbase[e] = b; b += (cnt[e] + 255) / 256 * 256; } pbase[32] = b; }
    __syncthreads();
    int* gidx = (int*)(ws + S_FLAT); float* fgate = (float*)(gidx + MAXSLOT); float* frstd = fgate + MAXSLOT; int* tile_e = (int*)(frstd + MAXSLOT); int* ftok = tile_e + MAXSLOT / 128; int* nrows = ftok + MAXSLOT;
    const int* stok = (const int*)(ws + S_SLOTTOK); const float* srs = (const float*)(ws + S_SLOTRSTD); const float* sg = (const float*)(ws + S_SLOTGATE);
    if (threadIdx.x == 0) nrows[0] = pbase[32];
    for (int e = 0; e < 32; ++e) {
        const int n = pbase[e + 1] - pbase[e];
        for (int i = threadIdx.x; i < n; i += 256) {
            const int s = pbase[e] + i; const bool ok = i < cnts[e];
            const int tk = ok ? stok[(size_t)e * T + i] : -1;
            gidx[s] = ok ? (tk & 0x3fffffff) : 0; ftok[s] = tk; fgate[s] = ok ? sg[(size_t)e * T + i] : 0.f; frstd[s] = ok ? srs[(size_t)e * T + i] : 0.f;
            if ((i & 127) == 0) tile_e[s >> 7] = e;
        }
    }
}
__global__ void __launch_bounds__(256) k_post6(const float* scr, unsigned char* ws) {
    const int* gidx = (const int*)(ws + S_FLAT); const float* frstd = (const float*)(gidx + 2 * MAXSLOT); const int* nrows = gidx + 3 * MAXSLOT + MAXSLOT / 128 + MAXSLOT;
    const size_t i = (size_t)blockIdx.x * 256 + threadIdx.x; const int slot = (int)(i >> 9), j = (int)(i & 511);
    if (slot >= nrows[0]) return;
    const float rs = frstd[slot]; const float* s = scr + (size_t)slot * 1024 + 8 * (j >> 2) + (j & 3);
    ((bf16_t*)(ws + WS_H))[i] = f2bf(silu_f(rs * s[0]) * (rs * s[4]));
}
__global__ void __launch_bounds__(256) k_post7(const float* scr, unsigned char* ws, const bf16_t* X1) {
    const int* gidx = (const int*)(ws + S_FLAT); const float* fgate = (const float*)(gidx + MAXSLOT); const int* ftok = gidx + 3 * MAXSLOT + MAXSLOT / 128; const int* nrows = ftok + MAXSLOT;
    const size_t i = (size_t)blockIdx.x * 256 + threadIdx.x; const int slot = (int)(i >> 10), n = (int)(i & 1023);
    if (slot >= nrows[0]) return;
    const int tk = ftok[slot]; if (tk < 0) return;
    const int tok = tk & 0x3fffffff, k = tk >> 30;
    const float v = fgate[slot] * scr[i];
    if (k == 0) ((bf16_t*)(ws + WS_Y0))[(size_t)tok * 1024 + n] = f2bf(bf2f(X1[(size_t)tok * 1024 + n]) + v);
    else ((bf16_t*)(ws + WS_Y1))[(size_t)tok * 1024 + n] = f2bf(v);
}
__global__ void __launch_bounds__(256) k_combine(unsigned char* ws, bf16_t* Xout) {
    const int lane = threadIdx.x & 63, row = (blockIdx.x * 256 + threadIdx.x) >> 6;
    const bf16_t* y0 = (const bf16_t*)(ws + WS_Y0) + (size_t)row * 1024; const bf16_t* y1 = (const bf16_t*)(ws + WS_Y1) + (size_t)row * 1024; float s = 0.f;
    for (int i = lane; i < 1024; i += 64) { const float v = bf2f(y0[i]) + bf2f(y1[i]); const bf16_t r = f2bf(v); Xout[(size_t)row * 1024 + i] = r; const float vr = bf2f(r); s += vr * vr; }
    s = wave_sum(s); if (lane == 0) ((float*)(ws + S_RSTD2))[row] = rsqrtf(s * (1.f / 1024.f) + EPS);
}
__global__ void __launch_bounds__(256) k_post9(const float* scr, unsigned char* ws, int layer, const bf16_t* Xin, bf16_t* Xout, float* fout, const float* b_pg) {
    const int lane = threadIdx.x & 63, row = (blockIdx.x * 256 + threadIdx.x) >> 6;
    const float rs = ((const float*)(ws + S_RSTD2))[row]; const bf16_t* e = (const bf16_t*)(ws + WS_E) + (size_t)row * 1024; float s = 0.f;
    for (int i = lane; i < 1024; i += 64) {
        const size_t o = (size_t)row * 1024 + i;
        const float v = bf2f(Xin[o]) + bf2f(e[i]) * sigmoid_f(rs * scr[o] + b_pg[i]);
        Xout[o] = f2bf(v); if (fout) fout[o] = v; s += v * v;
    }
    s = wave_sum(s); if (lane == 0) ((float*)(ws + Z_SSQ))[(size_t)(12 + layer + 1) * T + row] = s;
    if (lane < 16) ((float*)(ws + WS_SSQHP))[(size_t)lane * T + row] = lane == 0 ? s : 0.f;
}

#define LAS __attribute__((address_space(3)))
#define FILL_LAYERW(L, LF) \
            L.g_mix = LF(2, 1024); L.w_in = LF(3, 1024 * 1440); L.g_cq = LF(4, 256); L.g_ckv = LF(5, 128); L.w_uq = LF(6, 256 * 768); L.w_ukv = LF(7, 128 * 1024); \
            L.g_qn = LF(8, 96); L.g_kn = LF(9, 96); L.g_v = LF(10, 512); L.w_s = LF(11, 8 * 128 * 128); L.b_s = LF(12, 8 * 128); L.g_oa = LF(13, 512); L.g_om = LF(14, 512); \
            L.w_out = LF(15, 1024 * 1024); L.g_ffn = LF(16, 1024); L.w_rg = LF(17, 1024 * 4); L.w_re = LF(18, 1024 * 32); \
            L.w1 = LF(19, (size_t)32 * 1024 * 512); L.w3 = LF(20, (size_t)32 * 1024 * 512); L.w2 = LF(21, (size_t)32 * 512 * 1024); \
            L.g_ple = LF(22, 1024); L.w_pg = LF(23, 1024 * 1024); L.b_pg = LF(24, 1024); L.w_ple = LF(25, 256 * 1024);
typedef float f32x16 __attribute__((ext_vector_type(16)));
typedef short v4i16_t __attribute__((ext_vector_type(4)));
constexpr int NWAVES = 8, NTHREADS = 512;
constexpr int BM = 256, BK = 64, HALF = 128, HTB = HALF * BK * 2, NXCD = 8, WGM = 8;
constexpr int RING_BYTES = 131072, MAXU = 5;
constexpr int TABF_OFF = RING_BYTES, TABI_OFF = TABF_OFF + MAXU * 1024, TABG_OFF = TABI_OFF + MAXU * 1024;
constexpr int MISC_OFF = TABG_OFF + MAXU * 1024;
constexpr int LDS_BYTES = 155648;
constexpr int PTR_OFF = MISC_OFF + 1792;
static_assert(MISC_OFF + 384 + 320 * 4 <= PTR_OFF && PTR_OFF + 26 * 8 <= LDS_BYTES, "LDS map");
#define GAS __attribute__((address_space(1)))
__device__ __forceinline__ const float* lds_inptr(const LAS unsigned long long* tab, int i) {
    const unsigned long long v = tab[i]; const unsigned lo = __builtin_amdgcn_readfirstlane((unsigned)v), hi = __builtin_amdgcn_readfirstlane((unsigned)(v >> 32));
    return (const float*)(const GAS float*)(((unsigned long long)hi << 32) | lo);
}

__host__ __device__ __forceinline__ int lds_byte(int r, int c) { const int st = (r >> 4) * 2 + (c >> 5), rr = r & 15, cc = c & 31, ob = rr * 64 + cc * 2; return st * 1024 + (ob ^ (((ob >> 9) & 1) << 5)); }
__host__ __device__ __forceinline__ void stage_rc(int b, int& R, int& C) { const int st = b / 1024, sb = b % 1024, swz = sb ^ (((sb >> 9) & 1) << 5); R = (st >> 1) * 16 + swz / 64; C = (st & 1) * 32 + (swz % 64) / 2; }
__host__ __device__ __forceinline__ int perm32(int rho) { const int n = rho >> 4, i = rho & 15; return 8 * (i >> 2) + 4 * n + (i & 3); }
typedef float f32x2_t __attribute__((ext_vector_type(2))); typedef __bf16 bf16x2_t __attribute__((ext_vector_type(2)));
__device__ __forceinline__ unsigned cvt_pk_bf16(float lo, float hi) { f32x2_t v = {lo, hi}; bf16x2_t b = __builtin_convertvector(v, bf16x2_t); return __builtin_bit_cast(unsigned, b); }
__device__ __forceinline__ u32x4 pack8(const f32x4 a, const f32x4 b) { u32x4 w; w.x = cvt_pk_bf16(a[0], a[1]); w.y = cvt_pk_bf16(a[2], a[3]); w.z = cvt_pk_bf16(b[0], b[1]); w.w = cvt_pk_bf16(b[2], b[3]); return w; }
__device__ __forceinline__ f32x4 unpack_lo(u32x2 w) { return (f32x4){__uint_as_float(w.x << 16), __uint_as_float(w.x & 0xffff0000u), __uint_as_float(w.y << 16), __uint_as_float(w.y & 0xffff0000u)}; }
__device__ __forceinline__ f32x4 unpack_fp8x4(unsigned w) { typedef float f2 __attribute__((ext_vector_type(2))); const f2 lo = __builtin_amdgcn_cvt_pk_f32_fp8((int)w, false), hi = __builtin_amdgcn_cvt_pk_f32_fp8((int)w, true); return (f32x4){lo[0], lo[1], hi[0], hi[1]}; }
__device__ __forceinline__ float red4(float s) { s += __shfl_xor(s, 16); s += __shfl_xor(s, 32); return s; }
__device__ __forceinline__ float sq4(const f32x4 v) { return (v[0] * v[0] + v[1] * v[1]) + (v[2] * v[2] + v[3] * v[3]); }

__device__ __forceinline__ int opaque_v(int x) { asm volatile("" : "+v"(x)); return x; }
__device__ __forceinline__ int my_tid(int wv) { unsigned mk = ~0u; asm volatile("" : "+s"(mk)); return wv * 64 + (int)__builtin_amdgcn_mbcnt_hi(mk, __builtin_amdgcn_mbcnt_lo(mk, 0u)); }
struct Unit { int pm, pn, ti, e; };
struct SchedStatic {
    int nM, nN, nwg, G, c; const char* A; const char* B; size_t tstep;
    __device__ __forceinline__ void init(int M, int N, int K, int G_, int c_, const void* A_, const void* B_) { nM = M / BM; nN = N / BM; nwg = nM * nN; G = G_; c = c_; A = (const char*)A_; B = (const char*)B_; tstep = (size_t)BM * K * 2; }
    __device__ __forceinline__ bool next(int i, Unit& u) const {
        const long L = (long)i * G + c; if (L >= nwg) return false;
        int wgid = (int)L; { const int q = nwg / NXCD, r = nwg % NXCD, xcd = wgid % NXCD, off = wgid / NXCD; wgid = (xcd < r ? xcd * (q + 1) : r * (q + 1) + (xcd - r) * q) + off; }
        const int nig = WGM * nN, gid = wgid / nig, fm = gid * WGM, gsz = (nM - fm) < WGM ? (nM - fm) : WGM;
        u.pm = fm + ((wgid % nig) % gsz); u.pn = (wgid % nig) / gsz; u.ti = i; u.e = 0; return true;
    }
    __device__ __forceinline__ const char* aptr(const Unit& u) const { return A + (size_t)u.pm * tstep; }
    __device__ __forceinline__ const char* bptr(const Unit& u) const { return B + (size_t)u.pn * tstep; }
};
struct SchedE : SchedStatic {
    __device__ __forceinline__ bool next(int i, Unit& u) const {
        if ((G & 7) != 0 || G != 256) return SchedStatic::next(i, u);
        const int xcd = c & 7, rank = c >> 3, j = rank < 16 ? (i == 0 ? rank : -1) : (i < 3 ? 16 + (rank - 16) * 3 + i : -1);
        if (j < 0) return false;
        const int wgid = xcd * (nwg / NXCD) + j;
        const int nig = WGM * nN, gid = wgid / nig, fm = gid * WGM, gsz = (nM - fm) < WGM ? (nM - fm) : WGM;
        u.pm = fm + ((wgid % nig) % gsz); u.pn = (wgid % nig) / gsz; u.ti = i; u.e = 0; return true;
    }
};
struct SchedMoe {
    int ntiles, G, c; const LAS int* te; const char* A; const char* B; size_t astep, bestep, bnstep;
    __device__ __forceinline__ bool next(int i, Unit& u) const {
        int pm, pn;
        if ((G & 7) == 0) {
            const int x = c & 7, r = c >> 3, per = G >> 3, t0 = (ntiles * x) >> 3, t1 = (ntiles * (x + 1)) >> 3, j = i * per + r;
            if (j >= (t1 - t0) * 4) return false;
            pm = t0 + (j >> 2); pn = j & 3;
        } else { const int L = i * G + c; if (L >= ntiles * 4) return false; pm = L >> 2; pn = L & 3; }
        u.pm = pm; u.pn = pn; u.ti = i; u.e = __builtin_amdgcn_readfirstlane(te[pm]); return true;
    }
    __device__ __forceinline__ const char* aptr(const Unit& u) const { return A + (size_t)u.pm * astep; }
    __device__ __forceinline__ const char* bptr(const Unit& u) const { return B + (size_t)u.e * bestep + (size_t)u.pn * bnstep; }
};

typedef int i32x8 __attribute__((ext_vector_type(8)));
typedef int i32x4v __attribute__((ext_vector_type(4)));
template <class Epi, class Sched, bool GATHER, bool MIDK, bool FP8 = false>
__device__ __forceinline__ void gemm_phase(const int wv_, LAS unsigned char* lds, const int K, const Sched& S, const Epi& E, const LAS int* gtab) {
    const int tid = my_tid(wv_), wid = wv_, lane = tid & 63, wr = wid >> 2, wc = wid & 3, fr = lane & 15, fq = lane >> 4;
    const int nt = K / BK;
    const unsigned hstep = (unsigned)HALF * K * 2;
    unsigned vB[2], vAc[2][2];
#pragma unroll
    for (int i = 0; i < 2; ++i) { int R, C; stage_rc(tid * 16 + i * 8192, R, C); const int Rb = (R & ~31) + perm32(R & 31);
        vB[i] = (unsigned)(Rb * K + C) * 2u;
        vAc[0][i] = (unsigned)(R * K + C) * 2u; vAc[1][i] = vAc[0][i]; }
    const size_t hstepA = GATHER ? 0 : (size_t)hstep;
    const size_t kstep = (size_t)(BK * 2);
    const unsigned ldsw = (unsigned)wid * 1024u;
    const int aoff = lds_byte(wr * 64 + fr, fq * 8), boff = lds_byte(wc * 32 + fr, fq * 8);
#define G_SA(b, h) (((b) * 2 + (h)) * HTB)
#define G_SB(b, h) ((4 + (b) * 2 + (h)) * HTB)
#define G_STAGE_B(bufoff, h, ptr) do { _Pragma("unroll") for (int _i = 0; _i < 2; ++_i) \
        __builtin_amdgcn_global_load_lds((const unsigned*)((const char*)(ptr) + (size_t)(h) * hstep + (size_t)(unsigned)opaque_v((int)vB[_i])), (LAS unsigned*)(lds + (bufoff) + ldsw + _i * 8192), 16, 0, 0); } while (0)
#define G_STAGE_A(bufoff, h, ptr, NX) do { _Pragma("unroll") for (int _i = 0; _i < 2; ++_i) \
        __builtin_amdgcn_global_load_lds((const unsigned*)((const char*)(ptr) + (size_t)(h) * hstepA + (size_t)(unsigned)opaque_v((int)vAc[GATHER ? (h) : 0][_i])), (LAS unsigned*)(lds + (bufoff) + ldsw + _i * 8192), 16, 0, 0); } while (0)
#define G_LDA(dst, b, h) do { _Pragma("unroll") for (int m = 0; m < 4; ++m) _Pragma("unroll") for (int k = 0; k < 2; ++k) dst[m][k] = *(const LAS bf16x8*)(lds + G_SA(b, h) + aoff + m * 2048 + k * 1024); } while (0)
#define G_LDB(dst, b, h) do { _Pragma("unroll") for (int n = 0; n < 2; ++n) _Pragma("unroll") for (int k = 0; k < 2; ++k) dst[n][k] = *(const LAS bf16x8*)(lds + G_SB(b, h) + boff + n * 2048 + k * 1024); } while (0)
#define G_F8(F) __builtin_shufflevector(__builtin_bit_cast(i32x4v, F[0]), __builtin_bit_cast(i32x4v, F[1]), 0, 1, 2, 3, 4, 5, 6, 7)
#define G_MMA(ai, bj, At, Bt) do { __builtin_amdgcn_s_setprio(1); \
        if constexpr (FP8) { _Pragma("unroll") for (int m = 0; m < 4; ++m) _Pragma("unroll") for (int n = 0; n < 2; ++n) \
            acc[ai][bj][m][n] = __builtin_amdgcn_mfma_scale_f32_16x16x128_f8f6f4(G_F8(Bt[n]), G_F8(At[m]), acc[ai][bj][m][n], 0, 0, 0, 0, 0, 0); } \
        else { _Pragma("unroll") for (int m = 0; m < 4; ++m) _Pragma("unroll") for (int n = 0; n < 2; ++n) _Pragma("unroll") for (int k = 0; k < 2; ++k) \
            acc[ai][bj][m][n] = __builtin_amdgcn_mfma_f32_16x16x32_bf16(Bt[n][k], At[m][k], acc[ai][bj][m][n], 0, 0, 0); } \
        __builtin_amdgcn_s_setprio(0); } while (0)
#define G_WAIT_V(n) asm volatile("s_waitcnt vmcnt(" #n ")" ::: "memory")
#define G_WAIT_L(n) asm volatile("s_waitcnt lgkmcnt(" #n ")" ::: "memory")
#define G_BAR __builtin_amdgcn_s_barrier()
#define G_SCHED __builtin_amdgcn_sched_barrier(0)
#define G_LOADIDX(dst, u) do { if constexpr (GATHER) { _Pragma("unroll") for (int _h = 0; _h < 2; ++_h) _Pragma("unroll") for (int _i = 0; _i < 2; ++_i) { int R_, C_; stage_rc(tid * 16 + _i * 8192, R_, C_); \
        dst[_h][_i] = (unsigned)gtab[(u).ti * 256 + R_ + 128 * _h] * (unsigned)(K * 2) + (unsigned)C_ * 2u; } } } while (0)
    Unit cur, nxt; int ui = 0;
    if (!S.next(0, cur)) return;
    G_LOADIDX(vAc, cur);
    f32x4 acc[2][2][4][2];
#pragma unroll
    for (int a = 0; a < 2; ++a)
#pragma unroll
        for (int b = 0; b < 2; ++b)
#pragma unroll
            for (int m = 0; m < 4; ++m)
#pragma unroll
                for (int n = 0; n < 2; ++n) acc[a][b][m][n] = (f32x4){0.f, 0.f, 0.f, 0.f};
    bf16x8 At[4][2], B0[2][2], B1[2][2];
    const char* cA = S.aptr(cur); const char* cB = S.bptr(cur);
    G_STAGE_B(G_SB(0, 0), 0, cB); G_STAGE_B(G_SB(0, 1), 1, cB); G_STAGE_A(G_SA(0, 0), 0, cA, false); G_STAGE_A(G_SA(0, 1), 1, cA, false);
    if (wr == 1) G_BAR;
    G_WAIT_V(2); G_BAR;
    G_STAGE_B(G_SB(1, 0), 0, cB + kstep); G_STAGE_A(G_SA(1, 0), 0, cA + kstep, false); G_STAGE_B(G_SB(1, 1), 1, cB + kstep);
    G_WAIT_V(6); G_BAR;
    for (;;) {
        const bool has_next = S.next(ui + 1, nxt);
        const char* nA = has_next ? S.aptr(nxt) : cA; const char* nB = has_next ? S.bptr(nxt) : cB;
#pragma unroll 1
        for (int t = 0; t < nt; t += 2) {
            const bool last = (t == nt - 2);
            const char* a1 = cA + (size_t)(t + 1) * kstep;
            const char* a2 = last ? nA : cA + (size_t)(t + 2) * kstep; const char* b2 = last ? nB : cB + (size_t)(t + 2) * kstep;
            const char* a3 = a2 + kstep; const char* b3 = b2 + kstep;
            if constexpr (MIDK) { if (t == (nt >> 1)) { const int l2 = my_tid(wv_) & 63; E.midk(acc, cur, wr, l2 & 15); } }
            G_LDB(B0, 0, 0); G_LDB(B1, 0, 1); G_SCHED; G_LDA(At, 0, 0); G_STAGE_A(G_SA(1, 1), 1, a1, false);
            if constexpr (GATHER) { if (last && has_next) { G_LOADIDX(vAc, nxt); } }
            G_WAIT_V(8); G_WAIT_L(0); G_BAR; G_MMA(0, 0, At, B0); G_MMA(0, 1, At, B1); G_BAR; G_SCHED;
            G_LDA(At, 0, 1); G_STAGE_B(G_SB(0, 0), 0, b2); G_STAGE_B(G_SB(0, 1), 1, b2); G_STAGE_A(G_SA(0, 0), 0, a2, last);
            G_WAIT_V(8); G_WAIT_L(0); G_BAR; G_MMA(1, 0, At, B0); G_MMA(1, 1, At, B1); G_BAR; G_SCHED;
            G_LDB(B0, 1, 0); G_LDB(B1, 1, 1); G_SCHED; G_LDA(At, 1, 0); G_STAGE_A(G_SA(0, 1), 1, a2, last);
            G_WAIT_V(8); G_WAIT_L(0); G_BAR; G_MMA(0, 0, At, B0); G_MMA(0, 1, At, B1); G_BAR; G_SCHED;
            G_LDA(At, 1, 1); G_STAGE_B(G_SB(1, 0), 0, b3); G_STAGE_B(G_SB(1, 1), 1, b3); G_STAGE_A(G_SA(1, 0), 0, a3, last);
            G_WAIT_V(8); G_WAIT_L(0); G_BAR; G_MMA(1, 0, At, B0); G_MMA(1, 1, At, B1); G_BAR; G_SCHED;
        }
        if (wr == 0) G_BAR;
        { const int l2 = my_tid(wv_) & 63; E(acc, cur, wr, wc, l2 & 15, l2 >> 4); }
        if (!has_next) break;
#pragma unroll
        for (int a = 0; a < 2; ++a)
#pragma unroll
            for (int b = 0; b < 2; ++b)
#pragma unroll
                for (int m = 0; m < 4; ++m)
#pragma unroll
                    for (int n = 0; n < 2; ++n) acc[a][b][m][n] = (f32x4){0.f, 0.f, 0.f, 0.f};
        cur = nxt; cA = nA; cB = nB; ++ui;
        if (wr == 1) G_BAR;
    }
    G_WAIT_V(0);
    G_BAR;
#undef G_SA
#undef G_SB
#undef G_STAGE_A
#undef G_STAGE_B
#undef G_LDA
#undef G_LDB
#undef G_MMA
#undef G_F8
#undef G_WAIT_V
#undef G_WAIT_L
#undef G_BAR
#undef G_SCHED
#undef G_LOADIDX
}

#define EPI_ROWLOOP _Pragma("unroll") for (int ai = 0; ai < 2; ++ai) _Pragma("unroll") for (int m = 0; m < 4; ++m)
typedef f32x4 acc_t[2][2][4][2];
template <class TP> __device__ __forceinline__ TP* offp(TP* base, unsigned off) { return base + (size_t)off; }
struct Epi1 {
    bf16_t *cq, *ckv, *ub, *vb; const float* g_v; const LAS float* tabf;
    __device__ __forceinline__ void operator()(const acc_t& acc, const Unit& u, int wr, int wc, int fr, int fq) const {
        const LAS float* tf = tabf + u.ti * 256;
        const unsigned lc = wc * 32 + 8 * fq, rt0 = wr * 64 + fr, row0 = (unsigned)u.pm * BM + rt0;
        if (u.pn == 0) {
            EPI_ROWLOOP { const unsigned rt = rt0 + ai * HALF + m * 16, row = row0 + ai * HALF + m * 16; const float rs = tf[rt];
                const f32x4 v00 = acc[ai][0][m][0] * rs, v01 = acc[ai][0][m][1] * rs, v10 = acc[ai][1][m][0] * rs, v11 = acc[ai][1][m][1] * rs;
                *(u32x4*)offp(cq, row * 256 + lc) = pack8(v00, v01); *(u32x4*)offp(cq, row * 256 + HALF + lc) = pack8(v10, v11); }
        } else if (u.pn == 1) {
            EPI_ROWLOOP { const unsigned rt = rt0 + ai * HALF + m * 16, row = row0 + ai * HALF + m * 16; const float rs = tf[rt];
                const f32x4 v00 = acc[ai][0][m][0] * rs, v01 = acc[ai][0][m][1] * rs, v10 = acc[ai][1][m][0] * rs, v11 = acc[ai][1][m][1] * rs;
                *(u32x4*)offp(ckv, row * 256 + lc) = pack8(v00, v01); *(u32x4*)offp(ckv, row * 256 + HALF + lc) = pack8(v10, v11); }
        } else if (u.pn < 4) {
            const unsigned cb = (u.pn - 2) * 256 + lc;
            EPI_ROWLOOP { const unsigned rt = rt0 + ai * HALF + m * 16, row = row0 + ai * HALF + m * 16; const float rs = tf[rt];
#pragma unroll
                for (int bj = 0; bj < 2; ++bj) { f32x4 a = acc[ai][bj][m][0] * rs, b = acc[ai][bj][m][1] * rs;
#pragma unroll
                    for (int i = 0; i < 4; ++i) { a[i] = gelu_tanh(a[i]); b[i] = gelu_tanh(b[i]); }
                    *(u32x4*)offp(ub, row * 512 + cb + bj * HALF) = pack8(a, b); } }
        } else {
            const unsigned grp = 4 * (u.pn - 4) + wc, cb = (u.pn - 4) * 256 + 64 * wc + 8 * fq;
            const f32x4 g00 = *(const f32x4*)(g_v + grp * 64 + 8 * fq), g01 = *(const f32x4*)(g_v + grp * 64 + 8 * fq + 4), g10 = *(const f32x4*)(g_v + grp * 64 + 32 + 8 * fq), g11 = *(const f32x4*)(g_v + grp * 64 + 32 + 8 * fq + 4);
            EPI_ROWLOOP { const unsigned rt = rt0 + ai * HALF + m * 16, row = row0 + ai * HALF + m * 16; const float rs = tf[rt];
                f32x4 v00 = acc[ai][0][m][0] * rs, v01 = acc[ai][0][m][1] * rs, v10 = acc[ai][1][m][0] * rs, v11 = acc[ai][1][m][1] * rs;
#pragma unroll
                for (int i = 0; i < 4; ++i) { v00[i] = gelu_tanh(v00[i]); v01[i] = gelu_tanh(v01[i]); v10[i] = gelu_tanh(v10[i]); v11[i] = gelu_tanh(v11[i]); }
                const float s = red4(sq4(v00) + sq4(v01) + sq4(v10) + sq4(v11));
                const float rg = rsqrtf(s * (1.f / 64.f) + EPS);
                *(u32x4*)offp(vb, row * 512 + cb) = pack8(v00 * rg * g00, v01 * rg * g01); *(u32x4*)offp(vb, row * 512 + cb + 32) = pack8(v10 * rg * g10, v11 * rg * g11); }
        }
    }
};
template <bool SCALE> struct EpiStore {
    bf16_t* out; int ldc; const LAS float* tabf;
    __device__ __forceinline__ void operator()(const acc_t& acc, const Unit& u, int wr, int wc, int fr, int fq) const {
        const LAS float* tf = tabf + u.ti * 256;
        const unsigned rt0 = wr * 64 + fr, o0 = ((unsigned)u.pm * BM + rt0) * (unsigned)ldc + u.pn * BM + wc * 32 + 8 * fq;
        EPI_ROWLOOP { const unsigned rt = rt0 + ai * HALF + m * 16, o = o0 + (unsigned)(ai * HALF + m * 16) * (unsigned)ldc; const float rs = SCALE ? tf[rt] : 1.f;
#pragma unroll
            for (int bj = 0; bj < 2; ++bj) *(u32x4*)offp(out, o + bj * HALF) = pack8(acc[ai][bj][m][0] * rs, acc[ai][bj][m][1] * rs); }
    }
};
constexpr float E8_SCALE = 16.f, E8_INV = 1.f / 16.f;
struct EpiStoreF8 {
    unsigned char* out; int ldc;
    __device__ __forceinline__ void operator()(const acc_t& acc, const Unit& u, int wr, int wc, int fr, int fq) const {
        const unsigned rt0 = wr * 64 + fr, o0 = ((unsigned)u.pm * BM + rt0) * (unsigned)ldc + u.pn * BM + wc * 32 + 8 * fq;
        EPI_ROWLOOP { const unsigned o = o0 + (unsigned)(ai * HALF + m * 16) * (unsigned)ldc;
#pragma unroll
            for (int bj = 0; bj < 2; ++bj) { const f32x4 a = acc[ai][bj][m][0] * E8_SCALE, b = acc[ai][bj][m][1] * E8_SCALE; u32x2 q; q.x = pk4_fp8(a[0], a[1], a[2], a[3]); q.y = pk4_fp8(b[0], b[1], b[2], b[3]);
                *(u32x2*)offp(out, o + bj * HALF) = q; } }
    }
};
struct Epi2b {
    bf16_t *Kf, *Vf; const bf16_t* ckv; const float* g_kn; const float* rope; const LAS float* tabf; const LAS float* tabg;
    __device__ __forceinline__ void operator()(const acc_t& acc, const Unit& u, int wr, int wc, int fr, int fq) const {
        const LAS float* tf = tabf + u.ti * 256; const LAS float* tg = tabg + u.ti * 256;
        const unsigned head = 2 * u.pn + (wc >> 1), rt0 = wr * 64 + fr, row0 = (unsigned)u.pm * BM + rt0;
        if (wc & 1) {
            EPI_ROWLOOP { const unsigned rt = rt0 + ai * HALF + m * 16, row = row0 + ai * HALF + m * 16; const float rs = tf[rt];
#pragma unroll
                for (int bj = 0; bj < 2; ++bj) *(u32x4*)offp(Vf, row * 512 + head * 64 + 32 * bj + 8 * fq) = pack8(acc[ai][bj][m][0] * rs, acc[ai][bj][m][1] * rs); }
        } else {
            const f32x4 g00 = *(const f32x4*)(g_kn + 8 * fq), g01 = *(const f32x4*)(g_kn + 8 * fq + 4), g10 = *(const f32x4*)(g_kn + 32 + 8 * fq), g11 = *(const f32x4*)(g_kn + 32 + 8 * fq + 4);
            const f32x4 gr1 = *(const f32x4*)(g_kn + 64 + 4 * fq), gr2 = *(const f32x4*)(g_kn + 80 + 4 * fq);
#pragma unroll
            for (int ai = 0; ai < 2; ++ai)
#pragma unroll
            for (int mp = 0; mp < 2; ++mp) {
                u32x2 kr1[2], kr2[2]; f32x4 rp0[2], rp1[2];
#pragma unroll
                for (int mm = 0; mm < 2; ++mm) { const unsigned row = row0 + ai * HALF + (2 * mp + mm) * 16;
                    kr1[mm] = *(const u32x2*)offp(ckv, row * 256 + 128 + 4 * fq); kr2[mm] = *(const u32x2*)offp(ckv, row * 256 + 144 + 4 * fq);
                    const float* rp = offp(rope, ((row & 2047u) * 16 + 4 * fq) * 2); rp0[mm] = *(const f32x4*)rp; rp1[mm] = *(const f32x4*)(rp + 4); }
#pragma unroll
                for (int mm = 0; mm < 2; ++mm) { const int m = 2 * mp + mm; const unsigned rt = rt0 + ai * HALF + m * 16, row = row0 + ai * HALF + m * 16; const float rs = tf[rt];
                    const f32x4 v00 = acc[ai][0][m][0] * rs, v01 = acc[ai][0][m][1] * rs, v10 = acc[ai][1][m][0] * rs, v11 = acc[ai][1][m][1] * rs;
                    const float s = red4(sq4(v00) + sq4(v01) + sq4(v10) + sq4(v11));
                    const float rk = rsqrtf((s + tg[rt]) * (1.f / 96.f) + EPS);
                    const unsigned ko = row * 768 + head * 96;
                    *(u32x4*)offp(Kf, ko + 8 * fq) = pack8(v00 * rk * g00, v01 * rk * g01); *(u32x4*)offp(Kf, ko + 32 + 8 * fq) = pack8(v10 * rk * g10, v11 * rk * g11);
                    const f32x4 x1 = unpack_lo(kr1[mm]) * rk * gr1, x2 = unpack_lo(kr2[mm]) * rk * gr2;
                    const f32x4 cs = {rp0[mm][0], rp0[mm][2], rp1[mm][0], rp1[mm][2]}, sn = {rp0[mm][1], rp0[mm][3], rp1[mm][1], rp1[mm][3]};
                    const f32x4 o1 = x1 * cs - x2 * sn, o2 = x2 * cs + x1 * sn;
                    u32x2 w1, w2; w1.x = cvt_pk_bf16(o1[0], o1[1]); w1.y = cvt_pk_bf16(o1[2], o1[3]); w2.x = cvt_pk_bf16(o2[0], o2[1]); w2.y = cvt_pk_bf16(o2[2], o2[3]);
                    *(u32x2*)offp(Kf, ko + 64 + 4 * fq) = w1; *(u32x2*)offp(Kf, ko + 80 + 4 * fq) = w2; }
                asm volatile("" ::: "memory");
            }
        }
    }
};
struct Epi4 {
    const bf16_t* Xin; bf16_t* Xout; const LAS float* tabf; unsigned char* X8;
    __device__ __forceinline__ void midk(acc_t& acc, const Unit& u, int wr, int fr) const {
        const LAS float* tf = tabf + u.ti * 256;
        EPI_ROWLOOP { const float rs = tf[ai * HALF + wr * 64 + m * 16 + fr];
#pragma unroll
            for (int bj = 0; bj < 2; ++bj)
#pragma unroll
                for (int n = 0; n < 2; ++n) acc[ai][bj][m][n] *= rs; }
    }
    __device__ __forceinline__ void operator()(const acc_t& acc, const Unit& u, int wr, int wc, int fr, int fq) const {
        const unsigned o0 = ((unsigned)u.pm * BM + wr * 64 + fr) * 1024u + u.pn * BM + wc * 32 + 8 * fq;
#pragma unroll
        for (int ai = 0; ai < 2; ++ai) {
            u32x4 x[4][2];
#pragma unroll
            for (int m = 0; m < 4; ++m)
#pragma unroll
                for (int bj = 0; bj < 2; ++bj) x[m][bj] = *(const u32x4*)offp(Xin, o0 + (unsigned)(ai * HALF + m * 16) * 1024u + bj * HALF);
#pragma unroll
            for (int m = 0; m < 4; ++m)
#pragma unroll
                for (int bj = 0; bj < 2; ++bj) { const unsigned o = o0 + (unsigned)(ai * HALF + m * 16) * 1024u + bj * HALF;
                    const f32x4 h0 = acc[ai][bj][m][0] + unpack_lo((u32x2){x[m][bj].x, x[m][bj].y}), h1 = acc[ai][bj][m][1] + unpack_lo((u32x2){x[m][bj].z, x[m][bj].w});
                    const u32x4 w = pack8(h0, h1); *(u32x4*)offp(Xout, o) = w;
                    if (X8) { const f32x4 r0 = unpack_lo((u32x2){w.x, w.y}), r1 = unpack_lo((u32x2){w.z, w.w});
                        u32x2 q; q.x = pk4_fp8(r0[0], r0[1], r0[2], r0[3]); q.y = pk4_fp8(r1[0], r1[1], r1[2], r1[3]); *(u32x2*)offp(X8, o) = q; } }
            asm volatile("" ::: "memory");
        }
    }
};
struct Epi6F8 {
    unsigned char* H; const LAS float* tabf;
    __device__ __forceinline__ void operator()(const acc_t& acc, const Unit& u, int wr, int wc, int fr, int fq) const {
        const LAS float* tf = tabf + u.ti * 256;
        const unsigned rt0 = wr * 64 + fr, o0 = ((unsigned)u.pm * BM + rt0) * 512u + 128 * u.pn + 32 * wc + 8 * fq;
        EPI_ROWLOOP { const unsigned rt = rt0 + ai * HALF + m * 16; const float rs = tf[rt] * W8_INV; u32x2 w;
#pragma unroll
            for (int bj = 0; bj < 2; ++bj) { const f32x4 g = acc[ai][bj][m][0] * rs, up = acc[ai][bj][m][1] * rs; f32x4 h;
#pragma unroll
                for (int i = 0; i < 4; ++i) h[i] = silu_f(g[i]) * up[i];
                const unsigned p = pk4_fp8(h[0], h[1], h[2], h[3]); if (bj == 0) w.x = p; else w.y = p; }
            *(u32x2*)offp(H, o0 + (unsigned)(ai * HALF + m * 16) * 512u) = w; }
    }
};
struct Epi6 {
    bf16_t* H; const LAS float* tabf;
    __device__ __forceinline__ void operator()(const acc_t& acc, const Unit& u, int wr, int wc, int fr, int fq) const {
        const LAS float* tf = tabf + u.ti * 256;
        const unsigned rt0 = wr * 64 + fr, o0 = ((unsigned)u.pm * BM + rt0) * 512u + 128 * u.pn + 16 * wc + 4 * fq;
        EPI_ROWLOOP { const unsigned rt = rt0 + ai * HALF + m * 16; const float rs = tf[rt];
#pragma unroll
            for (int bj = 0; bj < 2; ++bj) { const f32x4 g = acc[ai][bj][m][0] * rs, up = acc[ai][bj][m][1] * rs; f32x4 h;
#pragma unroll
                for (int i = 0; i < 4; ++i) h[i] = silu_f(g[i]) * up[i];
                u32x2 w; w.x = cvt_pk_bf16(h[0], h[1]); w.y = cvt_pk_bf16(h[2], h[3]);
                *(u32x2*)offp(H, o0 + (unsigned)(ai * HALF + m * 16) * 512u + 64 * bj) = w; } }
    }
};
constexpr float Y8_SCALE = 32.f, Y8_INV = 1.f / 32.f;
struct Epi7 {
    bf16_t *y0, *y1; const LAS int* tabi; const LAS float* tabg; float wscale;
    __device__ __forceinline__ void operator()(const acc_t& acc, const Unit& u, int wr, int wc, int fr, int fq) const {
        const LAS int* ti = tabi + u.ti * 256; const LAS float* tg = tabg + u.ti * 256;
        const unsigned rt0 = wr * 64 + fr, c0 = u.pn * BM + wc * 32 + 8 * fq;
#if MOE_FP8
        unsigned char* yb0 = (unsigned char*)y0; const long dy = (long)((unsigned char*)y1 - (unsigned char*)y0);
        EPI_ROWLOOP {
            const unsigned rt = rt0 + ai * HALF + m * 16; const int tk = ti[rt]; const float gt = tg[rt] * (wscale * Y8_SCALE);
            if (tk >= 0) {
                unsigned char* yb = yb0 + dy * (long)(tk >> 30); const unsigned o0 = (unsigned)(tk & 0x3fffffff) * 1024u + c0;
#pragma unroll
                for (int bj = 0; bj < 2; ++bj) { const f32x4 a = acc[ai][bj][m][0] * gt, b = acc[ai][bj][m][1] * gt; u32x2 q; q.x = pk4_fp8(a[0], a[1], a[2], a[3]); q.y = pk4_fp8(b[0], b[1], b[2], b[3]);
                    *(u32x2*)offp(yb, o0 + bj * HALF) = q; }
            }
        }
#else
        const long dy = (long)(y1 - y0);
        EPI_ROWLOOP {
            const unsigned rt = rt0 + ai * HALF + m * 16; const int tk = ti[rt]; const float gt = tg[rt] * wscale;
            if (tk >= 0) {
                bf16_t* yb = y0 + dy * (long)(tk >> 30); const unsigned o0 = (unsigned)(tk & 0x3fffffff) * 1024u + c0;
#pragma unroll
                for (int bj = 0; bj < 2; ++bj) *(u32x4*)offp(yb, o0 + bj * HALF) = pack8(acc[ai][bj][m][0] * gt, acc[ai][bj][m][1] * gt);
            }
        }
#endif
    }
};
struct Epi9 {
    const bf16_t* Xin; const unsigned char* e; bf16_t* Xout; float* fout; float* ssq; const float* b_pg; const LAS float* tabf;
    __device__ __forceinline__ void operator()(const acc_t& acc, const Unit& u, int wr, int wc, int fr, int fq) const {
        const LAS float* tf = tabf + u.ti * 256;
        const unsigned rt0 = wr * 64 + fr, row0 = (unsigned)u.pm * BM + rt0, col0 = u.pn * BM + wc * 32 + 8 * fq;
        const f32x4 b00 = *(const f32x4*)(b_pg + col0), b01 = *(const f32x4*)(b_pg + col0 + 4), b10 = *(const f32x4*)(b_pg + col0 + HALF), b11 = *(const f32x4*)(b_pg + col0 + HALF + 4);
#pragma unroll
        for (int ai = 0; ai < 2; ++ai)
#pragma unroll
            for (int mp = 0; mp < 2; ++mp) {
                u32x4 xv[2][2]; u32x2 ev[2][2];
#pragma unroll
                for (int mm = 0; mm < 2; ++mm)
#pragma unroll
                    for (int bj = 0; bj < 2; ++bj) { const unsigned o = (row0 + ai * HALF + (2 * mp + mm) * 16) * 1024u + col0 + bj * HALF; xv[mm][bj] = *(const u32x4*)offp(Xin, o); ev[mm][bj] = *(const u32x2*)offp(e, o); }
#pragma unroll
                for (int mm = 0; mm < 2; ++mm) {
                    const int m = 2 * mp + mm; const unsigned rt = rt0 + ai * HALF + m * 16, row = row0 + ai * HALF + m * 16; const float rs = tf[rt]; float s = 0.f;
#pragma unroll
                    for (int bj = 0; bj < 2; ++bj) { const unsigned o = row * 1024u + col0 + bj * HALF;
                        const u32x4 x = xv[mm][bj]; const u32x2 evv = ev[mm][bj];
                        const f32x4 b0 = bj ? b10 : b00, b1 = bj ? b11 : b01;
                        const f32x4 x0 = unpack_lo((u32x2){x.x, x.y}), x1 = unpack_lo((u32x2){x.z, x.w}), e0 = unpack_fp8x4(evv.x) * E8_INV, e1 = unpack_fp8x4(evv.y) * E8_INV;
                        f32x4 h0, h1;
#pragma unroll
                        for (int i = 0; i < 4; ++i) { h0[i] = x0[i] + e0[i] * sigmoid_f(rs * acc[ai][bj][m][0][i] + b0[i]); h1[i] = x1[i] + e1[i] * sigmoid_f(rs * acc[ai][bj][m][1][i] + b1[i]); }
                        s += sq4(h0) + sq4(h1);
                        *(u32x4*)offp(Xout, o) = pack8(h0, h1);
                        if (fout) { __builtin_nontemporal_store(h0, (f32x4*)offp(fout, o)); __builtin_nontemporal_store(h1, (f32x4*)offp(fout, o + 4)); } }
                    s = red4(s); if (fq == 0) *offp(ssq, (u.pn * 4 + wc) * (unsigned)T + row) = s;
                }
                asm volatile("" ::: "memory");
            }
    }
};

struct EpiNull {
    float* sink;
    __device__ __forceinline__ void operator()(const acc_t& acc, const Unit& u, int wr, int wc, int fr, int fq) const {
        float s = 0.f;
        EPI_ROWLOOP {
#pragma unroll
            for (int bj = 0; bj < 2; ++bj) s += acc[ai][bj][m][0][0] + acc[ai][bj][m][1][3]; }
        if (s == 1.2345e30f) sink[threadIdx.x] = s;
    }
};
struct MkArgs { const float* in[26]; float* out; unsigned char* ws; int ph_lo, ph_hi; };
struct Frame {
    LAS unsigned char* lds; unsigned char* ws; int G, vcu, c, wv;
    LAS float* tabf; LAS int* tabi; LAS float* tabg;
};
#define XB_TMO      128
#define XB_XCNT(j)  (256  + 64 * (j))
#define XB_XSUB(j)  (1280 + 64 * (j))
#define XB_XGEN(j)  (2304 + 64 * (j))
#define XB_TOP      3328
#define XB_TOPGEN   3392
#define XCD_BAR_WORDS 3456
#define XB_SPIN_CAP (1u << 18)
__device__ __forceinline__ unsigned xb_ld(unsigned* p)              { return __hip_atomic_load(p, __ATOMIC_RELAXED, __HIP_MEMORY_SCOPE_AGENT); }
__device__ __forceinline__ unsigned xb_add(unsigned* p, unsigned v) { return __hip_atomic_fetch_add(p, v, __ATOMIC_RELAXED, __HIP_MEMORY_SCOPE_AGENT); }
__device__ __forceinline__ unsigned xb_xcc_id() { return (unsigned)__builtin_amdgcn_s_getreg((3 << 11) | 20) & 0xFu; }
#define XB_SPIN(cond, bar) do { unsigned _sp = 0; while (cond) { __builtin_amdgcn_s_sleep(1); \
    if ((++_sp & 255u) == 0u) { if (xb_ld(&(bar)[XB_TMO])) break; if (_sp > XB_SPIN_CAP) { atomicAdd(&(bar)[XB_TMO], 1u); break; } } } } while (0)
struct XcdBarrier { unsigned* bar; unsigned x; volatile LAS unsigned* st; };
__device__ __forceinline__ XcdBarrier xcd_barrier_post(unsigned* bar, volatile LAS unsigned* st) {
    XcdBarrier b; b.bar = bar; b.x = xb_xcc_id(); b.st = st;
    if (threadIdx.x == 0) (void)xb_add(&bar[XB_XCNT(b.x)], 1u);
    return b;
}
__device__ __forceinline__ void xcd_barrier_complete(unsigned* bar, unsigned x, unsigned& nloc, unsigned& nx) {
    const unsigned G = gridDim.x * gridDim.y * gridDim.z;
    unsigned sum, cnt, mine, sp = 0u;
    for (;;) {
        sum = 0u; cnt = 0u; mine = 0u;
#pragma unroll
        for (unsigned j = 0; j < 16; ++j) { const unsigned c = xb_ld(&bar[XB_XCNT(j)]); sum += c; cnt += (c > 0u) ? 1u : 0u; mine = (j == x) ? c : mine; }
        if (sum == G) break;
        __builtin_amdgcn_s_sleep(1);
        if ((++sp & 255u) == 0u) { if (xb_ld(&bar[XB_TMO])) break; if (sp > XB_SPIN_CAP) { atomicAdd(&bar[XB_TMO], 1u); break; } }
    }
    nloc = mine > 0u ? mine : 1u; nx = cnt > 0u ? cnt : 1u;
}
__device__ __forceinline__ void xcd_barrier(const XcdBarrier& b, const int tid_) {
    asm volatile("s_waitcnt vmcnt(0)" ::: "memory");
    __syncthreads();
    if (tid_ == 0) {
        unsigned* bar = b.bar;
        __builtin_amdgcn_s_waitcnt(0);
        unsigned nloc = b.st[0], nx = b.st[1];
        if (nloc == 0u) { xcd_barrier_complete(bar, b.x, nloc, nx); b.st[0] = nloc; b.st[1] = nx; }
        const unsigned old = xb_add(&bar[XB_XSUB(b.x)], 1u);
        const unsigned gen = old / nloc;
        if (old + 1u == (gen + 1u) * nloc) {
            __builtin_amdgcn_fence(__ATOMIC_RELEASE, "agent");
            asm volatile("s_waitcnt vmcnt(0)" ::: "memory");
            const unsigned og = xb_add(&bar[XB_TOP], 1u);
            const unsigned tg = og / nx;
            if (og + 1u == (tg + 1u) * nx) xb_add(&bar[XB_TOPGEN], 1u);
            else XB_SPIN(xb_ld(&bar[XB_TOPGEN]) == tg, bar);
            __builtin_amdgcn_fence(__ATOMIC_ACQUIRE, "agent");
            xb_add(&bar[XB_XGEN(b.x)], 1u);
            asm volatile("s_waitcnt vmcnt(0)" ::: "memory");
        } else {
            XB_SPIN(xb_ld(&bar[XB_XGEN(b.x)]) == gen, bar);
            __builtin_amdgcn_fence(__ATOMIC_ACQUIRE, "agent");
            asm volatile("s_waitcnt vmcnt(0)" ::: "memory");
        }
    }
    __syncthreads();
}

constexpr size_t Z_LBAR = 32768;
__device__ __forceinline__ void xcc_local_barrier(unsigned* lbar, unsigned* gbar, const unsigned x, const unsigned nloc, const int tid_) {
    asm volatile("s_waitcnt vmcnt(0)" ::: "memory");
    __syncthreads();
    if (tid_ == 0) {
        __builtin_amdgcn_s_waitcnt(0);
        const unsigned old = xb_add(&lbar[64 * x], 1u), gen = old / nloc;
        if (old + 1u == (gen + 1u) * nloc) xb_add(&lbar[1024 + 64 * x], 1u);
        else XB_SPIN(xb_ld(&lbar[1024 + 64 * x]) == gen, gbar);
        __builtin_amdgcn_fence(__ATOMIC_ACQUIRE, "agent");
        asm volatile("s_waitcnt vmcnt(0)" ::: "memory");
    }
    __syncthreads();
}
template <class Sched, class FF> __device__ __forceinline__ void fill_tab_static(Frame& F, const Sched& S, const FF& ff) {
    Unit u; const int t_ = my_tid(F.wv);
    for (int i = 0; i < MAXU && S.next(i, u); ++i)
        for (int r = t_; r < 256; r += NTHREADS) ff(i, r, u.pm * 256 + r);
    __syncthreads();
}

#ifndef CV_INTERLEAVE
#define CV_INTERLEAVE 0
#endif
struct CvCtx { int stride, nl; unsigned char* wsw; const LAS unsigned long long* ptab; };
template <int PART> __device__ __forceinline__ void cv_part(const CvCtx cv, int it, f32x4 (&v)[16], int lane) {
#if MOE_FP8
    convert_part_moe<PART>(lds_inptr(cv.ptab, 19) + (size_t)cv.nl * ((size_t)32 * 1024 * 512), lds_inptr(cv.ptab, 20) + (size_t)cv.nl * ((size_t)32 * 1024 * 512), lds_inptr(cv.ptab, 21) + (size_t)cv.nl * ((size_t)32 * 512 * 1024),
                           lds_inptr(cv.ptab, 16) + (size_t)cv.nl * 1024, cv.wsw, it, lane, v);
#endif
}
__device__ __forceinline__ float max3f(float a, float b, float c) { float r; asm("v_max3_f32 %0, %1, %2, %3" : "=v"(r) : "v"(a), "v"(b), "v"(c)); return r; }
constexpr int AK_STRIDE = 208, AV_STRIDE = 144, AK_BYTES = 64 * AK_STRIDE, ABUF = AK_BYTES + 64 * AV_STRIDE;
template <int VAR = 0> __device__ __forceinline__ void attn_unit(Frame& F, int b, int h, int qb, const bf16_t* qraw, const bf16_t* Kf, const bf16_t* Vf, bf16_t* am, float* ssq_a, const float* g_qn, const float* rope, const CvCtx cv, int& cv_it, int& cv_iter) {
    const int tid = my_tid(F.wv), lane = tid & 63, wid = __builtin_amdgcn_readfirstlane(tid >> 6), r32 = lane & 31, hi = lane >> 5;
    const int q0 = qb * 256 + wid * 32; const size_t row = (size_t)b * 2048 + q0 + r32;
    bf16x8 qf[6];
    {
        float qv[6][8]; float ss = 0.f; const bf16_t* qp = qraw + row * 768 + h * 96 + 8 * hi;
#pragma unroll
        for (int d0 = 0; d0 < 6; ++d0) { const bf16x8 raw = *(const bf16x8*)(qp + 16 * d0);
#pragma unroll
            for (int j = 0; j < 8; ++j) { qv[d0][j] = bf2f((bf16_t)raw[j]); ss += qv[d0][j] * qv[d0][j]; } }
        ss += __shfl_xor(ss, 32);
        const float rq = rsqrtf(ss * (1.f / 96.f) + EPS) * (SM_SCALE * 1.4426950408889634f);
#pragma unroll
        for (int d0 = 0; d0 < 6; ++d0)
#pragma unroll
            for (int j = 0; j < 8; ++j) qv[d0][j] *= rq * g_qn[16 * d0 + 8 * hi + j];
        const float* rp = rope + ((size_t)(q0 + r32) * 16 + 8 * hi) * 2;
#pragma unroll
        for (int j = 0; j < 8; ++j) { const float cs = rp[2 * j], sn = rp[2 * j + 1], x1 = qv[4][j], x2 = qv[5][j]; qv[4][j] = x1 * cs - x2 * sn; qv[5][j] = x2 * cs + x1 * sn; }
#pragma unroll
        for (int d0 = 0; d0 < 6; ++d0) { u32x4 w; w.x = cvt_pk_bf16(qv[d0][0], qv[d0][1]); w.y = cvt_pk_bf16(qv[d0][2], qv[d0][3]); w.z = cvt_pk_bf16(qv[d0][4], qv[d0][5]); w.w = cvt_pk_bf16(qv[d0][6], qv[d0][7]); qf[d0] = __builtin_bit_cast(bf16x8, w); }
    }
    const int ntile = 4 * qb + 4, nstep = ntile >> 1, mylast = 4 * qb + (wid >> 1);
    const int kc0 = tid, kc1 = tid + 512;
    const bf16_t* Kg = Kf + (size_t)b * 2048 * 768 + h * 96; const bf16_t* Vg = Vf + (size_t)b * 2048 * 512 + h * 64;
    const size_t kg0 = (size_t)(kc0 / 12) * 768 + (kc0 % 12) * 8, kg1 = (size_t)(kc1 / 12) * 768 + (kc1 % 12) * 8, vg0 = (size_t)(tid >> 3) * 512 + (tid & 7) * 8;
    const int kl0 = (kc0 / 12) * AK_STRIDE + (kc0 % 12) * 16, kl1 = (kc1 / 12) * AK_STRIDE + (kc1 % 12) * 16, vl0 = AK_BYTES + (tid >> 3) * AV_STRIDE + (tid & 7) * 16;
    LAS unsigned char* lds = F.lds;
    u32x4 kr[2][2], vr[2];
#pragma unroll
    for (int e = 0; e < 2; ++e) { kr[e][1] = (u32x4){0u, 0u, 0u, 0u}; const size_t ko = (size_t)e * 64 * 768, vo = (size_t)e * 64 * 512;
        kr[e][0] = *(const u32x4*)(Kg + ko + kg0); if (tid < 256) kr[e][1] = *(const u32x4*)(Kg + ko + kg1); vr[e] = *(const u32x4*)(Vg + vo + vg0); }
#pragma unroll
    for (int e = 0; e < 2; ++e) { LAS unsigned char* nb = lds + e * ABUF; *(LAS u32x4*)(nb + kl0) = kr[e][0]; if (tid < 256) *(LAS u32x4*)(nb + kl1) = kr[e][1]; *(LAS u32x4*)(nb + vl0) = vr[e]; }
    asm volatile("s_waitcnt lgkmcnt(0)" ::: "memory"); __builtin_amdgcn_s_barrier(); asm volatile("" ::: "memory");
    f32x16 o0, o1;
#pragma unroll
    for (int r = 0; r < 16; ++r) { o0[r] = 0.f; o1[r] = 0.f; }
    float m_run = 0.f, l_run = 0.f;
    f32x16 negm;
#pragma unroll
    for (int r = 0; r < 16; ++r) negm[r] = 0.f;
    const int q4 = (lane & 15) >> 2, p4 = lane & 3, blk = (lane >> 4) & 1;
#define ATT_QK(P0, P1, KB) do { \
        if (!(VAR & 4)) { _Pragma("unroll") for (int dh = 0; dh < 2; ++dh) { bf16x8 ka_[3], kb_[3]; \
            _Pragma("unroll") for (int d0 = 0; d0 < 3; ++d0) { ka_[d0] = *(const LAS bf16x8*)((KB) + r32 * AK_STRIDE + 32 * (3 * dh + d0) + 16 * hi); kb_[d0] = *(const LAS bf16x8*)((KB) + (32 + r32) * AK_STRIDE + 32 * (3 * dh + d0) + 16 * hi); } \
            __builtin_amdgcn_sched_barrier(0);        \
            _Pragma("unroll") for (int d0 = 0; d0 < 3; ++d0) { \
                if (dh == 0 && d0 == 0) { P0 = __builtin_amdgcn_mfma_f32_32x32x16_bf16(ka_[0], qf[0], negm, 0, 0, 0); P1 = __builtin_amdgcn_mfma_f32_32x32x16_bf16(kb_[0], qf[0], negm, 0, 0, 0); } \
                else { P0 = __builtin_amdgcn_mfma_f32_32x32x16_bf16(ka_[d0], qf[3 * dh + d0], P0, 0, 0, 0); P1 = __builtin_amdgcn_mfma_f32_32x32x16_bf16(kb_[d0], qf[3 * dh + d0], P1, 0, 0, 0); } } \
            __builtin_amdgcn_sched_barrier(0); } } else { P0 = negm; P1 = negm; } } while (0)
#define ATT_SM(P0, P1, PF) do { float mx_ = 0.f; \
        asm volatile("s_nop 15\n\ts_nop 7" : "+v"(P0), "+v"(P1));        \
        if (!(VAR & 1)) { float ma_ = max3f(P0[0], P0[1], P0[2]), mb_ = max3f(P1[0], P1[1], P1[2]); \
            _Pragma("unroll") for (int r = 3; r < 15; r += 2) { ma_ = max3f(ma_, P0[r], P0[r + 1]); mb_ = max3f(mb_, P1[r], P1[r + 1]); } \
            mx_ = max3f(ma_, mb_, fmaxf(P0[15], P1[15])); mx_ = fmaxf(mx_, __shfl_xor(mx_, 32)); } \
        if (__builtin_expect(!(VAR & 1) && __any(mx_ > 8.0f), 0)) { const float dl_ = fmaxf(mx_, 0.f), al_ = __builtin_amdgcn_exp2f(-dl_); m_run += dl_; l_run *= al_; \
            _Pragma("unroll") for (int r = 0; r < 16; ++r) { P0[r] -= dl_; P1[r] -= dl_; o0[r] *= al_; o1[r] *= al_; negm[r] = -m_run; } } \
        float ls_ = 0.f; _Pragma("unroll") for (int r = 0; r < 16; ++r) { if (!(VAR & 1)) { P0[r] = __builtin_amdgcn_exp2f(P0[r]); P1[r] = __builtin_amdgcn_exp2f(P1[r]); } ls_ += P0[r] + P1[r]; } \
        l_run += ls_; u32x4 w_; \
        w_.x = cvt_pk_bf16(P0[0], P0[1]); w_.y = cvt_pk_bf16(P0[2], P0[3]); w_.z = cvt_pk_bf16(P0[4], P0[5]); w_.w = cvt_pk_bf16(P0[6], P0[7]); PF[0] = __builtin_bit_cast(bf16x8, w_); \
        w_.x = cvt_pk_bf16(P0[8], P0[9]); w_.y = cvt_pk_bf16(P0[10], P0[11]); w_.z = cvt_pk_bf16(P0[12], P0[13]); w_.w = cvt_pk_bf16(P0[14], P0[15]); PF[1] = __builtin_bit_cast(bf16x8, w_); \
        w_.x = cvt_pk_bf16(P1[0], P1[1]); w_.y = cvt_pk_bf16(P1[2], P1[3]); w_.z = cvt_pk_bf16(P1[4], P1[5]); w_.w = cvt_pk_bf16(P1[6], P1[7]); PF[2] = __builtin_bit_cast(bf16x8, w_); \
        w_.x = cvt_pk_bf16(P1[8], P1[9]); w_.y = cvt_pk_bf16(P1[10], P1[11]); w_.z = cvt_pk_bf16(P1[12], P1[13]); w_.w = cvt_pk_bf16(P1[14], P1[15]); PF[3] = __builtin_bit_cast(bf16x8, w_); } while (0)
#define ATT_PV(PF, VB) do { if (!(VAR & 2)) { v4i16_t lo0_[4], hi0_[4], lo1_[4], hi1_[4]; \
            _Pragma("unroll") for (int ks = 0; ks < 4; ++ks) { const int krow_ = 32 * (ks >> 1) + 16 * (ks & 1) + 4 * hi + q4; const LAS unsigned char* vp_ = (VB) + krow_ * AV_STRIDE + 32 * blk + 8 * p4; \
                lo0_[ks] = __builtin_amdgcn_ds_read_tr16_b64_v4i16((LAS v4i16_t*)(vp_)); hi0_[ks] = __builtin_amdgcn_ds_read_tr16_b64_v4i16((LAS v4i16_t*)(vp_ + 8 * AV_STRIDE)); \
                lo1_[ks] = __builtin_amdgcn_ds_read_tr16_b64_v4i16((LAS v4i16_t*)(vp_ + 64)); hi1_[ks] = __builtin_amdgcn_ds_read_tr16_b64_v4i16((LAS v4i16_t*)(vp_ + 8 * AV_STRIDE + 64)); } \
            __builtin_amdgcn_sched_barrier(0);        \
            _Pragma("unroll") for (int ks = 0; ks < 4; ++ks) { \
                const bf16x8 v0_ = {lo0_[ks][0], lo0_[ks][1], lo0_[ks][2], lo0_[ks][3], hi0_[ks][0], hi0_[ks][1], hi0_[ks][2], hi0_[ks][3]}; const bf16x8 v1_ = {lo1_[ks][0], lo1_[ks][1], lo1_[ks][2], lo1_[ks][3], hi1_[ks][0], hi1_[ks][1], hi1_[ks][2], hi1_[ks][3]}; \
                o0 = __builtin_amdgcn_mfma_f32_32x32x16_bf16(v0_, PF[ks], o0, 0, 0, 0); o1 = __builtin_amdgcn_mfma_f32_32x32x16_bf16(v1_, PF[ks], o1, 0, 0, 0); } \
            __builtin_amdgcn_sched_barrier(0); } } while (0)
    for (int st = 0; st < nstep; ++st) {
        const bool more = st + 1 < nstep;
        if (more) {
#pragma unroll
            for (int e = 0; e < 2; ++e) { const size_t ko = (size_t)(2 * st + 2 + e) * 64 * 768, vo = (size_t)(2 * st + 2 + e) * 64 * 512;
                kr[e][0] = *(const u32x4*)(Kg + ko + kg0); if (tid < 256) kr[e][1] = *(const u32x4*)(Kg + ko + kg1); vr[e] = *(const u32x4*)(Vg + vo + vg0); } }
        if (2 * st <= mylast) {
            const LAS unsigned char* kbA = lds + (st & 1) * 2 * ABUF; const LAS unsigned char* kbB = kbA + ABUF;
            const bool actB = 2 * st + 1 <= mylast;
            f32x16 pA0, pA1, pB0, pB1; bf16x8 pf[4];
            ATT_QK(pA0, pA1, kbA);
            const float mrefB = m_run;
            if (actB) ATT_QK(pB0, pB1, kbB);
            ATT_SM(pA0, pA1, pf);
            ATT_PV(pf, kbA + AK_BYTES);
            if (actB) {
                const float adj = m_run - mrefB;
                if (__builtin_expect(__any(adj != 0.f), 0)) {
#pragma unroll
                    for (int r = 0; r < 16; ++r) { pB0[r] -= adj; pB1[r] -= adj; } }
                ATT_SM(pB0, pB1, pf);
                ATT_PV(pf, kbB + AK_BYTES);
            }
        }
        if (more) {
#pragma unroll
            for (int e = 0; e < 2; ++e) { LAS unsigned char* nb = lds + ((st + 1) & 1) * 2 * ABUF + e * ABUF;
                *(LAS u32x4*)(nb + kl0) = kr[e][0]; if (tid < 256) *(LAS u32x4*)(nb + kl1) = kr[e][1]; *(LAS u32x4*)(nb + vl0) = vr[e]; } }
        asm volatile("s_waitcnt lgkmcnt(0)" ::: "memory"); __builtin_amdgcn_s_barrier(); asm volatile("" ::: "memory");
    }
#undef ATT_QK
#undef ATT_SM
#undef ATT_PV
    const float l = l_run + __shfl_xor(l_run, 32), il = 1.f / l;
    float s = 0.f; bf16_t* op = am + row * 1024 + h * 64 + 4 * hi;
#pragma unroll
    for (int g = 0; g < 4; ++g) {
        const float a0 = o0[4 * g] * il, a1 = o0[4 * g + 1] * il, a2 = o0[4 * g + 2] * il, a3 = o0[4 * g + 3] * il;
        const float b0 = o1[4 * g] * il, b1 = o1[4 * g + 1] * il, b2 = o1[4 * g + 2] * il, b3 = o1[4 * g + 3] * il;
        s += (a0 * a0 + a1 * a1) + (a2 * a2 + a3 * a3) + (b0 * b0 + b1 * b1) + (b2 * b2 + b3 * b3);
        u32x2 w0, w1; w0.x = cvt_pk_bf16(a0, a1); w0.y = cvt_pk_bf16(a2, a3); w1.x = cvt_pk_bf16(b0, b1); w1.y = cvt_pk_bf16(b2, b3);
        *(u32x2*)(op + 8 * g) = w0; *(u32x2*)(op + 32 + 8 * g) = w1;
    }
    s += __shfl_xor(s, 32);
    if (hi == 0) ssq_a[(size_t)h * T + row] = s;
}

constexpr int GV_STRIDE = 136;
__device__ __forceinline__ void gmlp_unit(Frame& F, int blk128, const bf16_t* ub, const bf16_t* vb, const bf16_t* wsb, const float* b_s, bf16_t* am) {
    const int tid_ = my_tid(F.wv), lane = tid_ & 63, g = __builtin_amdgcn_readfirstlane(tid_ >> 6), fr = lane & 15, fq = lane >> 4, q4 = (lane & 15) >> 2, p4 = lane & 3;
    LAS unsigned char* vl = F.lds + g * (128 * GV_STRIDE);
    LAS float* red = (LAS float*)(F.lds + 8 * 128 * GV_STRIDE);
    const size_t tok0 = (size_t)blk128 * 128;
    u32x4 st[16];
#pragma unroll
    for (int u = 0; u < 16; ++u) { const int c = lane + 64 * u; st[u] = *(const u32x4*)(vb + (tok0 + (c >> 3)) * 512 + g * 64 + (c & 7) * 8); }
    bf16x8 wfa[4][2];
#pragma unroll
    for (int mm = 0; mm < 4; ++mm)
#pragma unroll
        for (int ks = 0; ks < 2; ++ks) wfa[mm][ks] = *(const bf16x8*)(wsb + ((size_t)g * 128 + 16 * mm + fr) * 128 + 32 * ks + 8 * fq);
#pragma unroll
    for (int u = 0; u < 16; ++u) { const int c = lane + 64 * u; *(LAS u32x4*)(vl + (c >> 3) * GV_STRIDE + (c & 7) * 16) = st[u]; }
    asm volatile("s_waitcnt lgkmcnt(0)" ::: "memory");
#define GM_VF(VF, KS4) do { _Pragma("unroll") for (int n = 0; n < 4; ++n) { const LAS unsigned char* vp_ = vl + (32 * (KS4) + 8 * fq + q4) * GV_STRIDE + 32 * n + 8 * p4; \
        const v4i16_t lo_ = __builtin_amdgcn_ds_read_tr16_b64_v4i16((LAS v4i16_t*)(vp_)), hi_ = __builtin_amdgcn_ds_read_tr16_b64_v4i16((LAS v4i16_t*)(vp_ + 4 * GV_STRIDE)); \
        VF[n] = (bf16x8){lo_[0], lo_[1], lo_[2], lo_[3], hi_[0], hi_[1], hi_[2], hi_[3]}; } } while (0)
#define GM_EPI(ACC, MBASE, UU, BSV) do { \
        _Pragma("unroll") for (int mm = 0; mm < 4; ++mm) { const int t = 16 * ((MBASE) + mm) + fr; float s_ = 0.f; \
            _Pragma("unroll") for (int n = 0; n < 4; ++n) { ACC[mm][n] = (ACC[mm][n] + BSV[mm]) * unpack_lo(UU[mm][n]); s_ += sq4(ACC[mm][n]); } \
            s_ = red4(s_); if (fq == 0) red[g * 128 + t] = s_; } \
        __syncthreads(); \
        _Pragma("unroll") for (int mm = 0; mm < 4; ++mm) { const int t = 16 * ((MBASE) + mm) + fr; float tot_ = 0.f; \
            _Pragma("unroll") for (int gg = 0; gg < 8; ++gg) tot_ += red[gg * 128 + t]; \
            const float rs_ = rsqrtf(tot_ * (1.f / 512.f) + EPS); \
            _Pragma("unroll") for (int n = 0; n < 4; ++n) { const f32x4 o_ = ACC[mm][n] * rs_; u32x2 w_; w_.x = cvt_pk_bf16(o_[0], o_[1]); w_.y = cvt_pk_bf16(o_[2], o_[3]); \
                *(u32x2*)(am + (tok0 + t) * 1024 + 512 + g * 64 + 16 * n + 4 * fq) = w_; } } } while (0)
    {
        bf16x8 wfb[4][4];
#pragma unroll
        for (int mm = 0; mm < 4; ++mm)
#pragma unroll
            for (int ks = 0; ks < 4; ++ks) wfb[mm][ks] = *(const bf16x8*)(wsb + ((size_t)g * 128 + 16 * (4 + mm) + fr) * 128 + 32 * ks + 8 * fq);
        u32x2 uu[4][4]; float bsv[4];
#pragma unroll
        for (int mm = 0; mm < 4; ++mm) { const int t = 16 * mm + fr; bsv[mm] = b_s[g * 128 + t];
#pragma unroll
            for (int n = 0; n < 4; ++n) uu[mm][n] = *(const u32x2*)(ub + (tok0 + t) * 512 + g * 64 + 16 * n + 4 * fq); }
        f32x4 acc[4][4];
#pragma unroll
        for (int mm = 0; mm < 4; ++mm)
#pragma unroll
            for (int n = 0; n < 4; ++n) acc[mm][n] = (f32x4){0.f, 0.f, 0.f, 0.f};
#pragma unroll
        for (int ks = 0; ks < 2; ++ks) { bf16x8 vf[4]; GM_VF(vf, ks);
#pragma unroll
            for (int mm = 0; mm < 4; ++mm)
#pragma unroll
                for (int n = 0; n < 4; ++n) acc[mm][n] = __builtin_amdgcn_mfma_f32_16x16x32_bf16(vf[n], wfa[mm][ks], acc[mm][n], 0, 0, 0); }
        GM_EPI(acc, 0, uu, bsv);
        u32x2 uv[4][4]; float bsw[4];
#pragma unroll
        for (int mm = 0; mm < 4; ++mm) { const int t = 16 * (4 + mm) + fr; bsw[mm] = b_s[g * 128 + t];
#pragma unroll
            for (int n = 0; n < 4; ++n) uv[mm][n] = *(const u32x2*)(ub + (tok0 + t) * 512 + g * 64 + 16 * n + 4 * fq); }
        f32x4 acb[4][4];
#pragma unroll
        for (int mm = 0; mm < 4; ++mm)
#pragma unroll
            for (int n = 0; n < 4; ++n) acb[mm][n] = (f32x4){0.f, 0.f, 0.f, 0.f};
#pragma unroll
        for (int ks = 0; ks < 4; ++ks) { bf16x8 vf[4]; GM_VF(vf, ks);
#pragma unroll
            for (int mm = 0; mm < 4; ++mm)
#pragma unroll
                for (int n = 0; n < 4; ++n) acb[mm][n] = __builtin_amdgcn_mfma_f32_16x16x32_bf16(vf[n], wfb[mm][ks], acb[mm][n], 0, 0, 0); }
        __syncthreads();
        GM_EPI(acb, 4, uv, bsw);
    }
#undef GM_VF
#undef GM_EPI
    __syncthreads();
}

__device__ __forceinline__ void router_unit(Frame& F, int blk128, const bf16_t* X, const bf16_t* wr_hi, int* gcnt, int* stok, float* srs, float* sg) {
    const int tid = my_tid(F.wv), lane = tid & 63, w = __builtin_amdgcn_readfirstlane(tid >> 6), fr = lane & 15, fq = lane >> 4;
    LAS float* lg = (LAS float*)F.lds;
    LAS float* ssq = lg + 128 * 49;
    LAS int* hist = (LAS int*)(ssq + 128);
    if (tid < 64) hist[tid] = 0;
    const size_t tok0 = (size_t)blk128 * 128;
    const bf16_t* wr_lo = wr_hi + 64 * 1024;
    {
        constexpr int WROW = 1040;
        LAS unsigned char* wl = F.lds + 26624;
        const bf16_t* xrow = X + (tok0 + 16 * w + fr) * 1024 + 8 * fq;
        bf16x8 a[32];
#pragma unroll
        for (int ks = 0; ks < 32; ++ks) a[ks] = *(const bf16x8*)(xrow + 32 * ks);
        f32x4 acc[3] = {{0.f, 0.f, 0.f, 0.f}, {0.f, 0.f, 0.f, 0.f}, {0.f, 0.f, 0.f, 0.f}}; float ss = 0.f;
#pragma unroll
        for (int half = 0; half < 2; ++half) {
            if (half) __syncthreads();
            { u32x4 st[12];
#pragma unroll
              for (int i = 0; i < 12; ++i) { const int c = tid + 512 * i, rowh = c >> 6, ch = c & 63, hl = rowh >= 48 ? 1 : 0, row = rowh - 48 * hl;
                  st[i] = *(const u32x4*)((hl ? wr_lo : wr_hi) + (size_t)row * 1024 + 512 * half + 8 * ch); }
#pragma unroll
              for (int i = 0; i < 12; ++i) { const int c = tid + 512 * i, rowh = c >> 6, ch = c & 63;
                  *(LAS u32x4*)(wl + rowh * WROW + ch * 16) = st[i]; } }
            __syncthreads();
#pragma unroll
            for (int k2 = 0; k2 < 16; ++k2) { const bf16x8 av = a[16 * half + k2];
#pragma unroll
                for (int j = 0; j < 8; ++j) { const float x = bf2f((bf16_t)av[j]); ss += x * x; }
#pragma unroll
                for (int nt = 0; nt < 3; ++nt) { const LAS unsigned char* bp = wl + (16 * nt + fr) * WROW + (32 * k2 + 8 * fq) * 2;
                    const bf16x8 bh = *(const LAS bf16x8*)bp, bl = *(const LAS bf16x8*)(bp + 48 * WROW);
                    acc[nt] = __builtin_amdgcn_mfma_f32_16x16x32_bf16(av, bh, acc[nt], 0, 0, 0); acc[nt] = __builtin_amdgcn_mfma_f32_16x16x32_bf16(av, bl, acc[nt], 0, 0, 0); }
            }
        }
#pragma unroll
        for (int nt = 0; nt < 3; ++nt)
#pragma unroll
            for (int i = 0; i < 4; ++i) lg[(16 * w + 4 * fq + i) * 49 + 16 * nt + fr] = acc[nt][i];
        ss = red4(ss);
        if (fq == 0) ssq[16 * w + fr] = ss;
    }
    __syncthreads();
    int ea = 0, eb = 0, ra = 0, rbk = 0; float g0 = 0.f, g1 = 0.f, rstd = 0.f;
    if (tid < 128) {
        rstd = rsqrtf(ssq[tid] * (1.f / 1024.f) + EPS);
        const LAS float* l = lg + tid * 49;
        int gs = 0; float gm = l[0] * rstd;
#pragma unroll
        for (int g = 1; g < 4; ++g) { const float v = l[g] * rstd; if (v > gm) { gm = v; gs = g; } }
        float den = 0.f;
#pragma unroll
        for (int g = 0; g < 4; ++g) den += __expf(l[g] * rstd - gm);
        const float psel = 1.f / den;
        int i0 = 0; float v0 = l[4 + gs * 8] * rstd;
        for (int i = 1; i < 8; ++i) { const float v = l[4 + gs * 8 + i] * rstd; if (v > v0) { v0 = v; i0 = i; } }
        int i1 = -1; float v1 = -3.0e38f;
        for (int i = 0; i < 8; ++i) { const float v = l[4 + gs * 8 + i] * rstd; if (i != i0 && v > v1) { v1 = v; i1 = i; } }
        const float e1 = __expf(v1 - v0); g0 = psel / (1.f + e1); g1 = psel * e1 / (1.f + e1);
        ea = gs * 8 + i0; eb = gs * 8 + i1;
        ra = __hip_atomic_fetch_add(&hist[ea], 1, __ATOMIC_RELAXED, __HIP_MEMORY_SCOPE_WORKGROUP); rbk = __hip_atomic_fetch_add(&hist[eb], 1, __ATOMIC_RELAXED, __HIP_MEMORY_SCOPE_WORKGROUP);
    }
    __syncthreads();
    if (tid < 32) { const int n = hist[tid]; hist[32 + tid] = n ? atomicAdd(gcnt + tid, n) : 0; }
    __syncthreads();
    if (tid < 128) {
        const int tok = (int)tok0 + tid; const size_t pa = (size_t)ea * T + hist[32 + ea] + ra, pb = (size_t)eb * T + hist[32 + eb] + rbk;
        stok[pa] = tok; srs[pa] = rstd; sg[pa] = g0;
        stok[pb] = tok | (1 << 30); srs[pb] = rstd; sg[pb] = g1;
    }
    __syncthreads();
}

__global__ void __launch_bounds__(NTHREADS, 2) mk_fwd(MkArgs args) {
    extern __shared__ __attribute__((aligned(16))) unsigned char lds_raw[];
    Frame F;
    F.lds = (LAS unsigned char*)lds_raw; F.ws = args.ws;
    F.wv = __builtin_amdgcn_readfirstlane((int)threadIdx.x >> 6);
    F.G = gridDim.x; F.c = blockIdx.x; F.vcu = (F.G % 8 == 0) ? (F.c % 8) * (F.G / 8) + F.c / 8 : F.c;
    F.tabf = (LAS float*)(F.lds + TABF_OFF); F.tabi = (LAS int*)(F.lds + TABI_OFF); F.tabg = (LAS float*)(F.lds + TABG_OFF);
    unsigned char* ws = args.ws;
    volatile LAS unsigned* misc = (volatile LAS unsigned*)(F.lds + MISC_OFF);
    if ((int)threadIdx.x < 8) misc[(int)threadIdx.x] = 0u;
    if ((int)threadIdx.x < 26) ((LAS unsigned long long*)(F.lds + PTR_OFF))[(int)threadIdx.x] = (unsigned long long)args.in[(int)threadIdx.x];
    __syncthreads();
    XcdBarrier bar; bar.bar = (unsigned*)(ws + Z_BAR); bar.x = xb_xcc_id(); bar.st = misc;
    if ((int)threadIdx.x == 0) {
        const unsigned rank = xb_add(&bar.bar[XB_XCNT(bar.x)], 1u);
        unsigned nloc, nx; xcd_barrier_complete(bar.bar, bar.x, nloc, nx);
        bool ok = (gridDim.x == 256u) && nx == 8u && bar.x < 8u;
#pragma unroll
        for (unsigned j = 0; j < 8; ++j) ok = ok && (xb_ld(&bar.bar[XB_XCNT(j)]) == 32u);
        misc[0] = nloc; misc[1] = nx; misc[4] = rank; misc[5] = ok ? 1u : 0u;
    }
    __syncthreads();
    const bool local_ok = __builtin_amdgcn_readfirstlane(misc[5]) != 0u;
    const int my_rank = (int)__builtin_amdgcn_readfirstlane(misc[4]), my_xcc = (int)bar.x;
    unsigned* const lbar = (unsigned*)(ws + Z_LBAR);
    if (local_ok) { F.c = my_rank * 8 + my_xcc; F.vcu = my_xcc * 32 + my_rank; }
    const int p2sel = (args.ph_lo >= 44) ? args.ph_lo - 44 : -1;
    const int lo = (p2sel >= 0) ? 33 : args.ph_lo, hi = (p2sel >= 0) ? 34 : args.ph_hi;
#ifndef PHMASK
#define PHMASK 0x7fff
#endif
#define IN(k) (lo <= (k) && (k) < hi)
#define PHON(b) (((PHMASK) >> (b)) & 1)
#ifdef TS_A
#define TS_REC(k) do { if (my_tid(F.wv) == 0) ((volatile LAS unsigned long long*)(F.lds + PTR_OFF + 256))[(k)] = __builtin_amdgcn_s_memrealtime(); } while (0)
#else
#define TS_REC(k) do { } while (0)
#endif
#define SEAM(k) do { if ((k) + 1 < hi) xcd_barrier(bar, my_tid(F.wv)); TS_REC(k); } while (0)
#define SEAM_L(k) do { if ((k) + 1 < hi) { if (local_ok) xcc_local_barrier(lbar, bar.bar, (unsigned)my_xcc, 32u, my_tid(F.wv)); else xcd_barrier(bar, my_tid(F.wv)); } TS_REC(k); } while (0)

    if (PHON(0) && IN(0)) {
        const float* x = lds_inptr((const LAS unsigned long long*)(F.lds + PTR_OFF), 0); const float* p = lds_inptr((const LAS unsigned long long*)(F.lds + PTR_OFF), 1);
        const int tid_ = my_tid(F.wv), lane = tid_ & 63, gw = F.vcu * NWAVES + (tid_ >> 6), ngw = F.G * NWAVES;
        float* ssqh = (float*)(ws + Z_SSQ) + (size_t)12 * T;
        for (int m = gw; m < T; m += ngw) {
            const f32x4* xr = (const f32x4*)(x + (size_t)m * D) + lane; float s = 0.f; u32x2* o = (u32x2*)((bf16_t*)(ws + WS_X0) + (size_t)m * D) + lane;
#pragma unroll
            for (int j = 0; j < 4; ++j) { const f32x4 v = __builtin_nontemporal_load(xr + 64 * j); s += v.x * v.x + v.y * v.y + v.z * v.z + v.w * v.w; u32x2 w; w.x = cvt_pk_bf16(v.x, v.y); w.y = cvt_pk_bf16(v.z, v.w); o[64 * j] = w; }
            s = wave_sum(s); if (lane == 0) ssqh[m] = s;
            if (lane < 16) ((float*)(ws + WS_SSQHP))[(size_t)lane * T + m] = lane == 0 ? s : 0.f;
        }
        bf16_t* pb = (bf16_t*)(ws + WS_PB);
        const size_t n4 = (size_t)T * 256 / 4, gt = (size_t)F.c * NTHREADS + tid_, ngt = (size_t)F.G * NTHREADS;
        for (size_t i = gt; i < n4; i += ngt) { const f32x4 v = __builtin_nontemporal_load((const f32x4*)p + i); u32x2 w; w.x = cvt_pk_bf16(v.x, v.y); w.y = cvt_pk_bf16(v.z, v.w); ((u32x2*)pb)[i] = w; }
        float* rope = (float*)(ws + S_ROPE);
        for (size_t i = gt; i < 2048 * 16; i += ngt) {
            const int pos = (int)(i >> 4), k = (int)(i & 15);
            const double inv = exp(-(double)(2 * k) / 32.0 * log(10000.0)), ang = (double)pos * inv;
            rope[2 * i] = (float)cos(ang); rope[2 * i + 1] = (float)sin(ang);
        }
    }

    for (int l = 0; l < NL; ++l) {
        const int pb0 = 1 + 10 * l;
        if (hi <= pb0 || lo >= pb0 + 10) continue;
#define LF(i, per) (lds_inptr((const LAS unsigned long long*)(F.lds + PTR_OFF), (i)) + (size_t)l * (per))
        { int c_ = local_ok ? my_rank * 8 + my_xcc : (int)blockIdx.x, g_ = gridDim.x; asm volatile("" : "+s"(c_), "+s"(g_)); F.c = c_; F.G = g_; F.vcu = (g_ % 8 == 0) ? (c_ % 8) * (g_ / 8) + c_ / 8 : c_; }
        { unsigned lb = 0u; asm volatile("" : "+s"(lb)); F.lds = (LAS unsigned char*)lds_raw + lb; size_t wo = 0; asm volatile("" : "+s"(wo)); ws = args.ws + wo; F.ws = ws; }
        F.tabf = (LAS float*)(F.lds + TABF_OFF); F.tabi = (LAS int*)(F.lds + TABI_OFF); F.tabg = (LAS float*)(F.lds + TABG_OFF);
        LAS int* moe_cnt = (LAS int*)(F.lds + MISC_OFF + 64); LAS int* moe_tb = (LAS int*)(F.lds + MISC_OFF + 192); LAS int* moe_te = (LAS int*)(F.lds + MISC_OFF + 384);
        unsigned char* wsw = ws + ((l & 1) ? W_ALT : 0);
#define ZSSQ(k) ((float*)(ws + Z_SSQ) + (size_t)(k) * T)
#define XIN ((bf16_t*)(ws + ((l & 1) ? WS_X1 : WS_X0)))
#define XMID ((bf16_t*)(ws + ((l & 1) ? WS_X0 : WS_X1)))
#define ROPE ((const float*)(ws + S_ROPE))
#define GCNT ((int*)(ws + Z_CNT) + l * 64)
        if (PHON(1) && IN(pb0 + 0) && (l == 0 || !MOE_FP8)) {
            LayerW L; FILL_LAYERW(L, LF)
            const int tid_ = my_tid(F.wv), wv = __builtin_amdgcn_readfirstlane(tid_ >> 6);
            float* scr = (float*)(F.lds + wv * 8448);
            const int gw = F.vcu * NWAVES + wv, ngw = F.G * NWAVES;
#if MOE_FP8
            for (int it = gw; it < IT_SMALL; it += ngw) convert_item(L, wsw, it, scr, tid_ & 63);
            for (int it = gw; it < IT_MOE; it += 2 * ngw) { f32x4 va[16], vb[16]; const int it1 = it + ngw < IT_MOE ? it + ngw : it;
                convert_part_moe<0>(L.w1, L.w3, L.w2, L.g_ffn, wsw, it, tid_ & 63, va); convert_part_moe<0>(L.w1, L.w3, L.w2, L.g_ffn, wsw, it1, tid_ & 63, vb);
                convert_part_moe<1>(L.w1, L.w3, L.w2, L.g_ffn, wsw, it, tid_ & 63, va); convert_part_moe<1>(L.w1, L.w3, L.w2, L.g_ffn, wsw, it1, tid_ & 63, vb); }
#else
            for (int it = gw; it < IT_TOTAL; it += ngw) convert_item(L, wsw, it, scr, tid_ & 63);
#endif
            convert_small(L, wsw, F.c * NTHREADS + tid_, F.G * NTHREADS);
            SEAM(pb0 + 0);
        }
        if (PHON(2) && IN(pb0 + 1)) {
            SchedStatic S; S.init(T, NPROJ, 1024, F.G, F.c, XIN, wsw + W_IN); const float* hp = (const float*)(ws + WS_SSQHP);
            fill_tab_static(F, S, [&](int i, int r, int row) { float s = 0.f;
#pragma unroll
                for (int k = 0; k < 16; ++k) s += hp[(size_t)k * T + row];
                F.tabf[i * 256 + r] = rsqrtf(s * (1.f / 1024.f) + EPS); });
            Epi1 E{(bf16_t*)(ws + WS_CQ), (bf16_t*)(ws + WS_CKV), (bf16_t*)(ws + WS_U), (bf16_t*)(ws + WS_V), LF(10, 512), F.tabf};
            gemm_phase<Epi1, SchedStatic, false, false>(F.wv, F.lds, 1024, S, E, nullptr);
            SEAM_L(pb0 + 1);
        }
        if (PHON(3) && IN(pb0 + 2)) {
            if (PHON(11) && (p2sel < 0 || p2sel == 0)) {
                SchedStatic S; S.init(T, 768, 256, F.G, F.c, ws + WS_CQ, wsw + W_UQ);
                { Unit u; const int t_ = my_tid(F.wv), r = t_ >> 1, hf = t_ & 1;
                  for (int i = 0; i < MAXU && S.next(i, u); ++i) {
                      const u32x4* p = (const u32x4*)((const bf16_t*)(ws + WS_CQ) + (size_t)(u.pm * 256 + r) * 256 + hf * 128); float s = 0.f;
                      u32x4 xx[16];
#pragma unroll
                      for (int k = 0; k < 16; ++k) xx[k] = p[k];
#pragma unroll
                      for (int k = 0; k < 16; ++k) s += sq4(unpack_lo((u32x2){xx[k].x, xx[k].y})) + sq4(unpack_lo((u32x2){xx[k].z, xx[k].w}));
                      s += __shfl_xor(s, 1);
                      if (hf == 0) F.tabf[i * 256 + r] = rsqrtf(s * (1.f / 256.f) + EPS); }
                  __syncthreads(); }
                EpiStore<true> E{(bf16_t*)(ws + WS_Q), 768, F.tabf};
                gemm_phase<EpiStore<true>, SchedStatic, false, false>(F.wv, F.lds, 256, S, E, nullptr);
            }
            if (PHON(12) && (p2sel < 0 || p2sel == 1)) {
                SchedStatic S; S.init(T, 1024, 256, F.G, F.c, ws + WS_CKV, wsw + W_UKV);
                { Unit u; const int t_ = my_tid(F.wv), r = t_ >> 1, hf = t_ & 1;
                  for (int i = 0; i < MAXU && S.next(i, u); ++i) {
                      const u32x4* p = (const u32x4*)((const bf16_t*)(ws + WS_CKV) + (size_t)(u.pm * 256 + r) * 256); float s = 0.f, sk = 0.f;
#pragma unroll
                      for (int k = 0; k < 8; ++k) { const u32x4 x = p[hf * 8 + k]; s += sq4(unpack_lo((u32x2){x.x, x.y})) + sq4(unpack_lo((u32x2){x.z, x.w})); }
#pragma unroll
                      for (int k = 0; k < 2; ++k) { const u32x4 x = p[16 + hf * 2 + k]; sk += sq4(unpack_lo((u32x2){x.x, x.y})) + sq4(unpack_lo((u32x2){x.z, x.w})); }
                      s += __shfl_xor(s, 1); sk += __shfl_xor(sk, 1);
                      if (hf == 0) { F.tabf[i * 256 + r] = rsqrtf(s * (1.f / 128.f) + EPS); F.tabg[i * 256 + r] = sk; } }
                  __syncthreads(); }
                Epi2b E{(bf16_t*)(ws + WS_K), (bf16_t*)(ws + WS_VF), (const bf16_t*)(ws + WS_CKV), LF(9, 96), ROPE, F.tabf, F.tabg};
                gemm_phase<Epi2b, SchedStatic, false, false>(F.wv, F.lds, 256, S, E, nullptr);
            }
            if (PHON(13) && (p2sel < 0 || p2sel == 2)) {
                SchedE S; S.init(T, 1024, 256, F.G, F.c, ws + WS_PB + (size_t)l * T * 256 * 2, wsw + W_PLE);
#if MOE_FP8
                EpiStoreF8 E{(unsigned char*)(ws + WS_E), 1024};
                gemm_phase<EpiStoreF8, SchedE, false, false>(F.wv, F.lds, 256, S, E, nullptr);
#else
                EpiStore<false> E{(bf16_t*)(ws + WS_E), 1024, F.tabf};
                gemm_phase<EpiStore<false>, SchedStatic, false, false>(F.wv, F.lds, 256, S, E, nullptr);
#endif
            }
            if (PHON(14) && (p2sel < 0 || p2sel == 3)) for (int u = F.vcu; u < T / 128; u += F.G) gmlp_unit(F, u, (const bf16_t*)(ws + WS_U), (const bf16_t*)(ws + WS_V), (const bf16_t*)(wsw + W_S), LF(12, 8 * 128), (bf16_t*)(ws + WS_AM));
            SEAM_L(pb0 + 2);
        }
        if (PHON(4) && IN(pb0 + 3)) {
            CvCtx cv; cv.nl = -1; cv.wsw = ws; cv.stride = 1; cv.ptab = (const LAS unsigned long long*)(F.lds + PTR_OFF); int cv_it = 0, cv_iter = 0;
            const int grp = (F.c >> 3) & 3;
            for (int v = F.vcu; v < 256; v += F.G) {
                const int bh = v >> 1, j = v & 1;
                const int cvp = (MOE_FP8 && l + 1 < NL && v == F.vcu) ? ((grp == 1) ? 1 + j : grp) : -1;
#pragma unroll 1
                for (int i = 0; i < 4; ++i) {
                    if (i == cvp) {
                        CvCtx c2; c2.nl = l + 1; c2.wsw = ws + (((l + 1) & 1) ? W_ALT : 0); c2.stride = F.G * NWAVES; c2.ptab = (const LAS unsigned long long*)(F.lds + PTR_OFF);
                        const int tid_ = my_tid(F.wv);
                        for (int it = F.vcu * NWAVES + __builtin_amdgcn_readfirstlane(tid_ >> 6); it < IT_MOE; it += 2 * c2.stride) { f32x4 va[16], vb[16]; const int it1 = it + c2.stride < IT_MOE ? it + c2.stride : it;
                            cv_part<0>(c2, it, va, tid_ & 63); cv_part<0>(c2, it1, vb, tid_ & 63);
                            cv_part<1>(c2, it, va, tid_ & 63); cv_part<1>(c2, it1, vb, tid_ & 63); }
                    }
                    const int ii = (grp == 1) ? ((i == 0) ? 2 : (i == 1) ? 0 : (i == 2) ? 1 : 3) : i;
                    const int qb = (ii == 0) ? j : (ii == 1) ? 7 - j : (ii == 2) ? 3 - j : 4 + j;
                    attn_unit(F, bh >> 3, bh & 7, qb, (const bf16_t*)(ws + WS_Q), (const bf16_t*)(ws + WS_K), (const bf16_t*)(ws + WS_VF), (bf16_t*)(ws + WS_AM), (float*)(ws + WS_SSQAP), LF(8, 96), ROPE, cv, cv_it, cv_iter);
                }
            }
            SEAM_L(pb0 + 3);
        }
        if (PHON(5) && IN(pb0 + 4)) {
            SchedStatic S; S.init(T, 1024, 1024, F.G, F.c, ws + WS_AM, wsw + W_OUT); const float* ap = (const float*)(ws + WS_SSQAP);
            fill_tab_static(F, S, [&](int i, int r, int row) { float s = 0.f;
#pragma unroll
                for (int k = 0; k < 8; ++k) s += ap[(size_t)k * T + row];
                F.tabf[i * 256 + r] = rsqrtf(s * (1.f / 512.f) + EPS); });
            Epi4 E{XIN, XMID, F.tabf, MOE_FP8 ? (unsigned char*)(ws + WS_X8) : nullptr};
            gemm_phase<Epi4, SchedStatic, false, true>(F.wv, F.lds, 1024, S, E, nullptr);
            SEAM_L(pb0 + 4);
        }
        if (PHON(6) && IN(pb0 + 5)) {
            for (int u = F.vcu; u < T / 128; u += F.G) router_unit(F, u, XMID, (const bf16_t*)(wsw + W_R), GCNT, (int*)(ws + S_SLOTTOK), (float*)(ws + S_SLOTRSTD), (float*)(ws + S_SLOTGATE));
            TS_REC(42 + l);
            SEAM(pb0 + 5);
        }
        if (PHON(7) && IN(pb0 + 6) && MOE_FP8 && l + 1 < NL) {
            CvCtx cv; int cv_it; cv.nl = l + 1; cv.wsw = ws + (((l + 1) & 1) ? W_ALT : 0);
            const int tid_ = my_tid(F.wv); cv_it = F.vcu * NWAVES + __builtin_amdgcn_readfirstlane(tid_ >> 6); cv.stride = F.G * NWAVES; cv.ptab = (const LAS unsigned long long*)(F.lds + PTR_OFF);
            { LayerW Ln; const int l_ = l; { const int l = l_ + 1; FILL_LAYERW(Ln, LF) } convert_small(Ln, cv.wsw, F.c * NTHREADS + tid_, F.G * NTHREADS);
              for (int it = cv_it; it < IT_SMALL; it += cv.stride) convert_item(Ln, cv.wsw, it, nullptr, tid_ & 63); }
        }
        if ((PHON(7) && IN(pb0 + 6)) || (PHON(8) && IN(pb0 + 7))) {
            const int t_ = my_tid(F.wv);
            if (t_ < 32) moe_cnt[t_] = __hip_atomic_load(GCNT + t_, __ATOMIC_RELAXED, __HIP_MEMORY_SCOPE_AGENT);
            __syncthreads();
            if (t_ == 0) { int b = 0; for (int e = 0; e < 32; ++e) { moe_tb[e] = b; const int n = (moe_cnt[e] + 255) >> 8; for (int k = 0; k < n; ++k) moe_te[b + k] = e; b += n; } moe_tb[32] = b; }
            __syncthreads();
        }
        if (PHON(7) && IN(pb0 + 6)) {
            const int* stok = (const int*)(ws + S_SLOTTOK); const float* srs = (const float*)(ws + S_SLOTRSTD);
#if MOE_FP8
            SchedMoe S{moe_tb[32], F.G, F.c, moe_te, (const char*)(ws + WS_X8), (const char*)(wsw + W_13), 0, (size_t)1024 * 1024, (size_t)256 * 1024};
#else
            SchedMoe S{moe_tb[32], F.G, F.c, moe_te, (const char*)XMID, (const char*)(wsw + W_13), 0, (size_t)1024 * 1024 * 2, (size_t)256 * 1024 * 2};
#endif
            { Unit u; for (int i = 0; i < MAXU && S.next(i, u); ++i) for (int r = my_tid(F.wv); r < 256; r += NTHREADS) {
                const int pos = (u.pm - moe_tb[u.e]) * 256 + r; const bool ok = pos < moe_cnt[u.e]; const size_t o = (size_t)u.e * T + pos;
                F.tabi[i * 256 + r] = ok ? (stok[o] & 0x3fffffff) : 0; F.tabf[i * 256 + r] = ok ? srs[o] : 0.f; }
              __syncthreads(); }
#if MOE_FP8
            Epi6F8 E{(unsigned char*)(ws + WS_H), F.tabf};
            gemm_phase<Epi6F8, SchedMoe, true, false, true>(F.wv, F.lds, 512, S, E, F.tabi);
#else
            Epi6 E{(bf16_t*)(ws + WS_H), F.tabf};
            gemm_phase<Epi6, SchedMoe, true, false>(F.wv, F.lds, 1024, S, E, F.tabi);
#endif
            SEAM_L(pb0 + 6);
        }
        if (PHON(8) && IN(pb0 + 7)) {
            const int* stok = (const int*)(ws + S_SLOTTOK); const float* sg = (const float*)(ws + S_SLOTGATE);
#if MOE_FP8
            SchedMoe S{moe_tb[32], F.G, F.c, moe_te, (const char*)(ws + WS_H), (const char*)(wsw + W_2), (size_t)256 * 512, (size_t)1024 * 512, (size_t)256 * 512};
#else
            SchedMoe S{moe_tb[32], F.G, F.c, moe_te, (const char*)(ws + WS_H), (const char*)(wsw + W_2), (size_t)256 * 512 * 2, (size_t)1024 * 512 * 2, (size_t)256 * 512 * 2};
#endif
            { Unit u; for (int i = 0; i < MAXU && S.next(i, u); ++i) for (int r = my_tid(F.wv); r < 256; r += NTHREADS) {
                const int pos = (u.pm - moe_tb[u.e]) * 256 + r; const bool ok = pos < moe_cnt[u.e]; const size_t o = (size_t)u.e * T + pos;
                F.tabi[i * 256 + r] = ok ? stok[o] : -1; F.tabg[i * 256 + r] = ok ? sg[o] : 0.f; }
              __syncthreads(); }
#if MOE_FP8
            Epi7 E{(bf16_t*)(ws + WS_Y0), (bf16_t*)(ws + WS_Y1), F.tabi, F.tabg, W8_INV};
            gemm_phase<Epi7, SchedMoe, false, false, true>(F.wv, F.lds, 256, S, E, nullptr);
#else
            Epi7 E{(bf16_t*)(ws + WS_Y0), (bf16_t*)(ws + WS_Y1), F.tabi, F.tabg, 1.f};
            gemm_phase<Epi7, SchedMoe, false, false>(F.wv, F.lds, 512, S, E, nullptr);
#endif
            SEAM(pb0 + 7);
        }
        if (PHON(9) && IN(pb0 + 8)) {
            const int tid_ = my_tid(F.wv), lane = tid_ & 63, gw = F.vcu * NWAVES + (tid_ >> 6), ngw = F.G * NWAVES;
            for (int mk = 0; mk < T / ngw; ++mk) { const int m = (gw >> 8) * 4096 + mk * 256 + (gw & 255);
#if MOE_FP8
                const u32x2* a = (const u32x2*)(ws + WS_Y0 + (size_t)m * 1024) + lane; const u32x2* b = (const u32x2*)(ws + WS_Y1 + (size_t)m * 1024) + lane; const u32x4* hh = (const u32x4*)(XMID + (size_t)m * 1024) + lane; u32x4* o = (u32x4*)(XIN + (size_t)m * 1024) + lane; float s = 0.f;
#pragma unroll
                for (int j = 0; j < 2; ++j) {
                    const u32x2 x = __builtin_nontemporal_load(a + 64 * j), y = __builtin_nontemporal_load(b + 64 * j); const u32x4 z = __builtin_nontemporal_load(hh + 64 * j);
                    const f32x4 v0 = unpack_lo((u32x2){z.x, z.y}) + (unpack_fp8x4(x.x) + unpack_fp8x4(y.x)) * Y8_INV, v1 = unpack_lo((u32x2){z.z, z.w}) + (unpack_fp8x4(x.y) + unpack_fp8x4(y.y)) * Y8_INV;
#else
                const u32x4* a = (const u32x4*)(ws + WS_Y0 + (size_t)m * 2048) + lane; const u32x4* b = (const u32x4*)(ws + WS_Y1 + (size_t)m * 2048) + lane; const u32x4* hh = (const u32x4*)(XMID + (size_t)m * 1024) + lane; u32x4* o = (u32x4*)(XIN + (size_t)m * 1024) + lane; float s = 0.f;
#pragma unroll
                for (int j = 0; j < 2; ++j) {
                    const u32x4 x = a[64 * j], y = b[64 * j], z = hh[64 * j];
                    const f32x4 v0 = unpack_lo((u32x2){z.x, z.y}) + (unpack_lo((u32x2){x.x, x.y}) + unpack_lo((u32x2){y.x, y.y})), v1 = unpack_lo((u32x2){z.z, z.w}) + (unpack_lo((u32x2){x.z, x.w}) + unpack_lo((u32x2){y.z, y.w}));
#endif
                    const u32x4 w = pack8(v0, v1); o[64 * j] = w;
                    const f32x4 r0 = unpack_lo((u32x2){w.x, w.y}), r1 = unpack_lo((u32x2){w.z, w.w});
                    if (MOE_FP8) { u32x2 q; q.x = pk4_fp8(r0[0], r0[1], r0[2], r0[3]); q.y = pk4_fp8(r1[0], r1[1], r1[2], r1[3]); ((u32x2*)(ws + WS_X8 + (size_t)m * 1024))[lane + 64 * j] = q; }
                    s += sq4(r0) + sq4(r1);
                }
                if (l + 1 < NL) { const f32x4 pv = __builtin_nontemporal_load((const f32x4*)(lds_inptr((const LAS unsigned long long*)(F.lds + PTR_OFF), 1) + ((size_t)(l + 1) * T + m) * 256) + lane); u32x2 pw; pw.x = cvt_pk_bf16(pv.x, pv.y); pw.y = cvt_pk_bf16(pv.z, pv.w);
                    ((u32x2*)((bf16_t*)(ws + WS_PB) + ((size_t)(l + 1) * T + m) * 256))[lane] = pw; }
                s = wave_sum(s); if (lane == 0) ((float*)(ws + S_RSTD2))[m] = rsqrtf(s * (1.f / 1024.f) + EPS);
            }
            SEAM_L(pb0 + 8);
        }
        if (PHON(10) && IN(pb0 + 9)) {
#if MOE_FP8
            SchedStatic S; S.init(T, 1024, 512, F.G, F.c, ws + WS_X8, wsw + W_PG); const float* rstd2 = (const float*)(ws + S_RSTD2);
            fill_tab_static(F, S, [&](int i, int r, int row) { F.tabf[i * 256 + r] = rstd2[row] * W8_INV; });
#else
            SchedStatic S; S.init(T, 1024, 1024, F.G, F.c, XIN, wsw + W_PG); const float* rstd2 = (const float*)(ws + S_RSTD2);
            fill_tab_static(F, S, [&](int i, int r, int row) { F.tabf[i * 256 + r] = rstd2[row]; });
#endif
            Epi9 E{XIN, (const unsigned char*)(ws + WS_E), XMID, (l == NL - 1) ? args.out : nullptr, (float*)(ws + WS_SSQHP), LF(24, 1024), F.tabf};
#if MOE_FP8
            gemm_phase<Epi9, SchedStatic, false, false, true>(F.wv, F.lds, 512, S, E, nullptr);
#else
            gemm_phase<Epi9, SchedStatic, false, false>(F.wv, F.lds, 1024, S, E, nullptr);
#endif
            SEAM_L(pb0 + 9);
        }
    }
#ifdef TS_A
    if (F.c == TS_C && my_tid(F.wv) == 0) { volatile LAS unsigned long long* ts = (volatile LAS unsigned long long*)(F.lds + PTR_OFF + 256);
        const unsigned long long d = ts[TS_B] - ts[TS_A], end = __builtin_amdgcn_s_memrealtime() + (unsigned long long)TS_M * d;
        if (d < 100000ull) while (__builtin_amdgcn_s_memrealtime() < end) __builtin_amdgcn_s_sleep(16); }
#endif
#undef IN
#undef SEAM
}

#ifdef PROBE_EXTRA
__global__ void __launch_bounds__(NTHREADS, 2) mk_probe(MkArgs args) {
    extern __shared__ __attribute__((aligned(16))) unsigned char lds_raw[];
    Frame F; F.lds = (LAS unsigned char*)lds_raw; F.ws = args.ws; F.wv = __builtin_amdgcn_readfirstlane((int)threadIdx.x >> 6);
    F.G = gridDim.x; F.c = blockIdx.x; F.vcu = F.c; F.tabf = (LAS float*)(F.lds + TABF_OFF); F.tabi = (LAS int*)(F.lds + TABI_OFF); F.tabg = (LAS float*)(F.lds + TABG_OFF);
    unsigned char* ws = args.ws; const int sel = args.ph_lo;
    for (int i = threadIdx.x; i < MAXU * 256; i += NTHREADS) F.tabf[i] = 1.f;
    __syncthreads();
    if (sel >= 10 && sel < 18) {
        CvCtx cv; cv.nl = -1; cv.wsw = ws; cv.stride = 1; cv.ptab = nullptr; int cv_it = 0, cv_iter = 0;
        const float* gq = (const float*)(ws + S_ROPE); const float* rope = (const float*)(ws + S_ROPE);
        const int v = (F.c % 8) * (F.G / 8) + F.c / 8, bh = v >> 1, j = v & 1;
#pragma unroll 1
        for (int i = 0; i < 4; ++i) { const int qb = (i == 0) ? j : (i == 1) ? 7 - j : (i == 2) ? 3 - j : 4 + j;
#define PATT(V) attn_unit<V>(F, bh >> 3, bh & 7, qb, (const bf16_t*)(ws + WS_AM), (const bf16_t*)(ws + WS_X0), (const bf16_t*)(ws + WS_X1), (bf16_t*)(ws + WS_SCR), (float*)(ws + WS_SCR + 64 * MiB), gq, rope, cv, cv_it, cv_iter)
            if (sel == 10) PATT(0); else if (sel == 11) PATT(1); else if (sel == 12) PATT(2); else if (sel == 13) PATT(3); else if (sel == 14) PATT(4); else if (sel == 17) PATT(7);
#undef PATT
        }
    }
    if (sel == 0) { SchedStatic S; S.init(T, 1024, 256, F.G, F.c, ws + WS_CKV, ws + W_UKV); EpiNull E{(float*)(ws + WS_SCR)}; gemm_phase<EpiNull, SchedStatic, false, false>(F.wv, F.lds, 256, S, E, nullptr); }
    if (sel == 1) { SchedStatic S; S.init(T, 1024, 1024, F.G, F.c, ws + WS_AM, ws + W_OUT); EpiNull E{(float*)(ws + WS_SCR)}; gemm_phase<EpiNull, SchedStatic, false, false>(F.wv, F.lds, 1024, S, E, nullptr); }
    if (sel == 2) { SchedStatic S; S.init(T, 1024, 256, F.G, F.c, ws + WS_CKV, ws + W_UKV); EpiStore<false> E{(bf16_t*)(ws + WS_SCR), 1024, F.tabf}; gemm_phase<EpiStore<false>, SchedStatic, false, false>(F.wv, F.lds, 256, S, E, nullptr); }
    if (sel == 3) { SchedStatic S; S.init(T, 1024, 1024, F.G, F.c, ws + WS_AM, ws + W_OUT); EpiStore<false> E{(bf16_t*)(ws + WS_SCR), 1024, F.tabf}; gemm_phase<EpiStore<false>, SchedStatic, false, false>(F.wv, F.lds, 1024, S, E, nullptr); }
}
#endif

#ifndef FASTMASK
#define FASTMASK 0x7ff
#endif
static void launch_mk(const MkArgs& base, int lo, int hi, int grid, hipStream_t stream) {
    MkArgs a = base; a.ph_lo = lo; a.ph_hi = hi;
    hipLaunchKernelGGL(mk_fwd, dim3(grid), dim3(NTHREADS), LDS_BYTES, stream, a);
}
extern "C" void kernel_launch(void* const* d_in, const int* in_sizes, int n_in, void* d_out, int out_size, void* d_ws, size_t ws_size, hipStream_t stream) {
    static int grid = 0;
    if (grid == 0) {
        if (n_in != 26 || ws_size < WS_END) { fprintf(stderr, "kernel_launch: unexpected n_in %d or ws_size %zu\n", n_in, ws_size); grid = -1; return; }
        int dev = 0, cus = 0;
        if (hipGetDevice(&dev) != hipSuccess || hipDeviceGetAttribute(&cus, hipDeviceAttributeMultiprocessorCount, dev) != hipSuccess) { grid = -1; return; }
        if (hipFuncSetAttribute((const void*)mk_fwd, hipFuncAttributeMaxDynamicSharedMemorySize, LDS_BYTES) != hipSuccess) { fprintf(stderr, "kernel_launch: hipFuncSetAttribute failed\n"); grid = -1; return; }
        int per_cu = 0;
        if (hipOccupancyMaxActiveBlocksPerMultiprocessor(&per_cu, (const void*)mk_fwd, NTHREADS, LDS_BYTES) != hipSuccess || per_cu < 1) fprintf(stderr, "kernel_launch: occupancy query says %d\n", per_cu);
        (void)hipGetLastError();
        grid = cus;
    }
    if (grid < 0) return;
    unsigned char* ws = (unsigned char*)d_ws;
    (void)hipMemsetAsync(ws + WS_ZERO, 0, ZERO_BYTES, stream);
    MkArgs A{};
    for (int i = 0; i < 26; ++i) A.in[i] = (const float*)d_in[i];
    A.out = (float*)d_out; A.ws = ws;
    constexpr unsigned FM = FASTMASK;
    if (FM == 0x7ffu) {
        launch_mk(A, 0, 1 + 10 * NL, grid, stream);
#ifdef PROBE_PH
#ifdef PROBE_EXTRA
        { static bool once = false; if (!once) { (void)hipFuncSetAttribute((const void*)mk_probe, hipFuncAttributeMaxDynamicSharedMemorySize, LDS_BYTES); once = true; }
          MkArgs a = A; a.ph_lo = PROBE_PH; a.ph_hi = 0; for (int r_ = 0; r_ < PROBE_REP; ++r_) hipLaunchKernelGGL(mk_probe, dim3(grid), dim3(NTHREADS), LDS_BYTES, stream, a); }
#else
        for (int r_ = 0; r_ < PROBE_REP; ++r_) launch_mk(A, 31 + PROBE_PH, 32 + PROBE_PH, grid, stream);
#endif
#endif
        return; }
    const float* x = (const float*)d_in[0]; const float* p = (const float*)d_in[1];
    if (FM & 1u) launch_mk(A, 0, 1, grid, stream); else k_prologue<<<1024, 256, 0, stream>>>(x, p, ws);
    float* scr = (float*)(ws + WS_SCR);
    bf16_t* X[2] = {(bf16_t*)(ws + WS_X0), (bf16_t*)(ws + WS_X1)};
    int* gidx = (int*)(ws + S_FLAT); int* tile_e = gidx + 3 * MAXSLOT; int* nrows = tile_e + MAXSLOT / 128 + MAXSLOT;
    for (int l = 0; l < NL; ++l) {
        auto F = [&](int i, size_t per) { return (const float*)d_in[i] + (size_t)l * per; };
        LayerW L;
        L.g_mix = F(2, 1024); L.w_in = F(3, 1024 * 1440); L.g_cq = F(4, 256); L.g_ckv = F(5, 128); L.w_uq = F(6, 256 * 768); L.w_ukv = F(7, 128 * 1024);
        L.g_qn = F(8, 96); L.g_kn = F(9, 96); L.g_v = F(10, 512); L.w_s = F(11, 8 * 128 * 128); L.b_s = F(12, 8 * 128); L.g_oa = F(13, 512); L.g_om = F(14, 512);
        L.w_out = F(15, 1024 * 1024); L.g_ffn = F(16, 1024); L.w_rg = F(17, 1024 * 4); L.w_re = F(18, 1024 * 32);
        L.w1 = F(19, (size_t)32 * 1024 * 512); L.w3 = F(20, (size_t)32 * 1024 * 512); L.w2 = F(21, (size_t)32 * 512 * 1024);
        L.g_ple = F(22, 1024); L.w_pg = F(23, 1024 * 1024); L.b_pg = F(24, 1024); L.w_ple = F(25, 256 * 1024);
        bf16_t* Xin = X[l & 1]; bf16_t* Xmid = X[(l & 1) ^ 1];
        const int pb0 = 1 + 10 * l;
        if (FM & 2u) launch_mk(A, pb0 + 0, pb0 + 1, grid, stream); else k_convert<<<1024, 256, 0, stream>>>(L, ws);
        if (FM & 4u) launch_mk(A, pb0 + 1, pb0 + 2, grid, stream);
        else {
            k_ngemm<<<dim3(NPROJ / 128, T / 128), 256, 0, stream>>>(Xin, 1024, nullptr, (const bf16_t*)(ws + W_IN), 1024, nullptr, 0, scr, NPROJ, 1024, nullptr);
            k_post1<<<T / 4, 256, 0, stream>>>(scr, ws, l, L.g_v);
        }
        if (FM & 8u) launch_mk(A, pb0 + 2, pb0 + 3, grid, stream);
        else {
            k_ngemm<<<dim3(768 / 128, T / 128), 256, 0, stream>>>((const bf16_t*)(ws + WS_CQ), 256, nullptr, (const bf16_t*)(ws + W_UQ), 256, nullptr, 0, scr, 768, 256, nullptr);
            k_post2a<<<T * 768 / 256, 256, 0, stream>>>(scr, ws, l);
            k_ngemm<<<dim3(1024 / 128, T / 128), 256, 0, stream>>>((const bf16_t*)(ws + WS_CKV), 256, nullptr, (const bf16_t*)(ws + W_UKV), 256, nullptr, 0, scr, 1024, 256, nullptr);
            k_post2b<<<T * 8 / 4, 256, 0, stream>>>(scr, ws, l, L.g_kn);
            k_gmlp<<<T * 512 / 256, 256, 0, stream>>>(ws, L.b_s);
            k_rowstat_am<<<T / 4, 256, 0, stream>>>(ws, l, 1);
            k_norm_m<<<T * 512 / 256, 256, 0, stream>>>(ws);
            k_ngemm<<<dim3(1024 / 128, T / 128), 256, 0, stream>>>((const bf16_t*)(ws + WS_PB) + (size_t)l * T * 256, 256, nullptr, (const bf16_t*)(ws + W_PLE), 256, nullptr, 0, scr, 1024, 256, nullptr);
            k_tobf16<<<T * 1024 / 256, 256, 0, stream>>>(scr, (bf16_t*)(ws + WS_E));
        }
        if (FM & 16u) launch_mk(A, pb0 + 3, pb0 + 4, grid, stream);
        else {
            k_attn<<<T * 8 / 64, 64, 0, stream>>>(ws, L.g_qn);
            k_rowstat_am<<<T / 4, 256, 0, stream>>>(ws, l, 0);
        }
        if (FM & 32u) launch_mk(A, pb0 + 4, pb0 + 5, grid, stream);
        else {
            k_ngemm<<<dim3(1024 / 128, T / 128), 256, 0, stream>>>((const bf16_t*)(ws + WS_AM), 1024, nullptr, (const bf16_t*)(ws + W_OUT), 1024, nullptr, 0, scr, 1024, 512, nullptr);
            k_ngemm<<<dim3(1024 / 128, T / 128), 256, 0, stream>>>((const bf16_t*)(ws + WS_AM) + 512, 1024, nullptr, (const bf16_t*)(ws + W_OUT) + 512, 1024, nullptr, 0, scr + (size_t)T * 1024, 1024, 512, nullptr);
            k_post4<<<T * 1024 / 256, 256, 0, stream>>>(scr, ws, l, Xin, Xmid);
        }
        if (FM & 64u) launch_mk(A, pb0 + 5, pb0 + 6, grid, stream); else k_router<<<T / 4, 256, 0, stream>>>(ws, l, Xmid);
        if ((FM & 384u) != 384u) k_build<<<1, 256, 0, stream>>>(ws, l);
        if (FM & 128u) launch_mk(A, pb0 + 6, pb0 + 7, grid, stream);
        else {
            k_ngemm<<<dim3(1024 / 128, MAXSLOT / 128), 256, 0, stream>>>(Xmid, 1024, gidx, (const bf16_t*)(ws + W_13), 1024, tile_e, (size_t)1024 * 1024, scr, 1024, 1024, nrows);
            k_post6<<<MAXSLOT * 512 / 256, 256, 0, stream>>>(scr, ws);
        }
        if (FM & 256u) launch_mk(A, pb0 + 7, pb0 + 8, grid, stream);
        else {
            k_ngemm<<<dim3(1024 / 128, MAXSLOT / 128), 256, 0, stream>>>((const bf16_t*)(ws + WS_H), 512, nullptr, (const bf16_t*)(ws + W_2), 512, tile_e, (size_t)1024 * 512, scr, 1024, 512, nrows);
            k_post7<<<MAXSLOT * 1024 / 256, 256, 0, stream>>>(scr, ws, Xmid);
        }
        if (FM & 512u) launch_mk(A, pb0 + 8, pb0 + 9, grid, stream); else k_combine<<<T / 4, 256, 0, stream>>>(ws, Xin);
        if (FM & 1024u) launch_mk(A, pb0 + 9, pb0 + 10, grid, stream);
        else {
            k_ngemm<<<dim3(1024 / 128, T / 128), 256, 0, stream>>>(Xin, 1024, nullptr, (const bf16_t*)(ws + W_PG), 1024, nullptr, 0, scr, 1024, 1024, nullptr);
            k_post9<<<T / 4, 256, 0, stream>>>(scr, ws, l, Xin, Xmid, l == NL - 1 ? (float*)d_out : nullptr, L.b_pg);
        }
    }
}
```

```cpp
#include <hip/hip_runtime.h>
#include <stdint.h>
#include <stdio.h>

typedef unsigned short bf16_t;
typedef short bf16x8 __attribute__((ext_vector_type(8)));
typedef float f32x4 __attribute__((ext_vector_type(4)));
typedef unsigned u32x4 __attribute__((ext_vector_type(4)));
typedef unsigned u32x2 __attribute__((ext_vector_type(2)));

constexpr int T = 32768, D = 1024, SEQ = 2048, NL = 4;
constexpr int NPROJ = 1536;
constexpr int NEXP = 32, DEXP = 512;
constexpr int MAXSLOT = 73728;
constexpr float EPS = 1e-6f;
constexpr float SM_SCALE = 0.10206207261596577f;

constexpr size_t MiB = 1u << 20;
constexpr size_t WS_ZERO = 0, ZERO_BYTES = 4 * MiB;
constexpr size_t Z_BAR = 0;
constexpr size_t Z_CNT = 16384;
constexpr size_t Z_SSQ = 65536;
constexpr size_t WS_SMALL = 4 * MiB;
constexpr size_t S_ROPE = WS_SMALL;
constexpr size_t S_SSQKR = WS_SMALL + 256 * 1024;
constexpr size_t S_RSTDM = S_SSQKR + 128 * 1024;
constexpr size_t S_RSTD2 = S_RSTDM + 128 * 1024;
constexpr size_t S_SLOTTOK = WS_SMALL + 1 * MiB;
constexpr size_t S_SLOTRSTD = WS_SMALL + 5 * MiB;
constexpr size_t S_SLOTGATE = WS_SMALL + 9 * MiB;
constexpr size_t S_FLAT = WS_SMALL + 13 * MiB;
constexpr size_t WS_W = 20 * MiB;
constexpr size_t W_IN = WS_W;
constexpr size_t W_UQ = W_IN + (size_t)NPROJ * 1024 * 2;
constexpr size_t W_UKV = W_UQ + 768 * 256 * 2;
constexpr size_t W_PLE = W_UKV + 1024 * 256 * 2;
constexpr size_t W_OUT = W_PLE + 1024 * 256 * 2;
constexpr size_t W_PG = W_OUT + 1024 * 1024 * 2;
constexpr size_t W_13 = W_PG + 1024 * 1024 * 2;
constexpr size_t W_2 = W_13 + (size_t)32 * 1024 * 1024 * 2;
constexpr size_t W_R = W_2 + (size_t)32 * 1024 * 512 * 2;
constexpr size_t W_S = W_R + 2 * 64 * 1024 * 2;
constexpr size_t W_END = W_S + 8 * 128 * 128 * 2;
static_assert(W_END <= 126 * MiB, "weights region");
constexpr size_t WS_X0 = 126 * MiB, WS_X1 = 190 * MiB;
constexpr size_t WS_PB = 254 * MiB;
constexpr size_t WS_CQ = 318 * MiB, WS_CKV = 334 * MiB, WS_U = 350 * MiB, WS_V = 382 * MiB;
constexpr size_t WS_H = 318 * MiB;
constexpr size_t WS_Q = 414 * MiB, WS_K = 462 * MiB, WS_VF = 510 * MiB;
constexpr size_t WS_Y0 = 414 * MiB, WS_Y1 = 478 * MiB;
constexpr size_t WS_AM = 542 * MiB;
constexpr size_t WS_E = 606 * MiB;
constexpr size_t WS_SCR = 670 * MiB;
constexpr size_t W_ALT = 682 * MiB;
constexpr size_t WS_X8 = 670 * MiB;
constexpr size_t WS_SSQHP = 958 * MiB;
constexpr size_t WS_SSQAP = 960 * MiB;
constexpr size_t WS_END = 961 * MiB;
static_assert((size_t)MAXSLOT * 512 * 2 <= 96 * MiB, "H overlay");

__device__ __forceinline__ float bf2f(bf16_t v) { return __uint_as_float((unsigned)v << 16); }
__device__ __forceinline__ bf16_t f2bf(float f) { unsigned u = __float_as_uint(f); return (bf16_t)((u + 0x7fffu + ((u >> 16) & 1u)) >> 16); }
__device__ __forceinline__ unsigned pk2(float lo, float hi) { return (unsigned)f2bf(lo) | ((unsigned)f2bf(hi) << 16); }
__device__ __forceinline__ float gelu_tanh(float x) { const float z = -2.3022081983740904f * (x + 0.044715f * x * x * x); return x * __builtin_amdgcn_rcpf(1.f + __builtin_amdgcn_exp2f(z)); }
__device__ __forceinline__ float silu_f(float x) { return x * __builtin_amdgcn_rcpf(1.f + __builtin_amdgcn_exp2f(-1.4426950408889634f * x)); }
__device__ __forceinline__ float sigmoid_f(float x) { return __builtin_amdgcn_rcpf(1.f + __builtin_amdgcn_exp2f(-1.4426950408889634f * x)); }
__device__ __forceinline__ float wave_sum(float v) {
#pragma unroll
    for (int o = 1; o < 64; o <<= 1) v += __shfl_xor(v, o);
    return v;
}
__host__ __device__ __forceinline__ int proj_src(int pc) {
    if (pc < 416) return pc;
    if (pc < 512) return -1;
    if (pc < 1024) return 416 + (pc - 512);
    const int q = pc - 1024, tv = q >> 8, r = q & 255, bj = r >> 7, wc = (r & 127) >> 5, x = r & 31;
    return 928 + 256 * tv + 64 * wc + 32 * bj + x;
}
__host__ __device__ __forceinline__ int ukv_src(int pc) {
    const int t = pc >> 8, r = pc & 255, bj = r >> 7, wc = (r & 127) >> 5, x = r & 31;
    return (2 * t + (wc >> 1)) * 128 + (wc & 1) * 64 + 32 * bj + x;
}

struct LayerW {
    const float *g_mix, *w_in, *g_cq, *g_ckv, *w_uq, *w_ukv, *g_qn, *g_kn, *g_v, *w_s, *b_s, *g_oa, *g_om, *w_out, *g_ffn, *w_rg, *w_re, *w1, *w3, *w2, *g_ple, *w_pg, *b_pg, *w_ple;
};

template <int PART, class Src>
__device__ __forceinline__ void transpose_part(const Src& src, int K, int N, bf16_t* out, int item, int lane, f32x4 (&v)[16]) {
    const int nblk = N / 32, kb_ = item / nblk, nb = item % nblk, kb = lane >> 3, ch = lane & 7, k0 = 64 * kb_ + 8 * kb, n0 = 32 * nb + 4 * ch;
    if (PART != 1) {
#pragma unroll
        for (int j = 0; j < 8; ++j) v[j] = src.load4(k0 + j, n0); }
    if (PART != 0) {
#pragma unroll
        for (int c = 0; c < 4; ++c) {
            u32x4 o; o.x = pk2(v[0][c], v[1][c]); o.y = pk2(v[2][c], v[3][c]); o.z = pk2(v[4][c], v[5][c]); o.w = pk2(v[6][c], v[7][c]);
            *(u32x4*)(out + (size_t)(n0 + c) * K + k0) = o; } }
}
template <class Src>
__device__ __forceinline__ void transpose_item(const Src& src, int K, int N, bf16_t* out, float*  , int item, int lane) { f32x4 v[16]; transpose_part<2>(src, K, N, out, item, lane, v); }
struct SrcIn { const float* w; const float* g; __device__ __forceinline__ f32x4 load4(int k, int n) const { const int s = proj_src(n); return s < 0 ? (f32x4){0.f, 0.f, 0.f, 0.f} : *(const f32x4*)(w + (size_t)k * 1440 + s) * g[k]; } };
struct SrcUq { const float* w; const float* g; __device__ __forceinline__ f32x4 load4(int k, int n) const { return *(const f32x4*)(w + (size_t)k * 768 + n) * g[k]; } };
struct SrcUkv { const float* w; const float* g; __device__ __forceinline__ f32x4 load4(int k, int n) const { return k < 128 ? *(const f32x4*)(w + (size_t)k * 1024 + ukv_src(n)) * g[k] : (f32x4){0.f, 0.f, 0.f, 0.f}; } };
struct SrcPlain { const float* w; int ldw; __device__ __forceinline__ f32x4 load4(int k, int n) const { return *(const f32x4*)(w + (size_t)k * ldw + n); } };
struct SrcOut { const float* w; const float* ga; const float* gm; __device__ __forceinline__ f32x4 load4(int k, int n) const { return *(const f32x4*)(w + (size_t)k * 1024 + n) * (k < 512 ? ga[k] : gm[k - 512]); } };
struct SrcPg { const float* w; const float* g; __device__ __forceinline__ f32x4 load4(int k, int n) const { return *(const f32x4*)(w + (size_t)k * 1024 + n) * g[k]; } };
struct Src13 { const float* w1; const float* w3; const float* g; __device__ __forceinline__ f32x4 load4(int k, int n) const { const int q = n >> 3; const long d13 = (long)(w3 - w1) * (long)((n >> 2) & 1); return *(const f32x4*)(w1 + d13 + (size_t)k * 512 + 4 * q) * g[k]; } };

#ifndef MOE_FP8
#define MOE_FP8 1
#endif
constexpr float W8_SCALE = 32.f, W8_INV = 1.f / 32.f;
__device__ __forceinline__ unsigned pk4_fp8(float a, float b, float c, float d) { int r = __builtin_amdgcn_cvt_pk_fp8_f32(a, b, 0, false); r = __builtin_amdgcn_cvt_pk_fp8_f32(c, d, r, true); return (unsigned)r; }
template <int PART, class Src>
__device__ __forceinline__ void transpose_part_fp8(const Src& src, int K, int N, unsigned char* out, int item, int lane, f32x4 (&v)[16]) {
    const int nblk = N / 32, kb_ = item / nblk, nb = item % nblk, kb = lane >> 3, ch = lane & 7, k0 = 128 * kb_ + 16 * kb, n0 = 32 * nb + 4 * ch;
    if (PART != 1) {
#pragma unroll
        for (int j = 0; j < 16; ++j) v[j] = src.load4(k0 + j, n0); }
    if (PART != 0) {
#pragma unroll
        for (int c = 0; c < 4; ++c) {
            u32x4 o; o.x = pk4_fp8(v[0][c], v[1][c], v[2][c], v[3][c]); o.y = pk4_fp8(v[4][c], v[5][c], v[6][c], v[7][c]); o.z = pk4_fp8(v[8][c], v[9][c], v[10][c], v[11][c]); o.w = pk4_fp8(v[12][c], v[13][c], v[14][c], v[15][c]);
            *(u32x4*)(out + (size_t)(n0 + c) * K + k0) = o; } }
}
template <class Src>
__device__ __forceinline__ void transpose_item_fp8(const Src& src, int K, int N, unsigned char* out, int item, int lane) { f32x4 v[16]; transpose_part_fp8<2>(src, K, N, out, item, lane, v); }
struct Src13F8 { const float* w1; const float* w3; const float* g; __device__ __forceinline__ f32x4 load4(int k, int pc) const {
    const int hcol = ((pc >> 8) << 7) + (((pc >> 5) & 3) << 5) + (((pc >> 3) & 3) << 3) + (((pc >> 7) & 1) << 2); const long d13 = (long)(w3 - w1) * (long)((pc >> 2) & 1);
    return __builtin_nontemporal_load((const f32x4*)(w1 + d13 + (size_t)k * 512 + hcol)) * (g[k] * W8_SCALE); } };
struct SrcPgF8 { const float* w; const float* g; __device__ __forceinline__ f32x4 load4(int k, int n) const { return *(const f32x4*)(w + (size_t)k * 1024 + n) * (g[k] * W8_SCALE); } };
struct SrcPlainF8 { const float* w; int ldw; __device__ __forceinline__ f32x4 load4(int k, int n) const { return __builtin_nontemporal_load((const f32x4*)(w + (size_t)k * ldw + n)) * W8_SCALE; } };
#if MOE_FP8
constexpr int IT_IN = 16 * 48, IT_UQ = 4 * 24, IT_UKV = 4 * 32, IT_PLE = 4 * 32, IT_OUT = 16 * 32, IT_PG = 8 * 32, IT_13 = 8 * 32, IT_2 = 4 * 32;
#else
constexpr int IT_IN = 16 * 48, IT_UQ = 4 * 24, IT_UKV = 4 * 32, IT_PLE = 4 * 32, IT_OUT = 16 * 32, IT_PG = 16 * 32, IT_13 = 16 * 32, IT_2 = 8 * 32;
#endif
constexpr int IT_SMALL = IT_IN + IT_UQ + IT_UKV + IT_PLE + IT_OUT + IT_PG;
constexpr int IT_TOTAL = IT_SMALL + 32 * IT_13 + 32 * IT_2;
__device__ __forceinline__ void convert_item(const LayerW& L, unsigned char* ws, int it, float* scr, int lane) {
    int r = it;
    if (r < IT_IN) { transpose_item(SrcIn{L.w_in, L.g_mix}, 1024, NPROJ, (bf16_t*)(ws + W_IN), scr, r, lane); return; } r -= IT_IN;
    if (r < IT_UQ) { transpose_item(SrcUq{L.w_uq, L.g_cq}, 256, 768, (bf16_t*)(ws + W_UQ), scr, r, lane); return; } r -= IT_UQ;
    if (r < IT_UKV) { transpose_item(SrcUkv{L.w_ukv, L.g_ckv}, 256, 1024, (bf16_t*)(ws + W_UKV), scr, r, lane); return; } r -= IT_UKV;
    if (r < IT_PLE) { transpose_item(SrcPlain{L.w_ple, 1024}, 256, 1024, (bf16_t*)(ws + W_PLE), scr, r, lane); return; } r -= IT_PLE;
    if (r < IT_OUT) { transpose_item(SrcOut{L.w_out, L.g_oa, L.g_om}, 1024, 1024, (bf16_t*)(ws + W_OUT), scr, r, lane); return; } r -= IT_OUT;
#if MOE_FP8
    if (r < IT_PG) { transpose_item_fp8(SrcPgF8{L.w_pg, L.g_ple}, 1024, 1024, ws + W_PG, r, lane); return; } r -= IT_PG;
#else
    if (r < IT_PG) { transpose_item(SrcPg{L.w_pg, L.g_ple}, 1024, 1024, (bf16_t*)(ws + W_PG), scr, r, lane); return; } r -= IT_PG;
#endif
#if MOE_FP8
    if (r < 32 * IT_13) { const int e = r / IT_13; transpose_item_fp8(Src13F8{L.w1 + (size_t)e * 1024 * 512, L.w3 + (size_t)e * 1024 * 512, L.g_ffn}, 1024, 1024, ws + W_13 + (size_t)e * 1024 * 1024, r % IT_13, lane); return; } r -= 32 * IT_13;
    { const int e = r / IT_2; transpose_item_fp8(SrcPlainF8{L.w2 + (size_t)e * 512 * 1024, 1024}, 512, 1024, ws + W_2 + (size_t)e * 1024 * 512, r % IT_2, lane); }
#else
    if (r < 32 * IT_13) { const int e = r / IT_13; transpose_item(Src13{L.w1 + (size_t)e * 1024 * 512, L.w3 + (size_t)e * 1024 * 512, L.g_ffn}, 1024, 1024, (bf16_t*)(ws + W_13) + (size_t)e * 1024 * 1024, scr, r % IT_13, lane); return; } r -= 32 * IT_13;
    { const int e = r / IT_2; transpose_item(SrcPlain{L.w2 + (size_t)e * 512 * 1024, 1024}, 512, 1024, (bf16_t*)(ws + W_2) + (size_t)e * 1024 * 512, scr, r % IT_2, lane); }
#endif
}
#if MOE_FP8
constexpr int IT_MOE = 32 * IT_13 + 32 * IT_2;
template <int PART>
__device__ __forceinline__ void convert_part_moe(const float* w1, const float* w3, const float* w2, const float* g_ffn, unsigned char* ws, int it, int lane, f32x4 (&v)[16]) {
    if (it < 32 * IT_13) { const int e = it / IT_13; transpose_part_fp8<PART>(Src13F8{w1 + (size_t)e * 1024 * 512, w3 + (size_t)e * 1024 * 512, g_ffn}, 1024, 1024, ws + W_13 + (size_t)e * 1024 * 1024, it % IT_13, lane, v); }
    else { const int r = it - 32 * IT_13, e = r / IT_2; transpose_part_fp8<PART>(SrcPlainF8{w2 + (size_t)e * 512 * 1024, 1024}, 512, 1024, ws + W_2 + (size_t)e * 1024 * 512, r % IT_2, lane, v); }
}
#endif
__device__ __forceinline__ void convert_small(const LayerW& L, unsigned char* ws, int gtid, int gthreads) {
    bf16_t* hi = (bf16_t*)(ws + W_R); bf16_t* lo = hi + 64 * 1024;
    for (int i = gtid; i < 64 * 1024; i += gthreads) {
        const int n = i >> 10, k = i & 1023; float w = 0.f;
        if (n < 4) w = L.g_ffn[k] * L.w_rg[k * 4 + n]; else if (n < 36) w = L.g_ffn[k] * L.w_re[k * 32 + (n - 4)];
        const bf16_t h = f2bf(w); hi[i] = h; lo[i] = f2bf(w - bf2f(h));
    }
    bf16_t* wsb = (bf16_t*)(ws + W_S);
    for (int i = gtid; i < 8 * 128 * 128; i += gthreads) { const int t = (i >> 7) & 127, j = i & 127; wsb[i] = (t < 64 && j >= 64) ? (bf16_t)0 : f2bf(L.w_s[i]); }
}
__global__ void __launch_bounds__(256) k_convert(LayerW L, unsigned char* ws) {
    __shared__ float scr[4][64 * 33];
    const int lane = threadIdx.x & 63, w = threadIdx.x >> 6, gw = blockIdx.x * 4 + w, ngw = gridDim.x * 4;
    for (int it = gw; it < IT_TOTAL; it += ngw) convert_item(L, ws, it, scr[w], lane);
    convert_small(L, ws, blockIdx.x * 256 + threadIdx.x, gridDim.x * 256);
}

__global__ void __launch_bounds__(256) k_prologue(const float* x, const float* p, unsigned char* ws) {
    const int lane = threadIdx.x & 63, gw = (blockIdx.x * 256 + threadIdx.x) >> 6, ngw = gridDim.x * 4;
    bf16_t* X0 = (bf16_t*)(ws + WS_X0); float* ssqh = (float*)(ws + Z_SSQ) + (size_t)12 * T;
    for (int m = gw; m < T; m += ngw) {
        const f32x4* xr = (const f32x4*)(x + (size_t)m * D) + lane; float s = 0.f;
        u32x2* o = (u32x2*)(X0 + (size_t)m * D) + lane;
#pragma unroll
        for (int j = 0; j < 4; ++j) { const f32x4 v = xr[64 * j]; s += v.x * v.x + v.y * v.y + v.z * v.z + v.w * v.w; u32x2 w; w.x = pk2(v.x, v.y); w.y = pk2(v.z, v.w); o[64 * j] = w; }
        s = wave_sum(s); if (lane == 0) ssqh[m] = s;
        if (lane < 16) ((float*)(ws + WS_SSQHP))[(size_t)lane * T + m] = lane == 0 ? s : 0.f;
    }
    bf16_t* pb = (bf16_t*)(ws + WS_PB);
    const size_t n4 = (size_t)NL * T * 256 / 4, gt = (size_t)blockIdx.x * 256 + threadIdx.x, ngt = (size_t)gridDim.x * 256;
    for (size_t i = gt; i < n4; i += ngt) { const f32x4 v = ((const f32x4*)p)[i]; u32x2 w; w.x = pk2(v.x, v.y); w.y = pk2(v.z, v.w); ((u32x2*)pb)[i] = w; }
    float* rope = (float*)(ws + S_ROPE);
    for (size_t i = gt; i < 2048 * 16; i += ngt) {
        const int pos = (int)(i >> 4), k = (int)(i & 15);
        const double inv = exp(-(double)(2 * k) / 32.0 * log(10000.0)), ang = (double)pos * inv;
        rope[2 * i] = (float)cos(ang); rope[2 * i + 1] = (float)sin(ang);
    }
}

__global__ void __launch_bounds__(256) k_ngemm(const bf16_t* A, int lda, const int* gidx, const bf16_t* Bt, int ldb, const int* bsel, size_t bstride, float* C, int ldc, int K, const int* mlimit) {
    const int lane = threadIdx.x & 63, w = threadIdx.x >> 6, fr = lane & 15, fq = lane >> 4;
    const int row0 = blockIdx.y * 128 + (w >> 1) * 64, col0 = blockIdx.x * 128 + (w & 1) * 64;
    if (mlimit && blockIdx.y * 128 >= *mlimit) return;
    if (bsel) Bt += (size_t)bsel[blockIdx.y] * bstride;
    const bf16_t* ap[4]; const bf16_t* bp[4];
#pragma unroll
    for (int i = 0; i < 4; ++i) { const int r = row0 + 16 * i + fr; ap[i] = A + (size_t)(gidx ? gidx[r] : r) * lda + 8 * fq; bp[i] = Bt + (size_t)(col0 + 16 * i + fr) * ldb + 8 * fq; }
    f32x4 acc[4][4];
#pragma unroll
    for (int i = 0; i < 4; ++i)
#pragma unroll
        for (int j = 0; j < 4; ++j) acc[i][j] = (f32x4){0.f, 0.f, 0.f, 0.f};
    for (int k0 = 0; k0 < K; k0 += 32) {
        bf16x8 a[4], b[4];
#pragma unroll
        for (int i = 0; i < 4; ++i) { a[i] = *(const bf16x8*)(ap[i] + k0); b[i] = *(const bf16x8*)(bp[i] + k0); }
#pragma unroll
        for (int i = 0; i < 4; ++i)
#pragma unroll
            for (int j = 0; j < 4; ++j) acc[i][j] = __builtin_amdgcn_mfma_f32_16x16x32_bf16(b[j], a[i], acc[i][j], 0, 0, 0);
    }
#pragma unroll
    for (int i = 0; i < 4; ++i)
#pragma unroll
        for (int j = 0; j < 4; ++j) *(f32x4*)(C + (size_t)(row0 + 16 * i + fr) * ldc + col0 + 16 * j + 4 * fq) = acc[i][j];
}

__global__ void __launch_bounds__(256) k_post1(const float* scr, unsigned char* ws, int layer, const float* g_v) {
    const int lane = threadIdx.x & 63, row = (blockIdx.x * 256 + threadIdx.x) >> 6;
    const float* ssq = (const float*)(ws + Z_SSQ);
    const float rstd = rsqrtf(ssq[(size_t)(12 + layer) * T + row] * (1.f / 1024.f) + EPS);
    const float* s = scr + (size_t)row * NPROJ;
    bf16_t* cq = (bf16_t*)(ws + WS_CQ) + (size_t)row * 256; bf16_t* ckv = (bf16_t*)(ws + WS_CKV) + (size_t)row * 256;
    bf16_t* u = (bf16_t*)(ws + WS_U) + (size_t)row * 512; bf16_t* v = (bf16_t*)(ws + WS_V) + (size_t)row * 512;
    float a = 0.f, b = 0.f, c = 0.f;
    for (int i = lane; i < 256; i += 64) { const float x = s[i] * rstd; cq[i] = f2bf(x); a += x * x; }
    for (int i = lane; i < 256; i += 64) { const float x = s[256 + i] * rstd; ckv[i] = f2bf(x); if (i < 128) b += x * x; else if (i < 160) c += x * x; }
    a = wave_sum(a); b = wave_sum(b); c = wave_sum(c);
    if (lane == 0) { ((float*)(ws + Z_SSQ))[(size_t)(0 + layer) * T + row] = a; ((float*)(ws + Z_SSQ))[(size_t)(4 + layer) * T + row] = b; ((float*)(ws + S_SSQKR))[row] = c; }
    for (int i = lane; i < 512; i += 64) u[i] = f2bf(gelu_tanh(s[512 + i] * rstd));
    for (int g = 0; g < 8; ++g) {
        const int lc = 64 * g + lane;
        const int tv = lc >> 8, wc = (lc & 255) >> 6, bj = (lc & 63) >> 5, x = lc & 31, pc = 1024 + 256 * tv + 128 * bj + 32 * wc + x;
        const float val = gelu_tanh(s[pc] * rstd); const float q = wave_sum(val * val);
        v[lc] = f2bf(val * rsqrtf(q * (1.f / 64.f) + EPS) * g_v[g * 64 + lane]);
    }
}
__global__ void __launch_bounds__(256) k_post2a(const float* scr, unsigned char* ws, int layer) {
    const size_t i = (size_t)blockIdx.x * 256 + threadIdx.x; const int row = (int)(i / 768);
    const float rs = rsqrtf(((const float*)(ws + Z_SSQ))[(size_t)layer * T + row] * (1.f / 256.f) + EPS);
    ((bf16_t*)(ws + WS_Q))[i] = f2bf(scr[i] * rs);
}
__global__ void __launch_bounds__(256) k_post2b(const float* scr, unsigned char* ws, int layer, const float* g_kn) {
    const int lane = threadIdx.x & 63, gw = (blockIdx.x * 256 + threadIdx.x) >> 6, row = gw >> 3, h = gw & 7;
    const float rckv = rsqrtf(((const float*)(ws + Z_SSQ))[(size_t)(4 + layer) * T + row] * (1.f / 128.f) + EPS);
    const float ssqkr = ((const float*)(ws + S_SSQKR))[row];
    const int t = h >> 1, bj = lane >> 5, x = lane & 31;
    const float kn = scr[(size_t)row * 1024 + 256 * t + 128 * bj + 32 * (2 * (h & 1) + 0) + x] * rckv;
    const float vv = scr[(size_t)row * 1024 + 256 * t + 128 * bj + 32 * (2 * (h & 1) + 1) + x] * rckv;
    const float sk = wave_sum(kn * kn);
    const float rk = rsqrtf((sk + ssqkr) * (1.f / 96.f) + EPS);
    bf16_t* Kf = (bf16_t*)(ws + WS_K) + (size_t)row * 768 + h * 96; bf16_t* Vf = (bf16_t*)(ws + WS_VF) + (size_t)row * 512 + h * 64;
    Kf[lane] = f2bf(kn * rk * g_kn[lane]); Vf[lane] = f2bf(vv);
    if (lane < 16) {
        const bf16_t* kr = (const bf16_t*)(ws + WS_CKV) + (size_t)row * 256 + 128; const float* rope = (const float*)(ws + S_ROPE) + ((size_t)(row & 2047) * 16 + lane) * 2;
        const float x1 = bf2f(kr[lane]) * rk * g_kn[64 + lane], x2 = bf2f(kr[16 + lane]) * rk * g_kn[80 + lane], cs = rope[0], sn = rope[1];
        Kf[64 + lane] = f2bf(x1 * cs - x2 * sn); Kf[80 + lane] = f2bf(x2 * cs + x1 * sn);
    }
}
__global__ void __launch_bounds__(256) k_gmlp(unsigned char* ws, const float* b_s) {
    const size_t i = (size_t)blockIdx.x * 256 + threadIdx.x; const int tok = (int)(i >> 9), col = (int)(i & 511), g = col >> 6, t = tok & 127, blk = tok >> 7;
    const bf16_t* wsb = (const bf16_t*)(ws + W_S) + ((size_t)g * 128 + t) * 128; const bf16_t* v = (const bf16_t*)(ws + WS_V) + (size_t)blk * 128 * 512 + col;
    float s = 0.f;
    for (int j = 0; j < 128; ++j) s += bf2f(wsb[j]) * bf2f(v[(size_t)j * 512]);
    s += b_s[g * 128 + t];
    ((bf16_t*)(ws + WS_AM))[(size_t)tok * 1024 + 512 + col] = f2bf(bf2f(((const bf16_t*)(ws + WS_U))[i]) * s);
}
__global__ void __launch_bounds__(256) k_rowstat_am(unsigned char* ws, int layer, int mode) {
    const int lane = threadIdx.x & 63, row = (blockIdx.x * 256 + threadIdx.x) >> 6;
    const bf16_t* p = (const bf16_t*)(ws + WS_AM) + (size_t)row * 1024 + (mode ? 512 : 0); float s = 0.f;
    for (int i = lane; i < 512; i += 64) { const float x = bf2f(p[i]); s += x * x; }
    s = wave_sum(s);
    if (lane == 0) { if (mode) ((float*)(ws + S_RSTDM))[row] = rsqrtf(s * (1.f / 512.f) + EPS); else ((float*)(ws + Z_SSQ))[(size_t)(8 + layer) * T + row] = s; }
    if (!mode && lane < 8) ((float*)(ws + WS_SSQAP))[(size_t)lane * T + row] = lane == 0 ? s : 0.f;
}
__global__ void __launch_bounds__(256) k_norm_m(unsigned char* ws) {
    const size_t i = (size_t)blockIdx.x * 256 + threadIdx.x; const int row = (int)(i >> 9), c = (int)(i & 511);
    bf16_t* p = (bf16_t*)(ws + WS_AM) + (size_t)row * 1024 + 512 + c; *p = f2bf(bf2f(*p) * ((const float*)(ws + S_RSTDM))[row]);
}
__global__ void __launch_bounds__(256) k_tobf16(const float* scr, bf16_t* out) { const size_t i = (size_t)blockIdx.x * 256 + threadIdx.x; out[i] = f2bf(scr[i]); }
__global__ void __launch_bounds__(64) k_attn(unsigned char* ws, const float* g_qn) {
    const int t = (blockIdx.x & 31) * 64 + threadIdx.x, bh = blockIdx.x >> 5, h = bh & 7, b = bh >> 3, row = b * 2048 + t;
    const bf16_t* qr = (const bf16_t*)(ws + WS_Q) + (size_t)row * 768 + h * 96;
    float q[96]; float ss = 0.f;
#pragma unroll
    for (int d = 0; d < 96; ++d) { q[d] = bf2f(qr[d]); ss += q[d] * q[d]; }
    const float rq = rsqrtf(ss * (1.f / 96.f) + EPS);
#pragma unroll
    for (int d = 0; d < 96; ++d) q[d] = q[d] * rq * g_qn[d];
    const float* rope = (const float*)(ws + S_ROPE) + (size_t)t * 32;
#pragma unroll
    for (int i = 0; i < 16; ++i) { const float cs = rope[2 * i], sn = rope[2 * i + 1], x1 = q[64 + i], x2 = q[80 + i]; q[64 + i] = x1 * cs - x2 * sn; q[80 + i] = x2 * cs + x1 * sn; }
#pragma unroll
    for (int d = 0; d < 96; ++d) q[d] *= SM_SCALE;
    float o[64];
#pragma unroll
    for (int d = 0; d < 64; ++d) o[d] = 0.f;
    float m = -1e30f, l = 0.f;
    const int nk = ((t >> 6) + 1) * 64;
    const bf16_t* Kb = (const bf16_t*)(ws + WS_K) + (size_t)(b * 2048) * 768 + h * 96; const bf16_t* Vb = (const bf16_t*)(ws + WS_VF) + (size_t)(b * 2048) * 512 + h * 64;
    for (int j = 0; j < nk; ++j) {
        const bf16_t* kr = Kb + (size_t)j * 768; float s = 0.f;
#pragma unroll
        for (int d = 0; d < 96; ++d) s += q[d] * bf2f(kr[d]);
        const float mn = fmaxf(m, s), f = __expf(m - mn), pp = __expf(s - mn);
        l = l * f + pp; m = mn;
        const bf16_t* vr = Vb + (size_t)j * 512;
#pragma unroll
        for (int d = 0; d < 64; ++d) o[d] = o[d] * f + pp * bf2f(vr[d]);
    }
    const float il = 1.f / l; bf16_t* out = (bf16_t*)(ws + WS_AM) + (size_t)row * 1024 + h * 64;
#pragma unroll
    for (int d = 0; d < 64; ++d) out[d] = f2bf(o[d] * il);
}
__global__ void __launch_bounds__(256) k_post4(const float* scr, unsigned char* ws, int layer, const bf16_t* Xin, bf16_t* Xout) {
    const size_t i = (size_t)blockIdx.x * 256 + threadIdx.x; const int row = (int)(i >> 10);
    const float ra = rsqrtf(((const float*)(ws + Z_SSQ))[(size_t)(8 + layer) * T + row] * (1.f / 512.f) + EPS);
    Xout[i] = f2bf(bf2f(Xin[i]) + ra * scr[i] + scr[(size_t)T * 1024 + i]);
}
__global__ void __launch_bounds__(256) k_router(unsigned char* ws, int layer, const bf16_t* X) {
    const int lane = threadIdx.x & 63, tok = (blockIdx.x * 256 + threadIdx.x) >> 6;
    const bf16_t* xr = X + (size_t)tok * 1024; const bf16_t* hi = (const bf16_t*)(ws + W_R); const bf16_t* lo = hi + 64 * 1024;
    float xv[16]; float ss = 0.f;
#pragma unroll
    for (int j = 0; j < 16; ++j) { xv[j] = bf2f(xr[lane + 64 * j]); ss += xv[j] * xv[j]; }
    ss = wave_sum(ss); const float rstd = rsqrtf(ss * (1.f / 1024.f) + EPS);
    float lg[36];
#pragma unroll
    for (int n = 0; n < 36; ++n) { float s = 0.f;
#pragma unroll
        for (int j = 0; j < 16; ++j) s += xv[j] * (bf2f(hi[n * 1024 + lane + 64 * j]) + bf2f(lo[n * 1024 + lane + 64 * j]));
        lg[n] = wave_sum(s) * rstd; }
    if (lane == 0) {
        int gs = 0; float gm = lg[0];
#pragma unroll
        for (int g = 1; g < 4; ++g) if (lg[g] > gm) { gm = lg[g]; gs = g; }
        float den = 0.f;
#pragma unroll
        for (int g = 0; g < 4; ++g) den += __expf(lg[g] - gm);
        const float psel = 1.f / den;
        float le[8];
#pragma unroll
        for (int i = 0; i < 8; ++i) le[i] = gs == 0 ? lg[4 + i] : gs == 1 ? lg[12 + i] : gs == 2 ? lg[20 + i] : lg[28 + i];
        int i0 = 0; float v0 = le[0];
#pragma unroll
        for (int i = 1; i < 8; ++i) if (le[i] > v0) { v0 = le[i]; i0 = i; }
        int i1 = -1; float v1 = -3.0e38f;
#pragma unroll
        for (int i = 0; i < 8; ++i) if (i != i0 && le[i] > v1) { v1 = le[i]; i1 = i; }
        const float e1 = __expf(v1 - v0), g0 = psel / (1.f + e1), g1 = psel * e1 / (1.f + e1);
        int* cnt = (int*)(ws + Z_CNT) + layer * 64; int* stok = (int*)(ws + S_SLOTTOK); float* srs = (float*)(ws + S_SLOTRSTD); float* sg = (float*)(ws + S_SLOTGATE);
        const int ea = gs * 8 + i0, eb = gs * 8 + i1;
        const int pa = atomicAdd(cnt + ea, 1), pb = atomicAdd(cnt + eb, 1);
        stok[(size_t)ea * T + pa] = tok; srs[(size_t)ea * T + pa] = rstd; sg[(size_t)ea * T + pa] = g0;
        stok[(size_t)eb * T + pb] = tok | (1 << 30); srs[(size_t)eb * T + pb] = rstd; sg[(size_t)eb * T + pb] = g1;
    }
}
__global__ void __launch_bounds__(256) k_build(unsigned char* ws, int layer) {
    __shared__ int pbase[33], cnts[32];
    const int* cnt = (const int*)(ws + Z_CNT) + layer * 64;
    if (threadIdx.x == 0) { int b = 0; for (int e = 0; e < 32; ++e) { cnts[e] = cnt[e]; pbase[e] = b; b += (cnt[e] + 255) / 256 * 256; } pbase[32] = b; }
    __syncthreads();
    int* gidx = (int*)(ws + S_FLAT); float* fgate = (float*)(gidx + MAXSLOT); float* frstd = fgate + MAXSLOT; int* tile_e = (int*)(frstd + MAXSLOT); int* ftok = tile_e + MAXSLOT / 128; int* nrows = ftok + MAXSLOT;
    const int* stok = (const int*)(ws + S_SLOTTOK); const float* srs = (const float*)(ws + S_SLOTRSTD); const float* sg = (const float*)(ws + S_SLOTGATE);
    if (threadIdx.x == 0) nrows[0] = pbase[32];
    for (int e = 0; e < 32; ++e) {
        const int n = pbase[e + 1] - pbase[e];
        for (int i = threadIdx.x; i < n; i += 256) {
            const int s = pbase[e] + i; const bool ok = i < cnts[e];
            const int tk = ok ? stok[(size_t)e * T + i] : -1;
            gidx[s] = ok ? (tk & 0x3fffffff) : 0; ftok[s] = tk; fgate[s] = ok ? sg[(size_t)e * T + i] : 0.f; frstd[s] = ok ? srs[(size_t)e * T + i] : 0.f;
            if ((i & 127) == 0) tile_e[s >> 7] = e;
        }
    }
}
__global__ void __launch_bounds__(256) k_post6(const float* scr, unsigned char* ws) {
    const int* gidx = (const int*)(ws + S_FLAT); const float* frstd = (const float*)(gidx + 2 * MAXSLOT); const int* nrows = gidx + 3 * MAXSLOT + MAXSLOT / 128 + MAXSLOT;
    const size_t i = (size_t)blockIdx.x * 256 + threadIdx.x; const int slot = (int)(i >> 9), j = (int)(i & 511);
    if (slot >= nrows[0]) return;
    const float rs = frstd[slot]; const float* s = scr + (size_t)slot * 1024 + 8 * (j >> 2) + (j & 3);
    ((bf16_t*)(ws + WS_H))[i] = f2bf(silu_f(rs * s[0]) * (rs * s[4]));
}
__global__ void __launch_bounds__(256) k_post7(const float* scr, unsigned char* ws, const bf16_t* X1) {
    const int* gidx = (const int*)(ws + S_FLAT); const float* fgate = (const float*)(gidx + MAXSLOT); const int* ftok = gidx + 3 * MAXSLOT + MAXSLOT / 128; const int* nrows = ftok + MAXSLOT;
    const size_t i = (size_t)blockIdx.x * 256 + threadIdx.x; const int slot = (int)(i >> 10), n = (int)(i & 1023);
    if (slot >= nrows[0]) return;
    const int tk = ftok[slot]; if (tk < 0) return;
    const int tok = tk & 0x3fffffff, k = tk >> 30;
    const float v = fgate[slot] * scr[i];
    if (k == 0) ((bf16_t*)(ws + WS_Y0))[(size_t)tok * 1024 + n] = f2bf(bf2f(X1[(size_t)tok * 1024 + n]) + v);
    else ((bf16_t*)(ws + WS_Y1))[(size_t)tok * 1024 + n] = f2bf(v);
}
__global__ void __launch_bounds__(256) k_combine(unsigned char* ws, bf16_t* Xout) {
    const int lane = threadIdx.x & 63, row = (blockIdx.x * 256 + threadIdx.x) >> 6;
    const bf16_t* y0 = (const bf16_t*)(ws + WS_Y0) + (size_t)row * 1024; const bf16_t* y1 = (const bf16_t*)(ws + WS_Y1) + (size_t)row * 1024; float s = 0.f;
    for (int i = lane; i < 1024; i += 64) { const float v = bf2f(y0[i]) + bf2f(y1[i]); const bf16_t r = f2bf(v); Xout[(size_t)row * 1024 + i] = r; const float vr = bf2f(r); s += vr * vr; }
    s = wave_sum(s); if (lane == 0) ((float*)(ws + S_RSTD2))[row] = rsqrtf(s * (1.f / 1024.f) + EPS);
}
__global__ void __launch_bounds__(256) k_post9(const float* scr, unsigned char* ws, int layer, const bf16_t* Xin, bf16_t* Xout, float* fout, const float* b_pg) {
    const int lane = threadIdx.x & 63, row = (blockIdx.x * 256 + threadIdx.x) >> 6;
    const float rs = ((const float*)(ws + S_RSTD2))[row]; const bf16_t* e = (const bf16_t*)(ws + WS_E) + (size_t)row * 1024; float s = 0.f;
    for (int i = lane; i < 1024; i += 64) {
        const size_t o = (size_t)row * 1024 + i;
        const float v = bf2f(Xin[o]) + bf2f(e[i]) * sigmoid_f(rs * scr[o] + b_pg[i]);
        Xout[o] = f2bf(v); if (fout) fout[o] = v; s += v * v;
    }
    s = wave_sum(s); if (lane == 0) ((float*)(ws + Z_SSQ))[(size_t)(12 + layer + 1) * T + row] = s;
    if (lane < 16) ((float*)(ws + WS_SSQHP))[(size_t)lane * T + row] = lane == 0 ? s : 0.f;
}

#define LAS __attribute__((address_space(3)))
#define FILL_LAYERW(L, LF) \
            L.g_mix = LF(2, 1024); L.w_in = LF(3, 1024 * 1440); L.g_cq = LF(4, 256); L.g_ckv = LF(5, 128); L.w_uq = LF(6, 256 * 768); L.w_ukv = LF(7, 128 * 1024); \
            L.g_qn = LF(8, 96); L.g_kn = LF(9, 96); L.g_v = LF(10, 512); L.w_s = LF(11, 8 * 128 * 128); L.b_s = LF(12, 8 * 128); L.g_oa = LF(13, 512); L.g_om = LF(14, 512); \
            L.w_out = LF(15, 1024 * 1024); L.g_ffn = LF(16, 1024); L.w_rg = LF(17, 1024 * 4); L.w_re = LF(18, 1024 * 32); \
            L.w1 = LF(19, (size_t)32 * 1024 * 512); L.w3 = LF(20, (size_t)32 * 1024 * 512); L.w2 = LF(21, (size_t)32 * 512 * 1024); \
            L.g_ple = LF(22, 1024); L.w_pg = LF(23, 1024 * 1024); L.b_pg = LF(24, 1024); L.w_ple = LF(25, 256 * 1024);
typedef float f32x16 __attribute__((ext_vector_type(16)));
typedef short v4i16_t __attribute__((ext_vector_type(4)));
constexpr int NWAVES = 8, NTHREADS = 512;
constexpr int BM = 256, BK = 64, HALF = 128, HTB = HALF * BK * 2, NXCD = 8, WGM = 8;
constexpr int RING_BYTES = 131072, MAXU = 5;
constexpr int TABF_OFF = RING_BYTES, TABI_OFF = TABF_OFF + MAXU * 1024, TABG_OFF = TABI_OFF + MAXU * 1024;
constexpr int MISC_OFF = TABG_OFF + MAXU * 1024;
constexpr int LDS_BYTES = 155648;
constexpr int PTR_OFF = MISC_OFF + 1792;
static_assert(MISC_OFF + 384 + 320 * 4 <= PTR_OFF && PTR_OFF + 26 * 8 <= LDS_BYTES, "LDS map");
#define GAS __attribute__((address_space(1)))
__device__ __forceinline__ const float* lds_inptr(const LAS unsigned long long* tab, int i) {
    const unsigned long long v = tab[i]; const unsigned lo = __builtin_amdgcn_readfirstlane((unsigned)v), hi = __builtin_amdgcn_readfirstlane((unsigned)(v >> 32));
    return (const float*)(const GAS float*)(((unsigned long long)hi << 32) | lo);
}

__host__ __device__ __forceinline__ int lds_byte(int r, int c) { const int st = (r >> 4) * 2 + (c >> 5), rr = r & 15, cc = c & 31, ob = rr * 64 + cc * 2; return st * 1024 + (ob ^ (((ob >> 9) & 1) << 5)); }
__host__ __device__ __forceinline__ void stage_rc(int b, int& R, int& C) { const int st = b / 1024, sb = b % 1024, swz = sb ^ (((sb >> 9) & 1) << 5); R = (st >> 1) * 16 + swz / 64; C = (st & 1) * 32 + (swz % 64) / 2; }
__host__ __device__ __forceinline__ int perm32(int rho) { const int n = rho >> 4, i = rho & 15; return 8 * (i >> 2) + 4 * n + (i & 3); }
typedef float f32x2_t __attribute__((ext_vector_type(2))); typedef __bf16 bf16x2_t __attribute__((ext_vector_type(2)));
__device__ __forceinline__ unsigned cvt_pk_bf16(float lo, float hi) { f32x2_t v = {lo, hi}; bf16x2_t b = __builtin_convertvector(v, bf16x2_t); return __builtin_bit_cast(unsigned, b); }
__device__ __forceinline__ u32x4 pack8(const f32x4 a, const f32x4 b) { u32x4 w; w.x = cvt_pk_bf16(a[0], a[1]); w.y = cvt_pk_bf16(a[2], a[3]); w.z = cvt_pk_bf16(b[0], b[1]); w.w = cvt_pk_bf16(b[2], b[3]); return w; }
__device__ __forceinline__ f32x4 unpack_lo(u32x2 w) { return (f32x4){__uint_as_float(w.x << 16), __uint_as_float(w.x & 0xffff0000u), __uint_as_float(w.y << 16), __uint_as_float(w.y & 0xffff0000u)}; }
__device__ __forceinline__ f32x4 unpack_fp8x4(unsigned w) { typedef float f2 __attribute__((ext_vector_type(2))); const f2 lo = __builtin_amdgcn_cvt_pk_f32_fp8((int)w, false), hi = __builtin_amdgcn_cvt_pk_f32_fp8((int)w, true); return (f32x4){lo[0], lo[1], hi[0], hi[1]}; }
__device__ __forceinline__ float red4(float s) { s += __shfl_xor(s, 16); s += __shfl_xor(s, 32); return s; }
__device__ __forceinline__ float sq4(const f32x4 v) { return (v[0] * v[0] + v[1] * v[1]) + (v[2] * v[2] + v[3] * v[3]); }

__device__ __forceinline__ int opaque_v(int x) { asm volatile("" : "+v"(x)); return x; }
__device__ __forceinline__ int my_tid(int wv) { unsigned mk = ~0u; asm volatile("" : "+s"(mk)); return wv * 64 + (int)__builtin_amdgcn_mbcnt_hi(mk, __builtin_amdgcn_mbcnt_lo(mk, 0u)); }
struct Unit { int pm, pn, ti, e; };
struct SchedStatic {
    int nM, nN, nwg, G, c; const char* A; const char* B; size_t tstep;
    __device__ __forceinline__ void init(int M, int N, int K, int G_, int c_, const void* A_, const void* B_) { nM = M / BM; nN = N / BM; nwg = nM * nN; G = G_; c = c_; A = (const char*)A_; B = (const char*)B_; tstep = (size_t)BM * K * 2; }
    __device__ __forceinline__ bool next(int i, Unit& u) const {
        const long L = (long)i * G + c; if (L >= nwg) return false;
        int wgid = (int)L; { const int q = nwg / NXCD, r = nwg % NXCD, xcd = wgid % NXCD, off = wgid / NXCD; wgid = (xcd < r ? xcd * (q + 1) : r * (q + 1) + (xcd - r) * q) + off; }
        const int nig = WGM * nN, gid = wgid / nig, fm = gid * WGM, gsz = (nM - fm) < WGM ? (nM - fm) : WGM;
        u.pm = fm + ((wgid % nig) % gsz); u.pn = (wgid % nig) / gsz; u.ti = i; u.e = 0; return true;
    }
    __device__ __forceinline__ const char* aptr(const Unit& u) const { return A + (size_t)u.pm * tstep; }
    __device__ __forceinline__ const char* bptr(const Unit& u) const { return B + (size_t)u.pn * tstep; }
};
struct SchedE : SchedStatic {
    __device__ __forceinline__ bool next(int i, Unit& u) const {
        if ((G & 7) != 0 || G != 256) return SchedStatic::next(i, u);
        const int xcd = c & 7, rank = c >> 3, j = rank < 16 ? (i == 0 ? rank : -1) : (i < 3 ? 16 + (rank - 16) * 3 + i : -1);
        if (j < 0) return false;
        const int wgid = xcd * (nwg / NXCD) + j;
        const int nig = WGM * nN, gid = wgid / nig, fm = gid * WGM, gsz = (nM - fm) < WGM ? (nM - fm) : WGM;
        u.pm = fm + ((wgid % nig) % gsz); u.pn = (wgid % nig) / gsz; u.ti = i; u.e = 0; return true;
    }
};
struct SchedMoe {
    int ntiles, G, c; const LAS int* te; const char* A; const char* B; size_t astep, bestep, bnstep;
    __device__ __forceinline__ bool next(int i, Unit& u) const {
        int pm, pn;
        if ((G & 7) == 0) {
            const int x = c & 7, r = c >> 3, per = G >> 3, t0 = (ntiles * x) >> 3, t1 = (ntiles * (x + 1)) >> 3, j = i * per + r;
            if (j >= (t1 - t0) * 4) return false;
            pm = t0 + (j >> 2); pn = j & 3;
        } else { const int L = i * G + c; if (L >= ntiles * 4) return false; pm = L >> 2; pn = L & 3; }
        u.pm = pm; u.pn = pn; u.ti = i; u.e = __builtin_amdgcn_readfirstlane(te[pm]); return true;
    }
    __device__ __forceinline__ const char* aptr(const Unit& u) const { return A + (size_t)u.pm * astep; }
    __device__ __forceinline__ const char* bptr(const Unit& u) const { return B + (size_t)u.e * bestep + (size_t)u.pn * bnstep; }
};

typedef int i32x8 __attribute__((ext_vector_type(8)));
typedef int i32x4v __attribute__((ext_vector_type(4)));
template <class Epi, class Sched, bool GATHER, bool MIDK, bool FP8 = false>
__device__ __forceinline__ void gemm_phase(const int wv_, LAS unsigned char* lds, const int K, const Sched& S, const Epi& E, const LAS int* gtab) {
    const int tid = my_tid(wv_), wid = wv_, lane = tid & 63, wr = wid >> 2, wc = wid & 3, fr = lane & 15, fq = lane >> 4;
    const int nt = K / BK;
    const unsigned hstep = (unsigned)HALF * K * 2;
    unsigned vB[2], vAc[2][2];
#pragma unroll
    for (int i = 0; i < 2; ++i) { int R, C; stage_rc(tid * 16 + i * 8192, R, C); const int Rb = (R & ~31) + perm32(R & 31);
        vB[i] = (unsigned)(Rb * K + C) * 2u;
        vAc[0][i] = (unsigned)(R * K + C) * 2u; vAc[1][i] = vAc[0][i]; }
    const size_t hstepA = GATHER ? 0 : (size_t)hstep;
    const size_t kstep = (size_t)(BK * 2);
    const unsigned ldsw = (unsigned)wid * 1024u;
    const int aoff = lds_byte(wr * 64 + fr, fq * 8), boff = lds_byte(wc * 32 + fr, fq * 8);
#define G_SA(b, h) (((b) * 2 + (h)) * HTB)
#define G_SB(b, h) ((4 + (b) * 2 + (h)) * HTB)
#define G_STAGE_B(bufoff, h, ptr) do { _Pragma("unroll") for (int _i = 0; _i < 2; ++_i) \
        __builtin_amdgcn_global_load_lds((const unsigned*)((const char*)(ptr) + (size_t)(h) * hstep + (size_t)(unsigned)opaque_v((int)vB[_i])), (LAS unsigned*)(lds + (bufoff) + ldsw + _i * 8192), 16, 0, 0); } while (0)
#define G_STAGE_A(bufoff, h, ptr, NX) do { _Pragma("unroll") for (int _i = 0; _i < 2; ++_i) \
        __builtin_amdgcn_global_load_lds((const unsigned*)((const char*)(ptr) + (size_t)(h) * hstepA + (size_t)(unsigned)opaque_v((int)vAc[GATHER ? (h) : 0][_i])), (LAS unsigned*)(lds + (bufoff) + ldsw + _i * 8192), 16, 0, 0); } while (0)
#define G_LDA(dst, b, h) do { _Pragma("unroll") for (int m = 0; m < 4; ++m) _Pragma("unroll") for (int k = 0; k < 2; ++k) dst[m][k] = *(const LAS bf16x8*)(lds + G_SA(b, h) + aoff + m * 2048 + k * 1024); } while (0)
#define G_LDB(dst, b, h) do { _Pragma("unroll") for (int n = 0; n < 2; ++n) _Pragma("unroll") for (int k = 0; k < 2; ++k) dst[n][k] = *(const LAS bf16x8*)(lds + G_SB(b, h) + boff + n * 2048 + k * 1024); } while (0)
#define G_F8(F) __builtin_shufflevector(__builtin_bit_cast(i32x4v, F[0]), __builtin_bit_cast(i32x4v, F[1]), 0, 1, 2, 3, 4, 5, 6, 7)
#define G_MMA(ai, bj, At, Bt) do { __builtin_amdgcn_s_setprio(1); \
        if constexpr (FP8) { _Pragma("unroll") for (int m = 0; m < 4; ++m) _Pragma("unroll") for (int n = 0; n < 2; ++n) \
            acc[ai][bj][m][n] = __builtin_amdgcn_mfma_scale_f32_16x16x128_f8f6f4(G_F8(Bt[n]), G_F8(At[m]), acc[ai][bj][m][n], 0, 0, 0, 0, 0, 0); } \
        else { _Pragma("unroll") for (int m = 0; m < 4; ++m) _Pragma("unroll") for (int n = 0; n < 2; ++n) _Pragma("unroll") for (int k = 0; k < 2; ++k) \
            acc[ai][bj][m][n] = __builtin_amdgcn_mfma_f32_16x16x32_bf16(Bt[n][k], At[m][k], acc[ai][bj][m][n], 0, 0, 0); } \
        __builtin_amdgcn_s_setprio(0); } while (0)
#define G_WAIT_V(n) asm volatile("s_waitcnt vmcnt(" #n ")" ::: "memory")
#define G_WAIT_L(n) asm volatile("s_waitcnt lgkmcnt(" #n ")" ::: "memory")
#define G_BAR __builtin_amdgcn_s_barrier()
#define G_SCHED __builtin_amdgcn_sched_barrier(0)
#define G_LOADIDX(dst, u) do { if constexpr (GATHER) { _Pragma("unroll") for (int _h = 0; _h < 2; ++_h) _Pragma("unroll") for (int _i = 0; _i < 2; ++_i) { int R_, C_; stage_rc(tid * 16 + _i * 8192, R_, C_); \
        dst[_h][_i] = (unsigned)gtab[(u).ti * 256 + R_ + 128 * _h] * (unsigned)(K * 2) + (unsigned)C_ * 2u; } } } while (0)
    Unit cur, nxt; int ui = 0;
    if (!S.next(0, cur)) return;
    G_LOADIDX(vAc, cur);
    f32x4 acc[2][2][4][2];
#pragma unroll
    for (int a = 0; a < 2; ++a)
#pragma unroll
        for (int b = 0; b < 2; ++b)
#pragma unroll
            for (int m = 0; m < 4; ++m)
#pragma unroll
                for (int n = 0; n < 2; ++n) acc[a][b][m][n] = (f32x4){0.f, 0.f, 0.f, 0.f};
    bf16x8 At[4][2], B0[2][2], B1[2][2];
    const char* cA = S.aptr(cur); const char* cB = S.bptr(cur);
    G_STAGE_B(G_SB(0, 0), 0, cB); G_STAGE_B(G_SB(0, 1), 1, cB); G_STAGE_A(G_SA(0, 0), 0, cA, false); G_STAGE_A(G_SA(0, 1), 1, cA, false);
    if (wr == 1) G_BAR;
    G_WAIT_V(2); G_BAR;
    G_STAGE_B(G_SB(1, 0), 0, cB + kstep); G_STAGE_A(G_SA(1, 0), 0, cA + kstep, false); G_STAGE_B(G_SB(1, 1), 1, cB + kstep);
    G_WAIT_V(6); G_BAR;
    for (;;) {
        const bool has_next = S.next(ui + 1, nxt);
        const char* nA = has_next ? S.aptr(nxt) : cA; const char* nB = has_next ? S.bptr(nxt) : cB;
#pragma unroll 1
        for (int t = 0; t < nt; t += 2) {
            const bool last = (t == nt - 2);
            const char* a1 = cA + (size_t)(t + 1) * kstep;
            const char* a2 = last ? nA : cA + (size_t)(t + 2) * kstep; const char* b2 = last ? nB : cB + (size_t)(t + 2) * kstep;
            const char* a3 = a2 + kstep; const char* b3 = b2 + kstep;
            if constexpr (MIDK) { if (t == (nt >> 1)) { const int l2 = my_tid(wv_) & 63; E.midk(acc, cur, wr, l2 & 15); } }
            G_LDB(B0, 0, 0); G_LDB(B1, 0, 1); G_SCHED; G_LDA(At, 0, 0); G_STAGE_A(G_SA(1, 1), 1, a1, false);
            if constexpr (GATHER) { if (last && has_next) { G_LOADIDX(vAc, nxt); } }
            G_WAIT_V(8); G_WAIT_L(0); G_BAR; G_MMA(0, 0, At, B0); G_MMA(0, 1, At, B1); G_BAR; G_SCHED;
            G_LDA(At, 0, 1); G_STAGE_B(G_SB(0, 0), 0, b2); G_STAGE_B(G_SB(0, 1), 1, b2); G_STAGE_A(G_SA(0, 0), 0, a2, last);
            G_WAIT_V(8); G_WAIT_L(0); G_BAR; G_MMA(1, 0, At, B0); G_MMA(1, 1, At, B1); G_BAR; G_SCHED;
            G_LDB(B0, 1, 0); G_LDB(B1, 1, 1); G_SCHED; G_LDA(At, 1, 0); G_STAGE_A(G_SA(0, 1), 1, a2, last);
            G_WAIT_V(8); G_WAIT_L(0); G_BAR; G_MMA(0, 0, At, B0); G_MMA(0, 1, At, B1); G_BAR; G_SCHED;
            G_LDA(At, 1, 1); G_STAGE_B(G_SB(1, 0), 0, b3); G_STAGE_B(G_SB(1, 1), 1, b3); G_STAGE_A(G_SA(1, 0), 0, a3, last);
            G_WAIT_V(8); G_WAIT_L(0); G_BAR; G_MMA(1, 0, At, B0); G_MMA(1, 1, At, B1); G_BAR; G_SCHED;
        }
        if (wr == 0) G_BAR;
        { const int l2 = my_tid(wv_) & 63; E(acc, cur, wr, wc, l2 & 15, l2 >> 4); }
        if (!has_next) break;
#pragma unroll
        for (int a = 0; a < 2; ++a)
#pragma unroll
            for (int b = 0; b < 2; ++b)
#pragma unroll
                for (int m = 0; m < 4; ++m)
#pragma unroll
                    for (int n = 0; n < 2; ++n) acc[a][b][m][n] = (f32x4){0.f, 0.f, 0.f, 0.f};
        cur = nxt; cA = nA; cB = nB; ++ui;
        if (wr == 1) G_BAR;
    }
    G_WAIT_V(0);
    G_BAR;
#undef G_SA
#undef G_SB
#undef G_STAGE_A
#undef G_STAGE_B
#undef G_LDA
#undef G_LDB
#undef G_MMA
#undef G_F8
#undef G_WAIT_V
#undef G_WAIT_L
#undef G_BAR
#undef G_SCHED
#undef G_LOADIDX
}

#define EPI_ROWLOOP _Pragma("unroll") for (int ai = 0; ai < 2; ++ai) _Pragma("unroll") for (int m = 0; m < 4; ++m)
typedef f32x4 acc_t[2][2][4][2];
template <class TP> __device__ __forceinline__ TP* offp(TP* base, unsigned off) { return base + (size_t)off; }
struct Epi1 {
    bf16_t *cq, *ckv, *ub, *vb; const float* g_v; const LAS float* tabf;
    __device__ __forceinline__ void operator()(const acc_t& acc, const Unit& u, int wr, int wc, int fr, int fq) const {
        const LAS float* tf = tabf + u.ti * 256;
        const unsigned lc = wc * 32 + 8 * fq, rt0 = wr * 64 + fr, row0 = (unsigned)u.pm * BM + rt0;
        if (u.pn == 0) {
            EPI_ROWLOOP { const unsigned rt = rt0 + ai * HALF + m * 16, row = row0 + ai * HALF + m * 16; const float rs = tf[rt];
                const f32x4 v00 = acc[ai][0][m][0] * rs, v01 = acc[ai][0][m][1] * rs, v10 = acc[ai][1][m][0] * rs, v11 = acc[ai][1][m][1] * rs;
                *(u32x4*)offp(cq, row * 256 + lc) = pack8(v00, v01); *(u32x4*)offp(cq, row * 256 + HALF + lc) = pack8(v10, v11); }
        } else if (u.pn == 1) {
            EPI_ROWLOOP { const unsigned rt = rt0 + ai * HALF + m * 16, row = row0 + ai * HALF + m * 16; const float rs = tf[rt];
                const f32x4 v00 = acc[ai][0][m][0] * rs, v01 = acc[ai][0][m][1] * rs, v10 = acc[ai][1][m][0] * rs, v11 = acc[ai][1][m][1] * rs;
                *(u32x4*)offp(ckv, row * 256 + lc) = pack8(v00, v01); *(u32x4*)offp(ckv, row * 256 + HALF + lc) = pack8(v10, v11); }
        } else if (u.pn < 4) {
            const unsigned cb = (u.pn - 2) * 256 + lc;
            EPI_ROWLOOP { const unsigned rt = rt0 + ai * HALF + m * 16, row = row0 + ai * HALF + m * 16; const float rs = tf[rt];
#pragma unroll
                for (int bj = 0; bj < 2; ++bj) { f32x4 a = acc[ai][bj][m][0] * rs, b = acc[ai][bj][m][1] * rs;
#pragma unroll
                    for (int i = 0; i < 4; ++i) { a[i] = gelu_tanh(a[i]); b[i] = gelu_tanh(b[i]); }
                    *(u32x4*)offp(ub, row * 512 + cb + bj * HALF) = pack8(a, b); } }
        } else {
            const unsigned grp = 4 * (u.pn - 4) + wc, cb = (u.pn - 4) * 256 + 64 * wc + 8 * fq;
            const f32x4 g00 = *(const f32x4*)(g_v + grp * 64 + 8 * fq), g01 = *(const f32x4*)(g_v + grp * 64 + 8 * fq + 4), g10 = *(const f32x4*)(g_v + grp * 64 + 32 + 8 * fq), g11 = *(const f32x4*)(g_v + grp * 64 + 32 + 8 * fq + 4);
            EPI_ROWLOOP { const unsigned rt = rt0 + ai * HALF + m * 16, row = row0 + ai * HALF + m * 16; const float rs = tf[rt];
                f32x4 v00 = acc[ai][0][m][0] * rs, v01 = acc[ai][0][m][1] * rs, v10 = acc[ai][1][m][0] * rs, v11 = acc[ai][1][m][1] * rs;
#pragma unroll
                for (int i = 0; i < 4; ++i) { v00[i] = gelu_tanh(v00[i]); v01[i] = gelu_tanh(v01[i]); v10[i] = gelu_tanh(v10[i]); v11[i] = gelu_tanh(v11[i]); }
                const float s = red4(sq4(v00) + sq4(v01) + sq4(v10) + sq4(v11));
                const float rg = rsqrtf(s * (1.f / 64.f) + EPS);
                *(u32x4*)offp(vb, row * 512 + cb) = pack8(v00 * rg * g00, v01 * rg * g01); *(u32x4*)offp(vb, row * 512 + cb + 32) = pack8(v10 * rg * g10, v11 * rg * g11); }
        }
    }
};
template <bool SCALE> struct EpiStore {
    bf16_t* out; int ldc; const LAS float* tabf;
    __device__ __forceinline__ void operator()(const acc_t& acc, const Unit& u, int wr, int wc, int fr, int fq) const {
        const LAS float* tf = tabf + u.ti * 256;
        const unsigned rt0 = wr * 64 + fr, o0 = ((unsigned)u.pm * BM + rt0) * (unsigned)ldc + u.pn * BM + wc * 32 + 8 * fq;
        EPI_ROWLOOP { const unsigned rt = rt0 + ai * HALF + m * 16, o = o0 + (unsigned)(ai * HALF + m * 16) * (unsigned)ldc; const float rs = SCALE ? tf[rt] : 1.f;
#pragma unroll
            for (int bj = 0; bj < 2; ++bj) *(u32x4*)offp(out, o + bj * HALF) = pack8(acc[ai][bj][m][0] * rs, acc[ai][bj][m][1] * rs); }
    }
};
constexpr float E8_SCALE = 16.f, E8_INV = 1.f / 16.f;
struct EpiStoreF8 {
    unsigned char* out; int ldc;
    __device__ __forceinline__ void operator()(const acc_t& acc, const Unit& u, int wr, int wc, int fr, int fq) const {
        const unsigned rt0 = wr * 64 + fr, o0 = ((unsigned)u.pm * BM + rt0) * (unsigned)ldc + u.pn * BM + wc * 32 + 8 * fq;
        EPI_ROWLOOP { const unsigned o = o0 + (unsigned)(ai * HALF + m * 16) * (unsigned)ldc;
#pragma unroll
            for (int bj = 0; bj < 2; ++bj) { const f32x4 a = acc[ai][bj][m][0] * E8_SCALE, b = acc[ai][bj][m][1] * E8_SCALE; u32x2 q; q.x = pk4_fp8(a[0], a[1], a[2], a[3]); q.y = pk4_fp8(b[0], b[1], b[2], b[3]);
                *(u32x2*)offp(out, o + bj * HALF) = q; } }
    }
};
struct Epi2b {
    bf16_t *Kf, *Vf; const bf16_t* ckv; const float* g_kn; const float* rope; const LAS float* tabf; const LAS float* tabg;
    __device__ __forceinline__ void operator()(const acc_t& acc, const Unit& u, int wr, int wc, int fr, int fq) const {
        const LAS float* tf = tabf + u.ti * 256; const LAS float* tg = tabg + u.ti * 256;
        const unsigned head = 2 * u.pn + (wc >> 1), rt0 = wr * 64 + fr, row0 = (unsigned)u.pm * BM + rt0;
        if (wc & 1) {
            EPI_ROWLOOP { const unsigned rt = rt0 + ai * HALF + m * 16, row = row0 + ai * HALF + m * 16; const float rs = tf[rt];
#pragma unroll
                for (int bj = 0; bj < 2; ++bj) *(u32x4*)offp(Vf, row * 512 + head * 64 + 32 * bj + 8 * fq) = pack8(acc[ai][bj][m][0] * rs, acc[ai][bj][m][1] * rs); }
        } else {
            const f32x4 g00 = *(const f32x4*)(g_kn + 8 * fq), g01 = *(const f32x4*)(g_kn + 8 * fq + 4), g10 = *(const f32x4*)(g_kn + 32 + 8 * fq), g11 = *(const f32x4*)(g_kn + 32 + 8 * fq + 4);
            const f32x4 gr1 = *(const f32x4*)(g_kn + 64 + 4 * fq), gr2 = *(const f32x4*)(g_kn + 80 + 4 * fq);
#pragma unroll
            for (int ai = 0; ai < 2; ++ai)
#pragma unroll
            for (int mp = 0; mp < 2; ++mp) {
                u32x2 kr1[2], kr2[2]; f32x4 rp0[2], rp1[2];
#pragma unroll
                for (int mm = 0; mm < 2; ++mm) { const unsigned row = row0 + ai * HALF + (2 * mp + mm) * 16;
                    kr1[mm] = *(const u32x2*)offp(ckv, row * 256 + 128 + 4 * fq); kr2[mm] = *(const u32x2*)offp(ckv, row * 256 + 144 + 4 * fq);
                    const float* rp = offp(rope, ((row & 2047u) * 16 + 4 * fq) * 2); rp0[mm] = *(const f32x4*)rp; rp1[mm] = *(const f32x4*)(rp + 4); }
#pragma unroll
                for (int mm = 0; mm < 2; ++mm) { const int m = 2 * mp + mm; const unsigned rt = rt0 + ai * HALF + m * 16, row = row0 + ai * HALF + m * 16; const float rs = tf[rt];
                    const f32x4 v00 = acc[ai][0][m][0] * rs, v01 = acc[ai][0][m][1] * rs, v10 = acc[ai][1][m][0] * rs, v11 = acc[ai][1][m][1] * rs;
                    const float s = red4(sq4(v00) + sq4(v01) + sq4(v10) + sq4(v11));
                    const float rk = rsqrtf((s + tg[rt]) * (1.f / 96.f) + EPS);
                    const unsigned ko = row * 768 + head * 96;
                    *(u32x4*)offp(Kf, ko + 8 * fq) = pack8(v00 * rk * g00, v01 * rk * g01); *(u32x4*)offp(Kf, ko + 32 + 8 * fq) = pack8(v10 * rk * g10, v11 * rk * g11);
                    const f32x4 x1 = unpack_lo(kr1[mm]) * rk * gr1, x2 = unpack_lo(kr2[mm]) * rk * gr2;
                    const f32x4 cs = {rp0[mm][0], rp0[mm][2], rp1[mm][0], rp1[mm][2]}, sn = {rp0[mm][1], rp0[mm][3], rp1[mm][1], rp1[mm][3]};
                    const f32x4 o1 = x1 * cs - x2 * sn, o2 = x2 * cs + x1 * sn;
                    u32x2 w1, w2; w1.x = cvt_pk_bf16(o1[0], o1[1]); w1.y = cvt_pk_bf16(o1[2], o1[3]); w2.x = cvt_pk_bf16(o2[0], o2[1]); w2.y = cvt_pk_bf16(o2[2], o2[3]);
                    *(u32x2*)offp(Kf, ko + 64 + 4 * fq) = w1; *(u32x2*)offp(Kf, ko + 80 + 4 * fq) = w2; }
                asm volatile("" ::: "memory");
            }
        }
    }
};
struct Epi4 {
    const bf16_t* Xin; bf16_t* Xout; const LAS float* tabf; unsigned char* X8;
    __device__ __forceinline__ void midk(acc_t& acc, const Unit& u, int wr, int fr) const {
        const LAS float* tf = tabf + u.ti * 256;
        EPI_ROWLOOP { const float rs = tf[ai * HALF + wr * 64 + m * 16 + fr];
#pragma unroll
            for (int bj = 0; bj < 2; ++bj)
#pragma unroll
                for (int n = 0; n < 2; ++n) acc[ai][bj][m][n] *= rs; }
    }
    __device__ __forceinline__ void operator()(const acc_t& acc, const Unit& u, int wr, int wc, int fr, int fq) const {
        const unsigned o0 = ((unsigned)u.pm * BM + wr * 64 + fr) * 1024u + u.pn * BM + wc * 32 + 8 * fq;
#pragma unroll
        for (int ai = 0; ai < 2; ++ai) {
            u32x4 x[4][2];
#pragma unroll
            for (int m = 0; m < 4; ++m)
#pragma unroll
                for (int bj = 0; bj < 2; ++bj) x[m][bj] = *(const u32x4*)offp(Xin, o0 + (unsigned)(ai * HALF + m * 16) * 1024u + bj * HALF);
#pragma unroll
            for (int m = 0; m < 4; ++m)
#pragma unroll
                for (int bj = 0; bj < 2; ++bj) { const unsigned o = o0 + (unsigned)(ai * HALF + m * 16) * 1024u + bj * HALF;
                    const f32x4 h0 = acc[ai][bj][m][0] + unpack_lo((u32x2){x[m][bj].x, x[m][bj].y}), h1 = acc[ai][bj][m][1] + unpack_lo((u32x2){x[m][bj].z, x[m][bj].w});
                    const u32x4 w = pack8(h0, h1); *(u32x4*)offp(Xout, o) = w;
                    if (X8) { const f32x4 r0 = unpack_lo((u32x2){w.x, w.y}), r1 = unpack_lo((u32x2){w.z, w.w});
                        u32x2 q; q.x = pk4_fp8(r0[0], r0[1], r0[2], r0[3]); q.y = pk4_fp8(r1[0], r1[1], r1[2], r1[3]); *(u32x2*)offp(X8, o) = q; } }
            asm volatile("" ::: "memory");
        }
    }
};
struct Epi6F8 {
    unsigned char* H; const LAS float* tabf;
    __device__ __forceinline__ void operator()(const acc_t& acc, const Unit& u, int wr, int wc, int fr, int fq) const {
        const LAS float* tf = tabf + u.ti * 256;
        const unsigned rt0 = wr * 64 + fr, o0 = ((unsigned)u.pm * BM + rt0) * 512u + 128 * u.pn + 32 * wc + 8 * fq;
        EPI_ROWLOOP { const unsigned rt = rt0 + ai * HALF + m * 16; const float rs = tf[rt] * W8_INV; u32x2 w;
#pragma unroll
            for (int bj = 0; bj < 2; ++bj) { const f32x4 g = acc[ai][bj][m][0] * rs, up = acc[ai][bj][m][1] * rs; f32x4 h;
#pragma unroll
                for (int i = 0; i < 4; ++i) h[i] = silu_f(g[i]) * up[i];
                const unsigned p = pk4_fp8(h[0], h[1], h[2], h[3]); if (bj == 0) w.x = p; else w.y = p; }
            *(u32x2*)offp(H, o0 + (unsigned)(ai * HALF + m * 16) * 512u) = w; }
    }
};
struct Epi6 {
    bf16_t* H; const LAS float* tabf;
    __device__ __forceinline__ void operator()(const acc_t& acc, const Unit& u, int wr, int wc, int fr, int fq) const {
        const LAS float* tf = tabf + u.ti * 256;
        const unsigned rt0 = wr * 64 + fr, o0 = ((unsigned)u.pm * BM + rt0) * 512u + 128 * u.pn + 16 * wc + 4 * fq;
        EPI_ROWLOOP { const unsigned rt = rt0 + ai * HALF + m * 16; const float rs = tf[rt];
#pragma unroll
            for (int bj = 0; bj < 2; ++bj) { const f32x4 g = acc[ai][bj][m][0] * rs, up = acc[ai][bj][m][1] * rs; f32x4 h;
#pragma unroll
                for (int i = 0; i < 4; ++i) h[i] = silu_f(g[i]) * up[i];
                u32x2 w; w.x = cvt_pk_bf16(h[0], h[1]); w.y = cvt_pk_bf16(h[2], h[3]);
                *(u32x2*)offp(H, o0 + (unsigned)(ai * HALF + m * 16) * 512u + 64 * bj) = w; } }
    }
};
constexpr float Y8_SCALE = 32.f, Y8_INV = 1.f / 32.f;
struct Epi7 {
    bf16_t *y0, *y1; const LAS int* tabi; const LAS float* tabg; float wscale;
    __device__ __forceinline__ void operator()(const acc_t& acc, const Unit& u, int wr, int wc, int fr, int fq) const {
        const LAS int* ti = tabi + u.ti * 256; const LAS float* tg = tabg + u.ti * 256;
        const unsigned rt0 = wr * 64 + fr, c0 = u.pn * BM + wc * 32 + 8 * fq;
#if MOE_FP8
        unsigned char* yb0 = (unsigned char*)y0; const long dy = (long)((unsigned char*)y1 - (unsigned char*)y0);
        EPI_ROWLOOP {
            const unsigned rt = rt0 + ai * HALF + m * 16; const int tk = ti[rt]; const float gt = tg[rt] * (wscale * Y8_SCALE);
            if (tk >= 0) {
                unsigned char* yb = yb0 + dy * (long)(tk >> 30); const unsigned o0 = (unsigned)(tk & 0x3fffffff) * 1024u + c0;
#pragma unroll
                for (int bj = 0; bj < 2; ++bj) { const f32x4 a = acc[ai][bj][m][0] * gt, b = acc[ai][bj][m][1] * gt; u32x2 q; q.x = pk4_fp8(a[0], a[1], a[2], a[3]); q.y = pk4_fp8(b[0], b[1], b[2], b[3]);
                    *(u32x2*)offp(yb, o0 + bj * HALF) = q; }
            }
        }
#else
        const long dy = (long)(y1 - y0);
        EPI_ROWLOOP {
            const unsigned rt = rt0 + ai * HALF + m * 16; const int tk = ti[rt]; const float gt = tg[rt] * wscale;
            if (tk >= 0) {
                bf16_t* yb = y0 + dy * (long)(tk >> 30); const unsigned o0 = (unsigned)(tk & 0x3fffffff) * 1024u + c0;
#pragma unroll
                for (int bj = 0; bj < 2; ++bj) *(u32x4*)offp(yb, o0 + bj * HALF) = pack8(acc[ai][bj][m][0] * gt, acc[ai][bj][m][1] * gt);
            }
        }
#endif
    }
};
struct Epi9 {
    const bf16_t* Xin; const unsigned char* e; bf16_t* Xout; float* fout; float* ssq; const float* b_pg; const LAS float* tabf;
    __device__ __forceinline__ void operator()(const acc_t& acc, const Unit& u, int wr, int wc, int fr, int fq) const {
        const LAS float* tf = tabf + u.ti * 256;
        const unsigned rt0 = wr * 64 + fr, row0 = (unsigned)u.pm * BM + rt0, col0 = u.pn * BM + wc * 32 + 8 * fq;
        const f32x4 b00 = *(const f32x4*)(b_pg + col0), b01 = *(const f32x4*)(b_pg + col0 + 4), b10 = *(const f32x4*)(b_pg + col0 + HALF), b11 = *(const f32x4*)(b_pg + col0 + HALF + 4);
#pragma unroll
        for (int ai = 0; ai < 2; ++ai)
#pragma unroll
            for (int mp = 0; mp < 2; ++mp) {
                u32x4 xv[2][2]; u32x2 ev[2][2];
#pragma unroll
                for (int mm = 0; mm < 2; ++mm)
#pragma unroll
                    for (int bj = 0; bj < 2; ++bj) { const unsigned o = (row0 + ai * HALF + (2 * mp + mm) * 16) * 1024u + col0 + bj * HALF; xv[mm][bj] = *(const u32x4*)offp(Xin, o); ev[mm][bj] = *(const u32x2*)offp(e, o); }
#pragma unroll
                for (int mm = 0; mm < 2; ++mm) {
                    const int m = 2 * mp + mm; const unsigned rt = rt0 + ai * HALF + m * 16, row = row0 + ai * HALF + m * 16; const float rs = tf[rt]; float s = 0.f;
#pragma unroll
                    for (int bj = 0; bj < 2; ++bj) { const unsigned o = row * 1024u + col0 + bj * HALF;
                        const u32x4 x = xv[mm][bj]; const u32x2 evv = ev[mm][bj];
                        const f32x4 b0 = bj ? b10 : b00, b1 = bj ? b11 : b01;
                        const f32x4 x0 = unpack_lo((u32x2){x.x, x.y}), x1 = unpack_lo((u32x2){x.z, x.w}), e0 = unpack_fp8x4(evv.x) * E8_INV, e1 = unpack_fp8x4(evv.y) * E8_INV;
                        f32x4 h0, h1;
#pragma unroll
                        for (int i = 0; i < 4; ++i) { h0[i] = x0[i] + e0[i] * sigmoid_f(rs * acc[ai][bj][m][0][i] + b0[i]); h1[i] = x1[i] + e1[i] * sigmoid_f(rs * acc[ai][bj][m][1][i] + b1[i]); }
                        s += sq4(h0) + sq4(h1);
                        *(u32x4*)offp(Xout, o) = pack8(h0, h1);
                        if (fout) { __builtin_nontemporal_store(h0, (f32x4*)offp(fout, o)); __builtin_nontemporal_store(h1, (f32x4*)offp(fout, o + 4)); } }
                    s = red4(s); if (fq == 0) *offp(ssq, (u.pn * 4 + wc) * (unsigned)T + row) = s;
                }
                asm volatile("" ::: "memory");
            }
    }
};

struct EpiNull {
    float* sink;
    __device__ __forceinline__ void operator()(const acc_t& acc, const Unit& u, int wr, int wc, int fr, int fq) const {
        float s = 0.f;
        EPI_ROWLOOP {
#pragma unroll
            for (int bj = 0; bj < 2; ++bj) s += acc[ai][bj][m][0][0] + acc[ai][bj][m][1][3]; }
        if (s == 1.2345e30f) sink[threadIdx.x] = s;
    }
};
struct MkArgs { const float* in[26]; float* out; unsigned char* ws; int ph_lo, ph_hi; };
struct Frame {
    LAS unsigned char* lds; unsigned char* ws; int G, vcu, c, wv;
    LAS float* tabf; LAS int* tabi; LAS float* tabg;
};
#define XB_TMO      128
#define XB_XCNT(j)  (256  + 64 * (j))
#define XB_XSUB(j)  (1280 + 64 * (j))
#define XB_XGEN(j)  (2304 + 64 * (j))
#define XB_TOP      3328
#define XB_TOPGEN   3392
#define XCD_BAR_WORDS 3456
#define XB_SPIN_CAP (1u << 18)
__device__ __forceinline__ unsigned xb_ld(unsigned* p)              { return __hip_atomic_load(p, __ATOMIC_RELAXED, __HIP_MEMORY_SCOPE_AGENT); }
__device__ __forceinline__ unsigned xb_add(unsigned* p, unsigned v) { return __hip_atomic_fetch_add(p, v, __ATOMIC_RELAXED, __HIP_MEMORY_SCOPE_AGENT); }
__device__ __forceinline__ unsigned xb_xcc_id() { return (unsigned)__builtin_amdgcn_s_getreg((3 << 11) | 20) & 0xFu; }
#define XB_SPIN(cond, bar) do { unsigned _sp = 0; while (cond) { __builtin_amdgcn_s_sleep(1); \
    if ((++_sp & 255u) == 0u) { if (xb_ld(&(bar)[XB_TMO])) break; if (_sp > XB_SPIN_CAP) { atomicAdd(&(bar)[XB_TMO], 1u); break; } } } } while (0)
struct XcdBarrier { unsigned* bar; unsigned x; volatile LAS unsigned* st; };
__device__ __forceinline__ XcdBarrier xcd_barrier_post(unsigned* bar, volatile LAS unsigned* st) {
    XcdBarrier b; b.bar = bar; b.x = xb_xcc_id(); b.st = st;
    if (threadIdx.x == 0) (void)xb_add(&bar[XB_XCNT(b.x)], 1u);
    return b;
}
__device__ __forceinline__ void xcd_barrier_complete(unsigned* bar, unsigned x, unsigned& nloc, unsigned& nx) {
    const unsigned G = gridDim.x * gridDim.y * gridDim.z;
    unsigned sum, cnt, mine, sp = 0u;
    for (;;) {
        sum = 0u; cnt = 0u; mine = 0u;
#pragma unroll
        for (unsigned j = 0; j < 16; ++j) { const unsigned c = xb_ld(&bar[XB_XCNT(j)]); sum += c; cnt += (c > 0u) ? 1u : 0u; mine = (j == x) ? c : mine; }
        if (sum == G) break;
        __builtin_amdgcn_s_sleep(1);
        if ((++sp & 255u) == 0u) { if (xb_ld(&bar[XB_TMO])) break; if (sp > XB_SPIN_CAP) { atomicAdd(&bar[XB_TMO], 1u); break; } }
    }
    nloc = mine > 0u ? mine : 1u; nx = cnt > 0u ? cnt : 1u;
}
__device__ __forceinline__ void xcd_barrier(const XcdBarrier& b, const int tid_) {
    asm volatile("s_waitcnt vmcnt(0)" ::: "memory");
    __syncthreads();
    if (tid_ == 0) {
        unsigned* bar = b.bar;
        __builtin_amdgcn_s_waitcnt(0);
        unsigned nloc = b.st[0], nx = b.st[1];
        if (nloc == 0u) { xcd_barrier_complete(bar, b.x, nloc, nx); b.st[0] = nloc; b.st[1] = nx; }
        const unsigned old = xb_add(&bar[XB_XSUB(b.x)], 1u);
        const unsigned gen = old / nloc;
        if (old + 1u == (gen + 1u) * nloc) {
            __builtin_amdgcn_fence(__ATOMIC_RELEASE, "agent");
            asm volatile("s_waitcnt vmcnt(0)" ::: "memory");
            const unsigned og = xb_add(&bar[XB_TOP], 1u);
            const unsigned tg = og / nx;
            if (og + 1u == (tg + 1u) * nx) xb_add(&bar[XB_TOPGEN], 1u);
            else XB_SPIN(xb_ld(&bar[XB_TOPGEN]) == tg, bar);
            __builtin_amdgcn_fence(__ATOMIC_ACQUIRE, "agent");
            xb_add(&bar[XB_XGEN(b.x)], 1u);
            asm volatile("s_waitcnt vmcnt(0)" ::: "memory");
        } else {
            XB_SPIN(xb_ld(&bar[XB_XGEN(b.x)]) == gen, bar);
            __builtin_amdgcn_fence(__ATOMIC_ACQUIRE, "agent");
            asm volatile("s_waitcnt vmcnt(0)" ::: "memory");
        }
    }
    __syncthreads();
}

constexpr size_t Z_LBAR = 32768;
__device__ __forceinline__ void xcc_local_barrier(unsigned* lbar, unsigned* gbar, const unsigned x, const unsigned nloc, const int tid_) {
    asm volatile("s_waitcnt vmcnt(0)" ::: "memory");
    __syncthreads();
    if (tid_ == 0) {
        __builtin_amdgcn_s_waitcnt(0);
        const unsigned old = xb_add(&lbar[64 * x], 1u), gen = old / nloc;
        if (old + 1u == (gen + 1u) * nloc) xb_add(&lbar[1024 + 64 * x], 1u);
        else XB_SPIN(xb_ld(&lbar[1024 + 64 * x]) == gen, gbar);
        __builtin_amdgcn_fence(__ATOMIC_ACQUIRE, "agent");
        asm volatile("s_waitcnt vmcnt(0)" ::: "memory");
    }
    __syncthreads();
}
template <class Sched, class FF> __device__ __forceinline__ void fill_units(Frame& F, const Sched& S, const FF& ff) {
    int pm[MAXU], ex[MAXU], n = 0; Unit u;
#pragma unroll
    for (int i = 0; i < MAXU; ++i) { pm[i] = 0; ex[i] = 0; }
#pragma unroll
    for (int i = 0; i < MAXU; ++i) { if (n == i && S.next(i, u)) { pm[i] = u.pm; ex[i] = u.e; n = i + 1; } }
    const int tot = n * 256, t_ = my_tid(F.wv);
    if (tot > 0) {
#pragma unroll 1
        for (int e0 = t_; e0 < tot; e0 += 3 * NTHREADS) {
#pragma unroll
            for (int q = 0; q < 3; ++q) { int e = e0 + q * NTHREADS; e = e < tot ? e : tot - 1; const int i = e >> 8, r = e & 255;
                int p = pm[0], x = ex[0];
#pragma unroll
                for (int j = 1; j < MAXU; ++j) { p = (i == j) ? pm[j] : p; x = (i == j) ? ex[j] : x; }
                ff(i, r, p, x); }
        }
    }
    __syncthreads();
}
template <class Sched, class FF> __device__ __forceinline__ void fill_tab_static(Frame& F, const Sched& S, const FF& ff) {
    fill_units(F, S, [&](int i, int r, int pm, int) { ff(i, r, pm * 256 + r); });
}
struct CvCtx { int stride, nl; unsigned char* wsw; const LAS unsigned long long* ptab; };
template <int PART> __device__ __forceinline__ void cv_part(const CvCtx cv, int it, f32x4 (&v)[16], int lane) {
#if MOE_FP8
    convert_part_moe<PART>(lds_inptr(cv.ptab, 19) + (size_t)cv.nl * ((size_t)32 * 1024 * 512), lds_inptr(cv.ptab, 20) + (size_t)cv.nl * ((size_t)32 * 1024 * 512), lds_inptr(cv.ptab, 21) + (size_t)cv.nl * ((size_t)32 * 512 * 1024),
                           lds_inptr(cv.ptab, 16) + (size_t)cv.nl * 1024, cv.wsw, it, lane, v);
#endif
}
__device__ __forceinline__ float max3f(float a, float b, float c) { float r; asm("v_max3_f32 %0, %1, %2, %3" : "=v"(r) : "v"(a), "v"(b), "v"(c)); return r; }
constexpr int AK_STRIDE = 208, AV_STRIDE = 144, AK_BYTES = 64 * AK_STRIDE, ABUF = AK_BYTES + 64 * AV_STRIDE;
template <int VAR = 0> __device__ __forceinline__ void attn_unit(Frame& F, int b, int h, int qb, const bf16_t* qraw, const bf16_t* Kf, const bf16_t* Vf, bf16_t* am, float* ssq_a, const float* g_qn, const float* rope, const CvCtx cv, int& cv_it, int& cv_iter) {
    const int tid = my_tid(F.wv), lane = tid & 63, wid = __builtin_amdgcn_readfirstlane(tid >> 6), r32 = lane & 31, hi = lane >> 5;
    const int q0 = qb * 256 + wid * 32; const size_t row = (size_t)b * 2048 + q0 + r32;
    bf16x8 qf[6];
    {
        float qv[6][8]; float ss = 0.f; const bf16_t* qp = qraw + row * 768 + h * 96 + 8 * hi;
#pragma unroll
        for (int d0 = 0; d0 < 6; ++d0) { const bf16x8 raw = *(const bf16x8*)(qp + 16 * d0);
#pragma unroll
            for (int j = 0; j < 8; ++j) { qv[d0][j] = bf2f((bf16_t)raw[j]); ss += qv[d0][j] * qv[d0][j]; } }
        ss += __shfl_xor(ss, 32);
        const float rq = rsqrtf(ss * (1.f / 96.f) + EPS) * (SM_SCALE * 1.4426950408889634f);
#pragma unroll
        for (int d0 = 0; d0 < 6; ++d0)
#pragma unroll
            for (int j = 0; j < 8; ++j) qv[d0][j] *= rq * g_qn[16 * d0 + 8 * hi + j];
        const float* rp = rope + ((size_t)(q0 + r32) * 16 + 8 * hi) * 2;
#pragma unroll
        for (int j = 0; j < 8; ++j) { const float cs = rp[2 * j], sn = rp[2 * j + 1], x1 = qv[4][j], x2 = qv[5][j]; qv[4][j] = x1 * cs - x2 * sn; qv[5][j] = x2 * cs + x1 * sn; }
#pragma unroll
        for (int d0 = 0; d0 < 6; ++d0) { u32x4 w; w.x = cvt_pk_bf16(qv[d0][0], qv[d0][1]); w.y = cvt_pk_bf16(qv[d0][2], qv[d0][3]); w.z = cvt_pk_bf16(qv[d0][4], qv[d0][5]); w.w = cvt_pk_bf16(qv[d0][6], qv[d0][7]); qf[d0] = __builtin_bit_cast(bf16x8, w); }
    }
    const int ntile = 4 * qb + 4, nstep = ntile >> 1, mylast = 4 * qb + (wid >> 1);
    const int kc0 = tid, kc1 = tid + 512;
    const bf16_t* Kg = Kf + (size_t)b * 2048 * 768 + h * 96; const bf16_t* Vg = Vf + (size_t)b * 2048 * 512 + h * 64;
    const size_t kg0 = (size_t)(kc0 / 12) * 768 + (kc0 % 12) * 8, kg1 = (size_t)(kc1 / 12) * 768 + (kc1 % 12) * 8, vg0 = (size_t)(tid >> 3) * 512 + (tid & 7) * 8;
    const int kl0 = (kc0 / 12) * AK_STRIDE + (kc0 % 12) * 16, kl1 = (kc1 / 12) * AK_STRIDE + (kc1 % 12) * 16, vl0 = AK_BYTES + (tid >> 3) * AV_STRIDE + (tid & 7) * 16;
    LAS unsigned char* lds = F.lds;
    u32x4 kr[2][2], vr[2];
#pragma unroll
    for (int e = 0; e < 2; ++e) { kr[e][1] = (u32x4){0u, 0u, 0u, 0u}; const size_t ko = (size_t)e * 64 * 768, vo = (size_t)e * 64 * 512;
        kr[e][0] = *(const u32x4*)(Kg + ko + kg0); if (tid < 256) kr[e][1] = *(const u32x4*)(Kg + ko + kg1); vr[e] = *(const u32x4*)(Vg + vo + vg0); }
#pragma unroll
    for (int e = 0; e < 2; ++e) { LAS unsigned char* nb = lds + e * ABUF; *(LAS u32x4*)(nb + kl0) = kr[e][0]; if (tid < 256) *(LAS u32x4*)(nb + kl1) = kr[e][1]; *(LAS u32x4*)(nb + vl0) = vr[e]; }
    asm volatile("s_waitcnt lgkmcnt(0)" ::: "memory"); __builtin_amdgcn_s_barrier(); asm volatile("" ::: "memory");
    f32x16 o0, o1;
#pragma unroll
    for (int r = 0; r < 16; ++r) { o0[r] = 0.f; o1[r] = 0.f; }
    float m_run = 0.f, l_run = 0.f;
    f32x16 negm;
#pragma unroll
    for (int r = 0; r < 16; ++r) negm[r] = 0.f;
    const int q4 = (lane & 15) >> 2, p4 = lane & 3, blk = (lane >> 4) & 1;
#define ATT_QK(P0, P1, KB) do { \
        if (!(VAR & 4)) { _Pragma("unroll") for (int dh = 0; dh < 2; ++dh) { bf16x8 ka_[3], kb_[3]; \
            _Pragma("unroll") for (int d0 = 0; d0 < 3; ++d0) { ka_[d0] = *(const LAS bf16x8*)((KB) + r32 * AK_STRIDE + 32 * (3 * dh + d0) + 16 * hi); kb_[d0] = *(const LAS bf16x8*)((KB) + (32 + r32) * AK_STRIDE + 32 * (3 * dh + d0) + 16 * hi); } \
            __builtin_amdgcn_sched_barrier(0);        \
            _Pragma("unroll") for (int d0 = 0; d0 < 3; ++d0) { \
                if (dh == 0 && d0 == 0) { P0 = __builtin_amdgcn_mfma_f32_32x32x16_bf16(ka_[0], qf[0], negm, 0, 0, 0); P1 = __builtin_amdgcn_mfma_f32_32x32x16_bf16(kb_[0], qf[0], negm, 0, 0, 0); } \
                else { P0 = __builtin_amdgcn_mfma_f32_32x32x16_bf16(ka_[d0], qf[3 * dh + d0], P0, 0, 0, 0); P1 = __builtin_amdgcn_mfma_f32_32x32x16_bf16(kb_[d0], qf[3 * dh + d0], P1, 0, 0, 0); } } \
            __builtin_amdgcn_sched_barrier(0); } } else { P0 = negm; P1 = negm; } } while (0)
#define ATT_SM(P0, P1, PF) do { float mx_ = 0.f; \
        asm volatile("s_nop 15\n\ts_nop 7" : "+v"(P0), "+v"(P1));        \
        if (!(VAR & 1)) { float ma_ = max3f(P0[0], P0[1], P0[2]), mb_ = max3f(P1[0], P1[1], P1[2]); \
            _Pragma("unroll") for (int r = 3; r < 15; r += 2) { ma_ = max3f(ma_, P0[r], P0[r + 1]); mb_ = max3f(mb_, P1[r], P1[r + 1]); } \
            mx_ = max3f(ma_, mb_, fmaxf(P0[15], P1[15])); mx_ = fmaxf(mx_, __shfl_xor(mx_, 32)); } \
        if (__builtin_expect(!(VAR & 1) && __any(mx_ > 8.0f), 0)) { const float dl_ = fmaxf(mx_, 0.f), al_ = __builtin_amdgcn_exp2f(-dl_); m_run += dl_; l_run *= al_; \
            _Pragma("unroll") for (int r = 0; r < 16; ++r) { P0[r] -= dl_; P1[r] -= dl_; o0[r] *= al_; o1[r] *= al_; negm[r] = -m_run; } } \
        float ls_ = 0.f; _Pragma("unroll") for (int r = 0; r < 16; ++r) { if (!(VAR & 1)) { P0[r] = __builtin_amdgcn_exp2f(P0[r]); P1[r] = __builtin_amdgcn_exp2f(P1[r]); } ls_ += P0[r] + P1[r]; } \
        l_run += ls_; u32x4 w_; \
        w_.x = cvt_pk_bf16(P0[0], P0[1]); w_.y = cvt_pk_bf16(P0[2], P0[3]); w_.z = cvt_pk_bf16(P0[4], P0[5]); w_.w = cvt_pk_bf16(P0[6], P0[7]); PF[0] = __builtin_bit_cast(bf16x8, w_); \
        w_.x = cvt_pk_bf16(P0[8], P0[9]); w_.y = cvt_pk_bf16(P0[10], P0[11]); w_.z = cvt_pk_bf16(P0[12], P0[13]); w_.w = cvt_pk_bf16(P0[14], P0[15]); PF[1] = __builtin_bit_cast(bf16x8, w_); \
        w_.x = cvt_pk_bf16(P1[0], P1[1]); w_.y = cvt_pk_bf16(P1[2], P1[3]); w_.z = cvt_pk_bf16(P1[4], P1[5]); w_.w = cvt_pk_bf16(P1[6], P1[7]); PF[2] = __builtin_bit_cast(bf16x8, w_); \
        w_.x = cvt_pk_bf16(P1[8], P1[9]); w_.y = cvt_pk_bf16(P1[10], P1[11]); w_.z = cvt_pk_bf16(P1[12], P1[13]); w_.w = cvt_pk_bf16(P1[14], P1[15]); PF[3] = __builtin_bit_cast(bf16x8, w_); } while (0)
#define ATT_PV(PF, VB) do { if (!(VAR & 2)) { v4i16_t lo0_[4], hi0_[4], lo1_[4], hi1_[4]; \
            _Pragma("unroll") for (int ks = 0; ks < 4; ++ks) { const int krow_ = 32 * (ks >> 1) + 16 * (ks & 1) + 4 * hi + q4; const LAS unsigned char* vp_ = (VB) + krow_ * AV_STRIDE + 32 * blk + 8 * p4; \
                lo0_[ks] = __builtin_amdgcn_ds_read_tr16_b64_v4i16((LAS v4i16_t*)(vp_)); hi0_[ks] = __builtin_amdgcn_ds_read_tr16_b64_v4i16((LAS v4i16_t*)(vp_ + 8 * AV_STRIDE)); \
                lo1_[ks] = __builtin_amdgcn_ds_read_tr16_b64_v4i16((LAS v4i16_t*)(vp_ + 64)); hi1_[ks] = __builtin_amdgcn_ds_read_tr16_b64_v4i16((LAS v4i16_t*)(vp_ + 8 * AV_STRIDE + 64)); } \
            __builtin_amdgcn_sched_barrier(0);        \
            _Pragma("unroll") for (int ks = 0; ks < 4; ++ks) { \
                const bf16x8 v0_ = {lo0_[ks][0], lo0_[ks][1], lo0_[ks][2], lo0_[ks][3], hi0_[ks][0], hi0_[ks][1], hi0_[ks][2], hi0_[ks][3]}; const bf16x8 v1_ = {lo1_[ks][0], lo1_[ks][1], lo1_[ks][2], lo1_[ks][3], hi1_[ks][0], hi1_[ks][1], hi1_[ks][2], hi1_[ks][3]}; \
                o0 = __builtin_amdgcn_mfma_f32_32x32x16_bf16(v0_, PF[ks], o0, 0, 0, 0); o1 = __builtin_amdgcn_mfma_f32_32x32x16_bf16(v1_, PF[ks], o1, 0, 0, 0); } \
            __builtin_amdgcn_sched_barrier(0); } } while (0)
    for (int st = 0; st < nstep; ++st) {
        const bool more = st + 1 < nstep;
        if (more) {
#pragma unroll
            for (int e = 0; e < 2; ++e) { const size_t ko = (size_t)(2 * st + 2 + e) * 64 * 768, vo = (size_t)(2 * st + 2 + e) * 64 * 512;
                kr[e][0] = *(const u32x4*)(Kg + ko + kg0); if (tid < 256) kr[e][1] = *(const u32x4*)(Kg + ko + kg1); vr[e] = *(const u32x4*)(Vg + vo + vg0); } }
        if (2 * st <= mylast) {
            const LAS unsigned char* kbA = lds + (st & 1) * 2 * ABUF; const LAS unsigned char* kbB = kbA + ABUF;
            const bool actB = 2 * st + 1 <= mylast;
            f32x16 pA0, pA1, pB0, pB1; bf16x8 pf[4];
            ATT_QK(pA0, pA1, kbA);
            const float mrefB = m_run;
            if (actB) ATT_QK(pB0, pB1, kbB);
            ATT_SM(pA0, pA1, pf);
            ATT_PV(pf, kbA + AK_BYTES);
            if (actB) {
                const float adj = m_run - mrefB;
                if (__builtin_expect(__any(adj != 0.f), 0)) {
#pragma unroll
                    for (int r = 0; r < 16; ++r) { pB0[r] -= adj; pB1[r] -= adj; } }
                ATT_SM(pB0, pB1, pf);
                ATT_PV(pf, kbB + AK_BYTES);
            }
        }
        if (more) {
#pragma unroll
            for (int e = 0; e < 2; ++e) { LAS unsigned char* nb = lds + ((st + 1) & 1) * 2 * ABUF + e * ABUF;
                *(LAS u32x4*)(nb + kl0) = kr[e][0]; if (tid < 256) *(LAS u32x4*)(nb + kl1) = kr[e][1]; *(LAS u32x4*)(nb + vl0) = vr[e]; } }
        asm volatile("s_waitcnt lgkmcnt(0)" ::: "memory"); __builtin_amdgcn_s_barrier(); asm volatile("" ::: "memory");
    }
#undef ATT_QK
#undef ATT_SM
#undef ATT_PV
    const float l = l_run + __shfl_xor(l_run, 32), il = 1.f / l;
    float s = 0.f; bf16_t* op = am + row * 1024 + h * 64 + 4 * hi;
#pragma unroll
    for (int g = 0; g < 4; ++g) {
        const float a0 = o0[4 * g] * il, a1 = o0[4 * g + 1] * il, a2 = o0[4 * g + 2] * il, a3 = o0[4 * g + 3] * il;
        const float b0 = o1[4 * g] * il, b1 = o1[4 * g + 1] * il, b2 = o1[4 * g + 2] * il, b3 = o1[4 * g + 3] * il;
        s += (a0 * a0 + a1 * a1) + (a2 * a2 + a3 * a3) + (b0 * b0 + b1 * b1) + (b2 * b2 + b3 * b3);
        u32x2 w0, w1; w0.x = cvt_pk_bf16(a0, a1); w0.y = cvt_pk_bf16(a2, a3); w1.x = cvt_pk_bf16(b0, b1); w1.y = cvt_pk_bf16(b2, b3);
        *(u32x2*)(op + 8 * g) = w0; *(u32x2*)(op + 32 + 8 * g) = w1;
    }
    s += __shfl_xor(s, 32);
    if (hi == 0) ssq_a[(size_t)h * T + row] = s;
}

constexpr int GV_STRIDE = 136;
__device__ __forceinline__ void gmlp_unit(Frame& F, int blk128, const bf16_t* ub, const bf16_t* vb, const bf16_t* wsb, const float* b_s, bf16_t* am) {
    const int tid_ = my_tid(F.wv), lane = tid_ & 63, g = __builtin_amdgcn_readfirstlane(tid_ >> 6), fr = lane & 15, fq = lane >> 4, q4 = (lane & 15) >> 2, p4 = lane & 3;
    LAS unsigned char* vl = F.lds + g * (128 * GV_STRIDE);
    LAS float* red = (LAS float*)(F.lds + 8 * 128 * GV_STRIDE);
    const size_t tok0 = (size_t)blk128 * 128;
    u32x4 st[16];
#pragma unroll
    for (int u = 0; u < 16; ++u) { const int c = lane + 64 * u; st[u] = *(const u32x4*)(vb + (tok0 + (c >> 3)) * 512 + g * 64 + (c & 7) * 8); }
    bf16x8 wfa[4][2];
#pragma unroll
    for (int mm = 0; mm < 4; ++mm)
#pragma unroll
        for (int ks = 0; ks < 2; ++ks) wfa[mm][ks] = *(const bf16x8*)(wsb + ((size_t)g * 128 + 16 * mm + fr) * 128 + 32 * ks + 8 * fq);
#pragma unroll
    for (int u = 0; u < 16; ++u) { const int c = lane + 64 * u; *(LAS u32x4*)(vl + (c >> 3) * GV_STRIDE + (c & 7) * 16) = st[u]; }
    asm volatile("s_waitcnt lgkmcnt(0)" ::: "memory");
#define GM_VF(VF, KS4) do { _Pragma("unroll") for (int n = 0; n < 4; ++n) { const LAS unsigned char* vp_ = vl + (32 * (KS4) + 8 * fq + q4) * GV_STRIDE + 32 * n + 8 * p4; \
        const v4i16_t lo_ = __builtin_amdgcn_ds_read_tr16_b64_v4i16((LAS v4i16_t*)(vp_)), hi_ = __builtin_amdgcn_ds_read_tr16_b64_v4i16((LAS v4i16_t*)(vp_ + 4 * GV_STRIDE)); \
        VF[n] = (bf16x8){lo_[0], lo_[1], lo_[2], lo_[3], hi_[0], hi_[1], hi_[2], hi_[3]}; } } while (0)
#define GM_EPI(ACC, MBASE, UU, BSV) do { \
        _Pragma("unroll") for (int mm = 0; mm < 4; ++mm) { const int t = 16 * ((MBASE) + mm) + fr; float s_ = 0.f; \
            _Pragma("unroll") for (int n = 0; n < 4; ++n) { ACC[mm][n] = (ACC[mm][n] + BSV[mm]) * unpack_lo(UU[mm][n]); s_ += sq4(ACC[mm][n]); } \
            s_ = red4(s_); if (fq == 0) red[g * 128 + t] = s_; } \
        __syncthreads(); \
        _Pragma("unroll") for (int mm = 0; mm < 4; ++mm) { const int t = 16 * ((MBASE) + mm) + fr; float tot_ = 0.f; \
            _Pragma("unroll") for (int gg = 0; gg < 8; ++gg) tot_ += red[gg * 128 + t]; \
            const float rs_ = rsqrtf(tot_ * (1.f / 512.f) + EPS); \
            _Pragma("unroll") for (int n = 0; n < 4; ++n) { const f32x4 o_ = ACC[mm][n] * rs_; u32x2 w_; w_.x = cvt_pk_bf16(o_[0], o_[1]); w_.y = cvt_pk_bf16(o_[2], o_[3]); \
                *(u32x2*)(am + (tok0 + t) * 1024 + 512 + g * 64 + 16 * n + 4 * fq) = w_; } } } while (0)
    {
        bf16x8 wfb[4][4];
#pragma unroll
        for (int mm = 0; mm < 4; ++mm)
#pragma unroll
            for (int ks = 0; ks < 4; ++ks) wfb[mm][ks] = *(const bf16x8*)(wsb + ((size_t)g * 128 + 16 * (4 + mm) + fr) * 128 + 32 * ks + 8 * fq);
        u32x2 uu[4][4]; float bsv[4];
#pragma unroll
        for (int mm = 0; mm < 4; ++mm) { const int t = 16 * mm + fr; bsv[mm] = b_s[g * 128 + t];
#pragma unroll
            for (int n = 0; n < 4; ++n) uu[mm][n] = *(const u32x2*)(ub + (tok0 + t) * 512 + g * 64 + 16 * n + 4 * fq); }
        f32x4 acc[4][4];
#pragma unroll
        for (int mm = 0; mm < 4; ++mm)
#pragma unroll
            for (int n = 0; n < 4; ++n) acc[mm][n] = (f32x4){0.f, 0.f, 0.f, 0.f};
#pragma unroll
        for (int ks = 0; ks < 2; ++ks) { bf16x8 vf[4]; GM_VF(vf, ks);
#pragma unroll
            for (int mm = 0; mm < 4; ++mm)
#pragma unroll
                for (int n = 0; n < 4; ++n) acc[mm][n] = __builtin_amdgcn_mfma_f32_16x16x32_bf16(vf[n], wfa[mm][ks], acc[mm][n], 0, 0, 0); }
        GM_EPI(acc, 0, uu, bsv);
        u32x2 uv[4][4]; float bsw[4];
#pragma unroll
        for (int mm = 0; mm < 4; ++mm) { const int t = 16 * (4 + mm) + fr; bsw[mm] = b_s[g * 128 + t];
#pragma unroll
            for (int n = 0; n < 4; ++n) uv[mm][n] = *(const u32x2*)(ub + (tok0 + t) * 512 + g * 64 + 16 * n + 4 * fq); }
        f32x4 acb[4][4];
#pragma unroll
        for (int mm = 0; mm < 4; ++mm)
#pragma unroll
            for (int n = 0; n < 4; ++n) acb[mm][n] = (f32x4){0.f, 0.f, 0.f, 0.f};
#pragma unroll
        for (int ks = 0; ks < 4; ++ks) { bf16x8 vf[4]; GM_VF(vf, ks);
#pragma unroll
            for (int mm = 0; mm < 4; ++mm)
#pragma unroll
                for (int n = 0; n < 4; ++n) acb[mm][n] = __builtin_amdgcn_mfma_f32_16x16x32_bf16(vf[n], wfb[mm][ks], acb[mm][n], 0, 0, 0); }
        __syncthreads();
        GM_EPI(acb, 4, uv, bsw);
    }
#undef GM_VF
#undef GM_EPI
    __syncthreads();
}

__device__ __forceinline__ void router_unit(Frame& F, int blk128, const bf16_t* X, const bf16_t* wr_hi, int* gcnt, int* stok, float* srs, float* sg) {
    const int tid = my_tid(F.wv), lane = tid & 63, w = __builtin_amdgcn_readfirstlane(tid >> 6), fr = lane & 15, fq = lane >> 4;
    LAS float* lg = (LAS float*)F.lds;
    LAS float* ssq = lg + 128 * 49;
    LAS int* hist = (LAS int*)(ssq + 128);
    if (tid < 64) hist[tid] = 0;
    const size_t tok0 = (size_t)blk128 * 128;
    const bf16_t* wr_lo = wr_hi + 64 * 1024;
    {
        constexpr int WROW = 1040;
        LAS unsigned char* wl = F.lds + 26624;
        const bf16_t* xrow = X + (tok0 + 16 * w + fr) * 1024 + 8 * fq;
        bf16x8 a[32];
#pragma unroll
        for (int ks = 0; ks < 32; ++ks) a[ks] = *(const bf16x8*)(xrow + 32 * ks);
        f32x4 acc[3] = {{0.f, 0.f, 0.f, 0.f}, {0.f, 0.f, 0.f, 0.f}, {0.f, 0.f, 0.f, 0.f}}; float ss = 0.f;
#pragma unroll
        for (int half = 0; half < 2; ++half) {
            if (half) __syncthreads();
            { u32x4 st[12];
#pragma unroll
              for (int i = 0; i < 12; ++i) { const int c = tid + 512 * i, rowh = c >> 6, ch = c & 63, hl = rowh >= 48 ? 1 : 0, row = rowh - 48 * hl;
                  st[i] = *(const u32x4*)((hl ? wr_lo : wr_hi) + (size_t)row * 1024 + 512 * half + 8 * ch); }
#pragma unroll
              for (int i = 0; i < 12; ++i) { const int c = tid + 512 * i, rowh = c >> 6, ch = c & 63;
                  *(LAS u32x4*)(wl + rowh * WROW + ch * 16) = st[i]; } }
            __syncthreads();
#pragma unroll
            for (int k2 = 0; k2 < 16; ++k2) { const bf16x8 av = a[16 * half + k2];
#pragma unroll
                for (int j = 0; j < 8; ++j) { const float x = bf2f((bf16_t)av[j]); ss += x * x; }
#pragma unroll
                for (int nt = 0; nt < 3; ++nt) { const LAS unsigned char* bp = wl + (16 * nt + fr) * WROW + (32 * k2 + 8 * fq) * 2;
                    const bf16x8 bh = *(const LAS bf16x8*)bp, bl = *(const LAS bf16x8*)(bp + 48 * WROW);
                    acc[nt] = __builtin_amdgcn_mfma_f32_16x16x32_bf16(av, bh, acc[nt], 0, 0, 0); acc[nt] = __builtin_amdgcn_mfma_f32_16x16x32_bf16(av, bl, acc[nt], 0, 0, 0); }
            }
        }
#pragma unroll
        for (int nt = 0; nt < 3; ++nt)
#pragma unroll
            for (int i = 0; i < 4; ++i) lg[(16 * w + 4 * fq + i) * 49 + 16 * nt + fr] = acc[nt][i];
        ss = red4(ss);
        if (fq == 0) ssq[16 * w + fr] = ss;
    }
    __syncthreads();
    int ea = 0, eb = 0, ra = 0, rbk = 0; float g0 = 0.f, g1 = 0.f, rstd = 0.f;
    if (tid < 128) {
        rstd = rsqrtf(ssq[tid] * (1.f / 1024.f) + EPS);
        const LAS float* l = lg + tid * 49;
        int gs = 0; float gm = l[0] * rstd;
#pragma unroll
        for (int g = 1; g < 4; ++g) { const float v = l[g] * rstd; if (v > gm) { gm = v; gs = g; } }
        float den = 0.f;
#pragma unroll
        for (int g = 0; g < 4; ++g) den += __expf(l[g] * rstd - gm);
        const float psel = 1.f / den;
        int i0 = 0; float v0 = l[4 + gs * 8] * rstd;
        for (int i = 1; i < 8; ++i) { const float v = l[4 + gs * 8 + i] * rstd; if (v > v0) { v0 = v; i0 = i; } }
        int i1 = -1; float v1 = -3.0e38f;
        for (int i = 0; i < 8; ++i) { const float v = l[4 + gs * 8 + i] * rstd; if (i != i0 && v > v1) { v1 = v; i1 = i; } }
        const float e1 = __expf(v1 - v0); g0 = psel / (1.f + e1); g1 = psel * e1 / (1.f + e1);
        ea = gs * 8 + i0; eb = gs * 8 + i1;
        ra = __hip_atomic_fetch_add(&hist[ea], 1, __ATOMIC_RELAXED, __HIP_MEMORY_SCOPE_WORKGROUP); rbk = __hip_atomic_fetch_add(&hist[eb], 1, __ATOMIC_RELAXED, __HIP_MEMORY_SCOPE_WORKGROUP);
    }
    __syncthreads();
    if (tid < 32) { const int n = hist[tid]; hist[32 + tid] = n ? atomicAdd(gcnt + tid, n) : 0; }
    __syncthreads();
    if (tid < 128) {
        const int tok = (int)tok0 + tid; const size_t pa = (size_t)ea * T + hist[32 + ea] + ra, pb = (size_t)eb * T + hist[32 + eb] + rbk;
        stok[pa] = tok; srs[pa] = rstd; sg[pa] = g0;
        stok[pb] = tok | (1 << 30); srs[pb] = rstd; sg[pb] = g1;
    }
    __syncthreads();
}

__global__ void __launch_bounds__(NTHREADS, 2) mk_fwd(MkArgs args) {
    extern __shared__ __attribute__((aligned(16))) unsigned char lds_raw[];
    Frame F;
    F.lds = (LAS unsigned char*)lds_raw; F.ws = args.ws;
    F.wv = __builtin_amdgcn_readfirstlane((int)threadIdx.x >> 6);
    F.G = gridDim.x; F.c = blockIdx.x; F.vcu = (F.G % 8 == 0) ? (F.c % 8) * (F.G / 8) + F.c / 8 : F.c;
    F.tabf = (LAS float*)(F.lds + TABF_OFF); F.tabi = (LAS int*)(F.lds + TABI_OFF); F.tabg = (LAS float*)(F.lds + TABG_OFF);
    unsigned char* ws = args.ws;
    volatile LAS unsigned* misc = (volatile LAS unsigned*)(F.lds + MISC_OFF);
    if ((int)threadIdx.x < 8) misc[(int)threadIdx.x] = 0u;
    if ((int)threadIdx.x < 26) ((LAS unsigned long long*)(F.lds + PTR_OFF))[(int)threadIdx.x] = (unsigned long long)args.in[(int)threadIdx.x];
    __syncthreads();
    XcdBarrier bar; bar.bar = (unsigned*)(ws + Z_BAR); bar.x = xb_xcc_id(); bar.st = misc;
    if ((int)threadIdx.x == 0) {
        const unsigned rank = xb_add(&bar.bar[XB_XCNT(bar.x)], 1u);
        unsigned nloc, nx; xcd_barrier_complete(bar.bar, bar.x, nloc, nx);
        bool ok = (gridDim.x == 256u) && nx == 8u && bar.x < 8u;
#pragma unroll
        for (unsigned j = 0; j < 8; ++j) ok = ok && (xb_ld(&bar.bar[XB_XCNT(j)]) == 32u);
        misc[0] = nloc; misc[1] = nx; misc[4] = rank; misc[5] = ok ? 1u : 0u;
    }
    __syncthreads();
    const bool local_ok = __builtin_amdgcn_readfirstlane(misc[5]) != 0u;
    const int my_rank = (int)__builtin_amdgcn_readfirstlane(misc[4]), my_xcc = (int)bar.x;
    unsigned* const lbar = (unsigned*)(ws + Z_LBAR);
    if (local_ok) { F.c = my_rank * 8 + my_xcc; F.vcu = my_xcc * 32 + my_rank; }
    const int p2sel = (args.ph_lo >= 44) ? args.ph_lo - 44 : -1;
    const int lo = (p2sel >= 0) ? 33 : args.ph_lo, hi = (p2sel >= 0) ? 34 : args.ph_hi;
#ifndef PHMASK
#define PHMASK 0x7fff
#endif
#define IN(k) (lo <= (k) && (k) < hi)
#define PHON(b) (((PHMASK) >> (b)) & 1)
#ifdef TS_A
#define TS_REC(k) do { if (my_tid(F.wv) == 0) ((volatile LAS unsigned long long*)(F.lds + PTR_OFF + 256))[(k)] = __builtin_amdgcn_s_memrealtime(); } while (0)
#else
#define TS_REC(k) do { } while (0)
#endif
#define TS_RECL(k) do { if (l == 1) TS_REC(k); } while (0)
#define SEAM(k) do { if ((k) + 1 < hi) xcd_barrier(bar, my_tid(F.wv)); TS_REC(k); } while (0)
#define SEAM_L(k) do { if ((k) + 1 < hi) { if (local_ok) xcc_local_barrier(lbar, bar.bar, (unsigned)my_xcc, 32u, my_tid(F.wv)); else xcd_barrier(bar, my_tid(F.wv)); } TS_REC(k); } while (0)

    if (PHON(0) && IN(0)) {
        const float* x = lds_inptr((const LAS unsigned long long*)(F.lds + PTR_OFF), 0); const float* p = lds_inptr((const LAS unsigned long long*)(F.lds + PTR_OFF), 1);
        const int tid_ = my_tid(F.wv), lane = tid_ & 63, gw = F.vcu * NWAVES + (tid_ >> 6), ngw = F.G * NWAVES;
        float* ssqh = (float*)(ws + Z_SSQ) + (size_t)12 * T;
        for (int m = gw; m < T; m += ngw) {
            const f32x4* xr = (const f32x4*)(x + (size_t)m * D) + lane; float s = 0.f; u32x2* o = (u32x2*)((bf16_t*)(ws + WS_X0) + (size_t)m * D) + lane;
#pragma unroll
            for (int j = 0; j < 4; ++j) { const f32x4 v = __builtin_nontemporal_load(xr + 64 * j); s += v.x * v.x + v.y * v.y + v.z * v.z + v.w * v.w; u32x2 w; w.x = cvt_pk_bf16(v.x, v.y); w.y = cvt_pk_bf16(v.z, v.w); o[64 * j] = w; }
            s = wave_sum(s); if (lane == 0) ssqh[m] = s;
            if (lane < 16) ((float*)(ws + WS_SSQHP))[(size_t)lane * T + m] = lane == 0 ? s : 0.f;
        }
        bf16_t* pb = (bf16_t*)(ws + WS_PB);
        const size_t n4 = (size_t)T * 256 / 4, gt = (size_t)F.c * NTHREADS + tid_, ngt = (size_t)F.G * NTHREADS;
        for (size_t i = gt; i < n4; i += ngt) { const f32x4 v = __builtin_nontemporal_load((const f32x4*)p + i); u32x2 w; w.x = cvt_pk_bf16(v.x, v.y); w.y = cvt_pk_bf16(v.z, v.w); ((u32x2*)pb)[i] = w; }
        float* rope = (float*)(ws + S_ROPE);
        for (size_t i = gt; i < 2048 * 16; i += ngt) {
            const int pos = (int)(i >> 4), k = (int)(i & 15);
            const double inv = exp(-(double)(2 * k) / 32.0 * log(10000.0)), ang = (double)pos * inv;
            rope[2 * i] = (float)cos(ang); rope[2 * i + 1] = (float)sin(ang);
        }
    }

    for (int l = 0; l < NL; ++l) {
        const int pb0 = 1 + 10 * l;
        if (hi <= pb0 || lo >= pb0 + 10) continue;
#define LF(i, per) (lds_inptr((const LAS unsigned long long*)(F.lds + PTR_OFF), (i)) + (size_t)l * (per))
        { int c_ = local_ok ? my_rank * 8 + my_xcc : (int)blockIdx.x, g_ = gridDim.x; asm volatile("" : "+s"(c_), "+s"(g_)); F.c = c_; F.G = g_; F.vcu = (g_ % 8 == 0) ? (c_ % 8) * (g_ / 8) + c_ / 8 : c_; }
        { unsigned lb = 0u; asm volatile("" : "+s"(lb)); F.lds = (LAS unsigned char*)lds_raw + lb; size_t wo = 0; asm volatile("" : "+s"(wo)); ws = args.ws + wo; F.ws = ws; }
        F.tabf = (LAS float*)(F.lds + TABF_OFF); F.tabi = (LAS int*)(F.lds + TABI_OFF); F.tabg = (LAS float*)(F.lds + TABG_OFF);
        LAS int* moe_cnt = (LAS int*)(F.lds + MISC_OFF + 64); LAS int* moe_tb = (LAS int*)(F.lds + MISC_OFF + 192); LAS int* moe_te = (LAS int*)(F.lds + MISC_OFF + 384);
        unsigned char* wsw = ws + ((l & 1) ? W_ALT : 0);
#define ZSSQ(k) ((float*)(ws + Z_SSQ) + (size_t)(k) * T)
#define XIN ((bf16_t*)(ws + ((l & 1) ? WS_X1 : WS_X0)))
#define XMID ((bf16_t*)(ws + ((l & 1) ? WS_X0 : WS_X1)))
#define ROPE ((const float*)(ws + S_ROPE))
#define GCNT ((int*)(ws + Z_CNT) + l * 64)
        if (PHON(1) && IN(pb0 + 0) && (l == 0 || !MOE_FP8)) {
            LayerW L; FILL_LAYERW(L, LF)
            const int tid_ = my_tid(F.wv), wv = __builtin_amdgcn_readfirstlane(tid_ >> 6);
            float* scr = (float*)(F.lds + wv * 8448);
            const int gw = F.vcu * NWAVES + wv, ngw = F.G * NWAVES;
#if MOE_FP8
            for (int it = gw; it < IT_SMALL; it += ngw) convert_item(L, wsw, it, scr, tid_ & 63);
            for (int it = gw; it < IT_MOE; it += 2 * ngw) { f32x4 va[16], vb[16]; const int it1 = it + ngw < IT_MOE ? it + ngw : it;
                convert_part_moe<0>(L.w1, L.w3, L.w2, L.g_ffn, wsw, it, tid_ & 63, va); convert_part_moe<0>(L.w1, L.w3, L.w2, L.g_ffn, wsw, it1, tid_ & 63, vb);
                convert_part_moe<1>(L.w1, L.w3, L.w2, L.g_ffn, wsw, it, tid_ & 63, va); convert_part_moe<1>(L.w1, L.w3, L.w2, L.g_ffn, wsw, it1, tid_ & 63, vb); }
#else
            for (int it = gw; it < IT_TOTAL; it += ngw) convert_item(L, wsw, it, scr, tid_ & 63);
#endif
            convert_small(L, wsw, F.c * NTHREADS + tid_, F.G * NTHREADS);
            SEAM(pb0 + 0);
        }
        if (PHON(2) && IN(pb0 + 1)) {
            SchedStatic S; S.init(T, NPROJ, 1024, F.G, F.c, XIN, wsw + W_IN); const float* hp = (const float*)(ws + WS_SSQHP);
            fill_tab_static(F, S, [&](int i, int r, int row) { float s = 0.f;
#pragma unroll
                for (int k = 0; k < 16; ++k) s += hp[(size_t)k * T + row];
                F.tabf[i * 256 + r] = rsqrtf(s * (1.f / 1024.f) + EPS); });
            Epi1 E{(bf16_t*)(ws + WS_CQ), (bf16_t*)(ws + WS_CKV), (bf16_t*)(ws + WS_U), (bf16_t*)(ws + WS_V), LF(10, 512), F.tabf};
            TS_RECL(50);
            gemm_phase<Epi1, SchedStatic, false, false>(F.wv, F.lds, 1024, S, E, nullptr);
            SEAM_L(pb0 + 1);
        }
        if (PHON(3) && IN(pb0 + 2)) {
            if (PHON(11) && (p2sel < 0 || p2sel == 0)) {
                SchedStatic S; S.init(T, 768, 256, F.G, F.c, ws + WS_CQ, wsw + W_UQ);
                { Unit u; const int t_ = my_tid(F.wv), r = t_ >> 1, hf = t_ & 1;
                  for (int i = 0; i < MAXU && S.next(i, u); ++i) {
                      const u32x4* p = (const u32x4*)((const bf16_t*)(ws + WS_CQ) + (size_t)(u.pm * 256 + r) * 256 + hf * 128); float s = 0.f;
                      u32x4 xx[16];
#pragma unroll
                      for (int k = 0; k < 16; ++k) xx[k] = p[k];
#pragma unroll
                      for (int k = 0; k < 16; ++k) s += sq4(unpack_lo((u32x2){xx[k].x, xx[k].y})) + sq4(unpack_lo((u32x2){xx[k].z, xx[k].w}));
                      s += __shfl_xor(s, 1);
                      if (hf == 0) F.tabf[i * 256 + r] = rsqrtf(s * (1.f / 256.f) + EPS); }
                  __syncthreads(); }
                EpiStore<true> E{(bf16_t*)(ws + WS_Q), 768, F.tabf};
                gemm_phase<EpiStore<true>, SchedStatic, false, false>(F.wv, F.lds, 256, S, E, nullptr);
                TS_RECL(51);
            }
            if (PHON(12) && (p2sel < 0 || p2sel == 1)) {
                SchedStatic S; S.init(T, 1024, 256, F.G, F.c, ws + WS_CKV, wsw + W_UKV);
                { Unit u; const int t_ = my_tid(F.wv), r = t_ >> 1, hf = t_ & 1;
                  for (int i = 0; i < MAXU && S.next(i, u); ++i) {
                      const u32x4* p = (const u32x4*)((const bf16_t*)(ws + WS_CKV) + (size_t)(u.pm * 256 + r) * 256); float s = 0.f, sk = 0.f;
#pragma unroll
                      for (int k = 0; k < 8; ++k) { const u32x4 x = p[hf * 8 + k]; s += sq4(unpack_lo((u32x2){x.x, x.y})) + sq4(unpack_lo((u32x2){x.z, x.w})); }
#pragma unroll
                      for (int k = 0; k < 2; ++k) { const u32x4 x = p[16 + hf * 2 + k]; sk += sq4(unpack_lo((u32x2){x.x, x.y})) + sq4(unpack_lo((u32x2){x.z, x.w})); }
                      s += __shfl_xor(s, 1); sk += __shfl_xor(sk, 1);
                      if (hf == 0) { F.tabf[i * 256 + r] = rsqrtf(s * (1.f / 128.f) + EPS); F.tabg[i * 256 + r] = sk; } }
                  __syncthreads(); }
                Epi2b E{(bf16_t*)(ws + WS_K), (bf16_t*)(ws + WS_VF), (const bf16_t*)(ws + WS_CKV), LF(9, 96), ROPE, F.tabf, F.tabg};
                gemm_phase<Epi2b, SchedStatic, false, false>(F.wv, F.lds, 256, S, E, nullptr);
                TS_RECL(52);
            }
            if (PHON(13) && (p2sel < 0 || p2sel == 2)) {
                SchedE S; S.init(T, 1024, 256, F.G, F.c, ws + WS_PB + (size_t)l * T * 256 * 2, wsw + W_PLE);
#if MOE_FP8
                EpiStoreF8 E{(unsigned char*)(ws + WS_E), 1024};
                gemm_phase<EpiStoreF8, SchedE, false, false>(F.wv, F.lds, 256, S, E, nullptr);
                TS_RECL(53);
#else
                EpiStore<false> E{(bf16_t*)(ws + WS_E), 1024, F.tabf};
                gemm_phase<EpiStore<false>, SchedStatic, false, false>(F.wv, F.lds, 256, S, E, nullptr);
#endif
            }
            if (PHON(14) && (p2sel < 0 || p2sel == 3)) for (int u = F.vcu; u < T / 128; u += F.G) gmlp_unit(F, u, (const bf16_t*)(ws + WS_U), (const bf16_t*)(ws + WS_V), (const bf16_t*)(wsw + W_S), LF(12, 8 * 128), (bf16_t*)(ws + WS_AM));
            SEAM_L(pb0 + 2);
        }
        if (PHON(4) && IN(pb0 + 3)) {
            CvCtx cv; cv.nl = -1; cv.wsw = ws; cv.stride = 1; cv.ptab = (const LAS unsigned long long*)(F.lds + PTR_OFF); int cv_it = 0, cv_iter = 0;
            const int grp = (F.c >> 3) & 3;
            for (int v = F.vcu; v < 256; v += F.G) {
                const int bh = v >> 1, j = v & 1;
                const int cvp = (MOE_FP8 && l + 1 < NL && v == F.vcu) ? ((grp == 1) ? 1 + j : grp) : -1;
#pragma unroll 1
                for (int i = 0; i < 4; ++i) {
                    if (i == cvp) {
                        CvCtx c2; c2.nl = l + 1; c2.wsw = ws + (((l + 1) & 1) ? W_ALT : 0); c2.stride = F.G * NWAVES; c2.ptab = (const LAS unsigned long long*)(F.lds + PTR_OFF);
                        const int tid_ = my_tid(F.wv);
                        for (int it = F.vcu * NWAVES + __builtin_amdgcn_readfirstlane(tid_ >> 6); it < IT_MOE; it += 2 * c2.stride) { f32x4 va[16], vb[16]; const int it1 = it + c2.stride < IT_MOE ? it + c2.stride : it;
                            cv_part<0>(c2, it, va, tid_ & 63); cv_part<0>(c2, it1, vb, tid_ & 63);
                            cv_part<1>(c2, it, va, tid_ & 63); cv_part<1>(c2, it1, vb, tid_ & 63); }
                        TS_RECL(54);
                    }
                    const int ii = (grp == 1) ? ((i == 0) ? 2 : (i == 1) ? 0 : (i == 2) ? 1 : 3) : i;
                    const int qb = (ii == 0) ? j : (ii == 1) ? 7 - j : (ii == 2) ? 3 - j : 4 + j;
                    attn_unit(F, bh >> 3, bh & 7, qb, (const bf16_t*)(ws + WS_Q), (const bf16_t*)(ws + WS_K), (const bf16_t*)(ws + WS_VF), (bf16_t*)(ws + WS_AM), (float*)(ws + WS_SSQAP), LF(8, 96), ROPE, cv, cv_it, cv_iter);
                }
            }
            SEAM_L(pb0 + 3);
        }
        if (PHON(5) && IN(pb0 + 4)) {
            SchedStatic S; S.init(T, 1024, 1024, F.G, F.c, ws + WS_AM, wsw + W_OUT); const float* ap = (const float*)(ws + WS_SSQAP);
            fill_tab_static(F, S, [&](int i, int r, int row) { float s = 0.f;
#pragma unroll
                for (int k = 0; k < 8; ++k) s += ap[(size_t)k * T + row];
                F.tabf[i * 256 + r] = rsqrtf(s * (1.f / 512.f) + EPS); });
            Epi4 E{XIN, XMID, F.tabf, MOE_FP8 ? (unsigned char*)(ws + WS_X8) : nullptr};
            TS_RECL(55);
            gemm_phase<Epi4, SchedStatic, false, true>(F.wv, F.lds, 1024, S, E, nullptr);
            SEAM_L(pb0 + 4);
        }
        if (PHON(6) && IN(pb0 + 5)) {
            for (int u = F.vcu; u < T / 128; u += F.G) router_unit(F, u, XMID, (const bf16_t*)(wsw + W_R), GCNT, (int*)(ws + S_SLOTTOK), (float*)(ws + S_SLOTRSTD), (float*)(ws + S_SLOTGATE));
            TS_REC(42 + l);
            SEAM(pb0 + 5);
        }
        if (PHON(7) && IN(pb0 + 6) && MOE_FP8 && l + 1 < NL) {
            CvCtx cv; int cv_it; cv.nl = l + 1; cv.wsw = ws + (((l + 1) & 1) ? W_ALT : 0);
            const int tid_ = my_tid(F.wv); cv_it = F.vcu * NWAVES + __builtin_amdgcn_readfirstlane(tid_ >> 6); cv.stride = F.G * NWAVES; cv.ptab = (const LAS unsigned long long*)(F.lds + PTR_OFF);
            { LayerW Ln; const int l_ = l; { const int l = l_ + 1; FILL_LAYERW(Ln, LF) } convert_small(Ln, cv.wsw, F.c * NTHREADS + tid_, F.G * NTHREADS);
              for (int it = cv_it; it < IT_SMALL; it += cv.stride) convert_item(Ln, cv.wsw, it, nullptr, tid_ & 63); }
        }
        TS_RECL(56);
        if ((PHON(7) && IN(pb0 + 6)) || (PHON(8) && IN(pb0 + 7))) {
            const int t_ = my_tid(F.wv);
            if (t_ < 32) moe_cnt[t_] = __hip_atomic_load(GCNT + t_, __ATOMIC_RELAXED, __HIP_MEMORY_SCOPE_AGENT);
            __syncthreads();
            if (t_ < 64) {
                const int n = t_ < 32 ? (moe_cnt[t_ & 31] + 255) >> 8 : 0; int inc = n;
#pragma unroll
                for (int d = 1; d < 32; d <<= 1) { const int o = __shfl_up(inc, d, 64); if ((t_ & 63) >= d) inc += o; }
                if (t_ < 32) { const int b = inc - n; moe_tb[t_] = b; for (int k = 0; k < n; ++k) moe_te[b + k] = t_; if (t_ == 31) moe_tb[32] = inc; }
            }
            __syncthreads();
        }
        if (PHON(7) && IN(pb0 + 6)) {
            const int* stok = (const int*)(ws + S_SLOTTOK); const float* srs = (const float*)(ws + S_SLOTRSTD);
#if MOE_FP8
            SchedMoe S{moe_tb[32], F.G, F.c, moe_te, (const char*)(ws + WS_X8), (const char*)(wsw + W_13), 0, (size_t)1024 * 1024, (size_t)256 * 1024};
#else
            SchedMoe S{moe_tb[32], F.G, F.c, moe_te, (const char*)XMID, (const char*)(wsw + W_13), 0, (size_t)1024 * 1024 * 2, (size_t)256 * 1024 * 2};
#endif
            fill_units(F, S, [&](int i, int r, int pm, int e) {
                const int pos = (pm - moe_tb[e]) * 256 + r; const bool ok = pos < moe_cnt[e]; const size_t o = (size_t)e * T + (ok ? pos : 0);
                const int tk = stok[o]; const float rs = srs[o];
                F.tabi[i * 256 + r] = ok ? (tk & 0x3fffffff) : 0; F.tabf[i * 256 + r] = ok ? rs : 0.f; });
#if MOE_FP8
            Epi6F8 E{(unsigned char*)(ws + WS_H), F.tabf};
            TS_RECL(57);
            gemm_phase<Epi6F8, SchedMoe, true, false, true>(F.wv, F.lds, 512, S, E, F.tabi);
#else
            Epi6 E{(bf16_t*)(ws + WS_H), F.tabf};
            gemm_phase<Epi6, SchedMoe, true, false>(F.wv, F.lds, 1024, S, E, F.tabi);
#endif
            SEAM_L(pb0 + 6);
        }
        if (PHON(8) && IN(pb0 + 7)) {
            const int* stok = (const int*)(ws + S_SLOTTOK); const float* sg = (const float*)(ws + S_SLOTGATE);
#if MOE_FP8
            SchedMoe S{moe_tb[32], F.G, F.c, moe_te, (const char*)(ws + WS_H), (const char*)(wsw + W_2), (size_t)256 * 512, (size_t)1024 * 512, (size_t)256 * 512};
#else
            SchedMoe S{moe_tb[32], F.G, F.c, moe_te, (const char*)(ws + WS_H), (const char*)(wsw + W_2), (size_t)256 * 512 * 2, (size_t)1024 * 512 * 2, (size_t)256 * 512 * 2};
#endif
            fill_units(F, S, [&](int i, int r, int pm, int e) {
                const int pos = (pm - moe_tb[e]) * 256 + r; const bool ok = pos < moe_cnt[e]; const size_t o = (size_t)e * T + (ok ? pos : 0);
                const int tk = stok[o]; const float g = sg[o];
                F.tabi[i * 256 + r] = ok ? tk : -1; F.tabg[i * 256 + r] = ok ? g : 0.f; });
#if MOE_FP8
            Epi7 E{(bf16_t*)(ws + WS_Y0), (bf16_t*)(ws + WS_Y1), F.tabi, F.tabg, W8_INV};
            TS_RECL(58);
            gemm_phase<Epi7, SchedMoe, false, false, true>(F.wv, F.lds, 256, S, E, nullptr);
#else
            Epi7 E{(bf16_t*)(ws + WS_Y0), (bf16_t*)(ws + WS_Y1), F.tabi, F.tabg, 1.f};
            gemm_phase<Epi7, SchedMoe, false, false>(F.wv, F.lds, 512, S, E, nullptr);
#endif
            SEAM(pb0 + 7);
        }
        if (PHON(9) && IN(pb0 + 8)) {
            const int tid_ = my_tid(F.wv), lane = tid_ & 63, gw = F.vcu * NWAVES + (tid_ >> 6), ngw = F.G * NWAVES;
            for (int mk = 0; mk < T / ngw; ++mk) { const int m = (gw >> 8) * 4096 + mk * 256 + (gw & 255);
#if MOE_FP8
                const u32x2* a = (const u32x2*)(ws + WS_Y0 + (size_t)m * 1024) + lane; const u32x2* b = (const u32x2*)(ws + WS_Y1 + (size_t)m * 1024) + lane; const u32x4* hh = (const u32x4*)(XMID + (size_t)m * 1024) + lane; u32x4* o = (u32x4*)(XIN + (size_t)m * 1024) + lane; float s = 0.f;
#pragma unroll
                for (int j = 0; j < 2; ++j) {
                    const u32x2 x = __builtin_nontemporal_load(a + 64 * j), y = __builtin_nontemporal_load(b + 64 * j); const u32x4 z = __builtin_nontemporal_load(hh + 64 * j);
                    const f32x4 v0 = unpack_lo((u32x2){z.x, z.y}) + (unpack_fp8x4(x.x) + unpack_fp8x4(y.x)) * Y8_INV, v1 = unpack_lo((u32x2){z.z, z.w}) + (unpack_fp8x4(x.y) + unpack_fp8x4(y.y)) * Y8_INV;
#else
                const u32x4* a = (const u32x4*)(ws + WS_Y0 + (size_t)m * 2048) + lane; const u32x4* b = (const u32x4*)(ws + WS_Y1 + (size_t)m * 2048) + lane; const u32x4* hh = (const u32x4*)(XMID + (size_t)m * 1024) + lane; u32x4* o = (u32x4*)(XIN + (size_t)m * 1024) + lane; float s = 0.f;
#pragma unroll
                for (int j = 0; j < 2; ++j) {
                    const u32x4 x = a[64 * j], y = b[64 * j], z = hh[64 * j];
                    const f32x4 v0 = unpack_lo((u32x2){z.x, z.y}) + (unpack_lo((u32x2){x.x, x.y}) + unpack_lo((u32x2){y.x, y.y})), v1 = unpack_lo((u32x2){z.z, z.w}) + (unpack_lo((u32x2){x.z, x.w}) + unpack_lo((u32x2){y.z, y.w}));
#endif
                    const u32x4 w = pack8(v0, v1); o[64 * j] = w;
                    const f32x4 r0 = unpack_lo((u32x2){w.x, w.y}), r1 = unpack_lo((u32x2){w.z, w.w});
                    if (MOE_FP8) { u32x2 q; q.x = pk4_fp8(r0[0], r0[1], r0[2], r0[3]); q.y = pk4_fp8(r1[0], r1[1], r1[2], r1[3]); ((u32x2*)(ws + WS_X8 + (size_t)m * 1024))[lane + 64 * j] = q; }
                    s += sq4(r0) + sq4(r1);
                }
                if (l + 1 < NL) { const f32x4 pv = __builtin_nontemporal_load((const f32x4*)(lds_inptr((const LAS unsigned long long*)(F.lds + PTR_OFF), 1) + ((size_t)(l + 1) * T + m) * 256) + lane); u32x2 pw; pw.x = cvt_pk_bf16(pv.x, pv.y); pw.y = cvt_pk_bf16(pv.z, pv.w);
                    ((u32x2*)((bf16_t*)(ws + WS_PB) + ((size_t)(l + 1) * T + m) * 256))[lane] = pw; }
                s = wave_sum(s); if (lane == 0) ((float*)(ws + S_RSTD2))[m] = rsqrtf(s * (1.f / 1024.f) + EPS);
            }
            SEAM_L(pb0 + 8);
        }
        if (PHON(10) && IN(pb0 + 9)) {
#if MOE_FP8
            SchedStatic S; S.init(T, 1024, 512, F.G, F.c, ws + WS_X8, wsw + W_PG); const float* rstd2 = (const float*)(ws + S_RSTD2);
            fill_tab_static(F, S, [&](int i, int r, int row) { F.tabf[i * 256 + r] = rstd2[row] * W8_INV; });
#else
            SchedStatic S; S.init(T, 1024, 1024, F.G, F.c, XIN, wsw + W_PG); const float* rstd2 = (const float*)(ws + S_RSTD2);
            fill_tab_static(F, S, [&](int i, int r, int row) { F.tabf[i * 256 + r] = rstd2[row]; });
#endif
            Epi9 E{XIN, (const unsigned char*)(ws + WS_E), XMID, (l == NL - 1) ? args.out : nullptr, (float*)(ws + WS_SSQHP), LF(24, 1024), F.tabf};
#if MOE_FP8
            TS_RECL(59);
            gemm_phase<Epi9, SchedStatic, false, false, true>(F.wv, F.lds, 512, S, E, nullptr);
#else
            gemm_phase<Epi9, SchedStatic, false, false>(F.wv, F.lds, 1024, S, E, nullptr);
#endif
            SEAM_L(pb0 + 9);
        }
    }
#ifdef TS_A
    if (F.c == TS_C && my_tid(F.wv) == 0) { volatile LAS unsigned long long* ts = (volatile LAS unsigned long long*)(F.lds + PTR_OFF + 256);
        const unsigned long long d = ts[TS_B] - ts[TS_A], end = __builtin_amdgcn_s_memrealtime() + (unsigned long long)TS_M * d;
        if (d < 100000ull) while (__builtin_amdgcn_s_memrealtime() < end) __builtin_amdgcn_s_sleep(16); }
#endif
#undef IN
#undef SEAM
}

#ifdef PROBE_EXTRA
__global__ void __launch_bounds__(NTHREADS, 2) mk_probe(MkArgs args) {
    extern __shared__ __attribute__((aligned(16))) unsigned char lds_raw[];
    Frame F; F.lds = (LAS unsigned char*)lds_raw; F.ws = args.ws; F.wv = __builtin_amdgcn_readfirstlane((int)threadIdx.x >> 6);
    F.G = gridDim.x; F.c = blockIdx.x; F.vcu = F.c; F.tabf = (LAS float*)(F.lds + TABF_OFF); F.tabi = (LAS int*)(F.lds + TABI_OFF); F.tabg = (LAS float*)(F.lds + TABG_OFF);
    unsigned char* ws = args.ws; const int sel = args.ph_lo;
    for (int i = threadIdx.x; i < MAXU * 256; i += NTHREADS) F.tabf[i] = 1.f;
    __syncthreads();
    if (sel >= 10 && sel < 18) {
        CvCtx cv; cv.nl = -1; cv.wsw = ws; cv.stride = 1; cv.ptab = nullptr; int cv_it = 0, cv_iter = 0;
        const float* gq = (const float*)(ws + S_ROPE); const float* rope = (const float*)(ws + S_ROPE);
        const int v = (F.c % 8) * (F.G / 8) + F.c / 8, bh = v >> 1, j = v & 1;
#pragma unroll 1
        for (int i = 0; i < 4; ++i) { const int qb = (i == 0) ? j : (i == 1) ? 7 - j : (i == 2) ? 3 - j : 4 + j;
#define PATT(V) attn_unit<V>(F, bh >> 3, bh & 7, qb, (const bf16_t*)(ws + WS_AM), (const bf16_t*)(ws + WS_X0), (const bf16_t*)(ws + WS_X1), (bf16_t*)(ws + WS_SCR), (float*)(ws + WS_SCR + 64 * MiB), gq, rope, cv, cv_it, cv_iter)
            if (sel == 10) PATT(0); else if (sel == 11) PATT(1); else if (sel == 12) PATT(2); else if (sel == 13) PATT(3); else if (sel == 14) PATT(4); else if (sel == 17) PATT(7);
#undef PATT
        }
    }
    if (sel == 0) { SchedStatic S; S.init(T, 1024, 256, F.G, F.c, ws + WS_CKV, ws + W_UKV); EpiNull E{(float*)(ws + WS_SCR)}; gemm_phase<EpiNull, SchedStatic, false, false>(F.wv, F.lds, 256, S, E, nullptr); }
    if (sel == 1) { SchedStatic S; S.init(T, 1024, 1024, F.G, F.c, ws + WS_AM, ws + W_OUT); EpiNull E{(float*)(ws + WS_SCR)}; gemm_phase<EpiNull, SchedStatic, false, false>(F.wv, F.lds, 1024, S, E, nullptr); }
    if (sel == 2) { SchedStatic S; S.init(T, 1024, 256, F.G, F.c, ws + WS_CKV, ws + W_UKV); EpiStore<false> E{(bf16_t*)(ws + WS_SCR), 1024, F.tabf}; gemm_phase<EpiStore<false>, SchedStatic, false, false>(F.wv, F.lds, 256, S, E, nullptr); }
    if (sel == 3) { SchedStatic S; S.init(T, 1024, 1024, F.G, F.c, ws + WS_AM, ws + W_OUT); EpiStore<false> E{(bf16_t*)(ws + WS_SCR), 1024, F.tabf}; gemm_phase<EpiStore<false>, SchedStatic, false, false>(F.wv, F.lds, 1024, S, E, nullptr); }
}
#endif

#ifndef FASTMASK
#define FASTMASK 0x7ff
#endif
static void launch_mk(const MkArgs& base, int lo, int hi, int grid, hipStream_t stream) {
    MkArgs a = base; a.ph_lo = lo; a.ph_hi = hi;
    hipLaunchKernelGGL(mk_fwd, dim3(grid), dim3(NTHREADS), LDS_BYTES, stream, a);
}
extern "C" void kernel_launch(void* const* d_in, const int* in_sizes, int n_in, void* d_out, int out_size, void* d_ws, size_t ws_size, hipStream_t stream) {
    static int grid = 0;
    if (grid == 0) {
        if (n_in != 26 || ws_size < WS_END) { fprintf(stderr, "kernel_launch: unexpected n_in %d or ws_size %zu\n", n_in, ws_size); grid = -1; return; }
        int dev = 0, cus = 0;
        if (hipGetDevice(&dev) != hipSuccess || hipDeviceGetAttribute(&cus, hipDeviceAttributeMultiprocessorCount, dev) != hipSuccess) { grid = -1; return; }
        if (hipFuncSetAttribute((const void*)mk_fwd, hipFuncAttributeMaxDynamicSharedMemorySize, LDS_BYTES) != hipSuccess) { fprintf(stderr, "kernel_launch: hipFuncSetAttribute failed\n"); grid = -1; return; }
        int per_cu = 0;
        if (hipOccupancyMaxActiveBlocksPerMultiprocessor(&per_cu, (const void*)mk_fwd, NTHREADS, LDS_BYTES) != hipSuccess || per_cu < 1) fprintf(stderr, "kernel_launch: occupancy query says %d\n", per_cu);
        (void)hipGetLastError();
        grid = cus;
    }
    if (grid < 0) return;
    unsigned char* ws = (unsigned char*)d_ws;
    (void)hipMemsetAsync(ws + WS_ZERO, 0, ZERO_BYTES, stream);
    MkArgs A{};
    for (int i = 0; i < 26; ++i) A.in[i] = (const float*)d_in[i];
    A.out = (float*)d_out; A.ws = ws;
    constexpr unsigned FM = FASTMASK;
    if (FM == 0x7ffu) {
        launch_mk(A, 0, 1 + 10 * NL, grid, stream);
#ifdef PROBE_PH
#ifdef PROBE_EXTRA
        { static bool once = false; if (!once) { (void)hipFuncSetAttribute((const void*)mk_probe, hipFuncAttributeMaxDynamicSharedMemorySize, LDS_BYTES); once = true; }
          MkArgs a = A; a.ph_lo = PROBE_PH; a.ph_hi = 0; for (int r_ = 0; r_ < PROBE_REP; ++r_) hipLaunchKernelGGL(mk_probe, dim3(grid), dim3(NTHREADS), LDS_BYTES, stream, a); }
#else
        for (int r_ = 0; r_ < PROBE_REP; ++r_) launch_mk(A, 31 + PROBE_PH, 32 + PROBE_PH, grid, stream);
#endif
#endif
        return; }
    const float* x = (const float*)d_in[0]; const float* p = (const float*)d_in[1];
    if (FM & 1u) launch_mk(A, 0, 1, grid, stream); else k_prologue<<<1024, 256, 0, stream>>>(x, p, ws);
    float* scr = (float*)(ws + WS_SCR);
    bf16_t* X[2] = {(bf16_t*)(ws + WS_X0), (bf16_t*)(ws + WS_X1)};
    int* gidx = (int*)(ws + S_FLAT); int* tile_e = gidx + 3 * MAXSLOT; int* nrows = tile_e + MAXSLOT / 128 + MAXSLOT;
    for (int l = 0; l < NL; ++l) {
        auto F = [&](int i, size_t per) { return (const float*)d_in[i] + (size_t)l * per; };
        LayerW L;
        L.g_mix = F(2, 1024); L.w_in = F(3, 1024 * 1440); L.g_cq = F(4, 256); L.g_ckv = F(5, 128); L.w_uq = F(6, 256 * 768); L.w_ukv = F(7, 128 * 1024);
        L.g_qn = F(8, 96); L.g_kn = F(9, 96); L.g_v = F(10, 512); L.w_s = F(11, 8 * 128 * 128); L.b_s = F(12, 8 * 128); L.g_oa = F(13, 512); L.g_om = F(14, 512);
        L.w_out = F(15, 1024 * 1024); L.g_ffn = F(16, 1024); L.w_rg = F(17, 1024 * 4); L.w_re = F(18, 1024 * 32);
        L.w1 = F(19, (size_t)32 * 1024 * 512); L.w3 = F(20, (size_t)32 * 1024 * 512); L.w2 = F(21, (size_t)32 * 512 * 1024);
        L.g_ple = F(22, 1024); L.w_pg = F(23, 1024 * 1024); L.b_pg = F(24, 1024); L.w_ple = F(25, 256 * 1024);
        bf16_t* Xin = X[l & 1]; bf16_t* Xmid = X[(l & 1) ^ 1];
        const int pb0 = 1 + 10 * l;
        if (FM & 2u) launch_mk(A, pb0 + 0, pb0 + 1, grid, stream); else k_convert<<<1024, 256, 0, stream>>>(L, ws);
        if (FM & 4u) launch_mk(A, pb0 + 1, pb0 + 2, grid, stream);
        else {
            k_ngemm<<<dim3(NPROJ / 128, T / 128), 256, 0, stream>>>(Xin, 1024, nullptr, (const bf16_t*)(ws + W_IN), 1024, nullptr, 0, scr, NPROJ, 1024, nullptr);
            k_post1<<<T / 4, 256, 0, stream>>>(scr, ws, l, L.g_v);
        }
        if (FM & 8u) launch_mk(A, pb0 + 2, pb0 + 3, grid, stream);
        else {
            k_ngemm<<<dim3(768 / 128, T / 128), 256, 0, stream>>>((const bf16_t*)(ws + WS_CQ), 256, nullptr, (const bf16_t*)(ws + W_UQ), 256, nullptr, 0, scr, 768, 256, nullptr);
            k_post2a<<<T * 768 / 256, 256, 0, stream>>>(scr, ws, l);
            k_ngemm<<<dim3(1024 / 128, T / 128), 256, 0, stream>>>((const bf16_t*)(ws + WS_CKV), 256, nullptr, (const bf16_t*)(ws + W_UKV), 256, nullptr, 0, scr, 1024, 256, nullptr);
            k_post2b<<<T * 8 / 4, 256, 0, stream>>>(scr, ws, l, L.g_kn);
            k_gmlp<<<T * 512 / 256, 256, 0, stream>>>(ws, L.b_s);
            k_rowstat_am<<<T / 4, 256, 0, stream>>>(ws, l, 1);
            k_norm_m<<<T * 512 / 256, 256, 0, stream>>>(ws);
            k_ngemm<<<dim3(1024 / 128, T / 128), 256, 0, stream>>>((const bf16_t*)(ws + WS_PB) + (size_t)l * T * 256, 256, nullptr, (const bf16_t*)(ws + W_PLE), 256, nullptr, 0, scr, 1024, 256, nullptr);
            k_tobf16<<<T * 1024 / 256, 256, 0, stream>>>(scr, (bf16_t*)(ws + WS_E));
        }
        if (FM & 16u) launch_mk(A, pb0 + 3, pb0 + 4, grid, stream);
        else {
            k_attn<<<T * 8 / 64, 64, 0, stream>>>(ws, L.g_qn);
            k_rowstat_am<<<T / 4, 256, 0, stream>>>(ws, l, 0);
        }
        if (FM & 32u) launch_mk(A, pb0 + 4, pb0 + 5, grid, stream);
        else {
            k_ngemm<<<dim3(1024 / 128, T / 128), 256, 0, stream>>>((const bf16_t*)(ws + WS_AM), 1024, nullptr, (const bf16_t*)(ws + W_OUT), 1024, nullptr, 0, scr, 1024, 512, nullptr);
            k_ngemm<<<dim3(1024 / 128, T / 128), 256, 0, stream>>>((const bf16_t*)(ws + WS_AM) + 512, 1024, nullptr, (const bf16_t*)(ws + W_OUT) + 512, 1024, nullptr, 0, scr + (size_t)T * 1024, 1024, 512, nullptr);
            k_post4<<<T * 1024 / 256, 256, 0, stream>>>(scr, ws, l, Xin, Xmid);
        }
        if (FM & 64u) launch_mk(A, pb0 + 5, pb0 + 6, grid, stream); else k_router<<<T / 4, 256, 0, stream>>>(ws, l, Xmid);
        if ((FM & 384u) != 384u) k_build<<<1, 256, 0, stream>>>(ws, l);
        if (FM & 128u) launch_mk(A, pb0 + 6, pb0 + 7, grid, stream);
        else {
            k_ngemm<<<dim3(1024 / 128, MAXSLOT / 128), 256, 0, stream>>>(Xmid, 1024, gidx, (const bf16_t*)(ws + W_13), 1024, tile_e, (size_t)1024 * 1024, scr, 1024, 1024, nrows);
            k_post6<<<MAXSLOT * 512 / 256, 256, 0, stream>>>(scr, ws);
        }
        if (FM & 256u) launch_mk(A, pb0 + 7, pb0 + 8, grid, stream);
        else {
            k_ngemm<<<dim3(1024 / 128, MAXSLOT / 128), 256, 0, stream>>>((const bf16_t*)(ws + WS_H), 512, nullptr, (const bf16_t*)(ws + W_2), 512, tile_e, (size_t)1024 * 512, scr, 1024, 512, nrows);
            k_post7<<<MAXSLOT * 1024 / 256, 256, 0, stream>>>(scr, ws, Xmid);
        }
        if (FM & 512u) launch_mk(A, pb0 + 8, pb0 + 9, grid, stream); else k_combine<<<T / 4, 256, 0, stream>>>(ws, Xin);
        if (FM & 1024u) launch_mk(A, pb0 + 9, pb0 + 10, grid, stream);
        else {
            k_ngemm<<<dim3(1024 / 128, T / 128), 256, 0, stream>>>(Xin, 1024, nullptr, (const bf16_t*)(ws + W_PG), 1024, nullptr, 0, scr, 1024, 1024, nullptr);
            k_post9<<<T / 4, 256, 0, stream>>>(scr, ws, l, Xin, Xmid, l == NL - 1 ? (float*)d_out : nullptr, L.b_pg);
        }
    }
}
```
